# Optimizing an MI355X kernel written in HIP

```python
import jax, jax.numpy as jnp
from jax import lax
import numpy as np

D_MODEL = 1024
BATCH = 16
SEQ = 2048
DEPTH = 2
DEC_BATCH = 128
DEC_SEQ = 1
PAST_LEN = 16384
PAGE_SIZE = 128

D_MIX = D_MODEL
D_POOL = D_MIX // 4
POOL_WINDOWS = (2, 4, 8, 16)
POOL_GROUPS = len(POOL_WINDOWS)
POOL_CG = D_POOL // POOL_GROUPS
POOL_BUF = max(POOL_WINDOWS) - 1
HEAD_DIM = 64
D_ATTN = D_MIX // 2
N_HEADS = D_ATTN // HEAD_DIM
N_KV = max(1, N_HEADS // 4)
Q_PER_KV = N_HEADS // N_KV
D_KV = N_KV * HEAD_DIM
WINDOW = 128
BLOCK = 128
ROPE_THETA = 10000.0
QK_EPS = 1e-6
D_RWKV = D_MIX - D_POOL - D_ATTN
RWKV_HEAD = 64
RWKV_HEADS = D_RWKV // RWKV_HEAD
LORA_W = 32
LORA_A = 32
D_SHIFT = 3 * D_RWKV + LORA_W + LORA_A
GN_EPS = 64e-5
NORM_EPS = 1e-6
D_IN = 2 * D_POOL + 2 * D_ATTN + 2 * D_KV + D_SHIFT + D_RWKV

kernel_name = "hymba_pool_swa_rwkv7_step"


def _split(z, sizes):
    idx = [int(i) for i in np.cumsum(sizes)[:-1]]
    return jnp.split(z, idx, axis=-1)


def _rmsnorm(x, g, eps):
    xf = x.astype(jnp.float32)
    y = xf * lax.rsqrt(jnp.mean(xf * xf, axis=-1, keepdims=True) + eps)
    return (y * g.astype(jnp.float32)).astype(x.dtype)


def _rope(x, pos):
    half = HEAD_DIM // 2
    freqs = ROPE_THETA ** (-jnp.arange(half, dtype=jnp.float32) / half)
    ang = pos.astype(jnp.float32)[:, None] * freqs[None, :]
    c = jnp.cos(ang)[None, :, None, :]
    s = jnp.sin(ang)[None, :, None, :]
    xf = x.astype(jnp.float32)
    x1, x2 = xf[..., :half], xf[..., half:]
    return jnp.concatenate([x1 * c - x2 * s, x1 * s + x2 * c], axis=-1).astype(x.dtype)


def _sink_softmax(s, mask, sinks):
    s = jnp.where(mask, s, -jnp.inf)
    sink = sinks.astype(jnp.float32)[:, :, None, None]
    m = jnp.maximum(jnp.max(s, axis=-1, keepdims=True), sink)
    p = jnp.exp(s - m)
    denom = jnp.sum(p, axis=-1, keepdims=True) + jnp.exp(sink - m)
    return p / denom


def _swa_prompt(q, k, v, sinks):
    B, T = q.shape[:2]
    nb = T // BLOCK
    scale = HEAD_DIM ** -0.5
    qb = q.reshape(B, nb, BLOCK, N_KV, Q_PER_KV, HEAD_DIM)

    def with_prev(t):
        tb = t.reshape(B, nb, BLOCK, N_KV, HEAD_DIM)
        prev = jnp.pad(tb, ((0, 0), (1, 0), (0, 0), (0, 0), (0, 0)))[:, :-1]
        return jnp.concatenate([prev, tb], axis=2)

    kx, vx = with_prev(k), with_prev(v)
    s = jnp.einsum('bnqkgd,bnskd->bnkgqs', qb, kx, preferred_element_type=jnp.float32) * scale
    qi = jnp.arange(BLOCK)[:, None] + BLOCK
    ki = jnp.arange(2 * BLOCK)[None, :]
    band = (ki <= qi) & (ki > qi - WINDOW)
    kabs = jnp.arange(nb)[:, None] * BLOCK - BLOCK + jnp.arange(2 * BLOCK)[None, :]
    mask = band[None, :, :] & (kabs >= 0)[:, None, :]
    mask = mask[None, :, None, None]
    p = _sink_softmax(s, mask, sinks.reshape(N_KV, Q_PER_KV))
    o = jnp.einsum('bnkgqs,bnskd->bnqkgd', p.astype(vx.dtype), vx)
    return o.reshape(B, T, N_HEADS * HEAD_DIM)


def _swa_cached(q, k, v, k_buf, v_buf, pos0, sinks):
    B, T = q.shape[:2]
    scale = HEAD_DIM ** -0.5
    kx = jnp.concatenate([k_buf.astype(k.dtype), k], axis=1)
    vx = jnp.concatenate([v_buf.astype(v.dtype), v], axis=1)
    L = kx.shape[1]
    kpos = pos0 - k_buf.shape[1] + jnp.arange(L)
    qpos = pos0 + jnp.arange(T)
    mask = (kpos[None, :] <= qpos[:, None]) & (kpos[None, :] > qpos[:, None] - WINDOW) & (kpos[None, :] >= 0)
    qg = q.reshape(B, T, N_KV, Q_PER_KV, HEAD_DIM)
    s = jnp.einsum('btkgd,bskd->bkgts', qg, kx, preferred_element_type=jnp.float32) * scale
    p = _sink_softmax(s, mask, sinks.reshape(N_KV, Q_PER_KV))
    o = jnp.einsum('bkgts,bskd->btkgd', p.astype(vx.dtype), vx).reshape(B, T, N_HEADS * HEAD_DIM)
    return o, kx[:, -WINDOW:], vx[:, -WINDOW:]


def _pool_mixer(u, buf, pos0, pool_w, pool_scale):
    B, T, C = u.shape
    P = buf.shape[1]
    ext = jnp.concatenate([buf.astype(u.dtype), u], axis=1)
    cs = jnp.cumsum(ext.astype(jnp.float32), axis=1)
    cs = jnp.pad(cs, ((0, 0), (1, 0), (0, 0)))
    pos = pos0 + jnp.arange(T)
    uf = u.astype(jnp.float32)
    outs = []
    for g, w in enumerate(POOL_WINDOWS):
        sl = slice(g * POOL_CG, (g + 1) * POOL_CG)
        win_sum = cs[:, P + 1:P + 1 + T, sl] - cs[:, P + 1 - w:P + 1 - w + T, sl]
        cnt = jnp.minimum(pos + 1, w).astype(jnp.float32)[None, :, None]
        outs.append(win_sum / cnt - uf[..., sl])
    pooled = jnp.concatenate(outs, axis=-1).reshape(B, T, POOL_GROUPS, POOL_CG)
    mixed = jnp.einsum('btgc,gcd->btgd', pooled, pool_w.astype(jnp.float32)).reshape(B, T, C)
    mixed = mixed * pool_scale.astype(jnp.float32)
    return mixed.astype(u.dtype), ext[:, -P:]


def _rwkv_mix(xin, shift_prev, wkv0, p):
    B, T, _ = xin.shape
    f32 = jnp.float32
    prev = jnp.concatenate([shift_prev[:, None].astype(xin.dtype), xin[:, :-1]], axis=1)
    xf = xin.astype(f32)
    xs = xf + (prev.astype(f32) - xf) * p['mu'].astype(f32)
    r, k, v, wd, ad = _split(xs, (D_RWKV, D_RWKV, D_RWKV, LORA_W, LORA_A))
    w_log = -jax.nn.softplus(-(p['w0'].astype(f32) + jnp.tanh(wd) @ p['w_up'].astype(f32))) - 0.5
    decay = jnp.exp(-jnp.exp(w_log))
    a = jax.nn.sigmoid(p['a0'].astype(f32) + ad @ p['a_up'].astype(f32))
    heads = lambda t: t.reshape(B, T, RWKV_HEADS, RWKV_HEAD)
    kk = heads(k * p['k_k'].astype(f32))
    kk = kk / jnp.maximum(jnp.sqrt(jnp.sum(kk * kk, axis=-1, keepdims=True)), 1e-12)
    k = k * (1.0 + (a - 1.0) * p['k_a'].astype(f32))
    r, k, v, decay, a = heads(r), heads(k), heads(v), heads(decay), heads(a)

    def step(S, inp):
        r_t, w_t, k_t, v_t, kk_t, a_t = inp
        sa = jnp.einsum('bhvk,bhk->bhv', S, kk_t)
        S = S * w_t[:, :, None, :] - sa[..., None] * (kk_t * a_t)[:, :, None, :] + v_t[..., None] * k_t[:, :, None, :]
        o = jnp.einsum('bhvk,bhk->bhv', S, r_t)
        return S, o

    seq = tuple(jnp.moveaxis(t, 1, 0) for t in (r, decay, k, v, kk, a))
    S, o = lax.scan(step, wkv0.astype(f32), seq)
    o = jnp.moveaxis(o, 0, 1)
    mu_o = jnp.mean(o, axis=-1, keepdims=True)
    var_o = jnp.mean(jnp.square(o - mu_o), axis=-1, keepdims=True)
    o = (o - mu_o) * lax.rsqrt(var_o + GN_EPS)
    o = o * p['ln_g'].astype(f32).reshape(RWKV_HEADS, RWKV_HEAD) + p['ln_b'].astype(f32).reshape(RWKV_HEADS, RWKV_HEAD)
    bonus = jnp.sum(r * k * p['r_k'].astype(f32).reshape(RWKV_HEADS, RWKV_HEAD), axis=-1, keepdims=True) * v
    o = (o + bonus).reshape(B, T, D_RWKV)
    return o.astype(xin.dtype), xin[:, -1], S.astype(wkv0.dtype)


def _layer(x, pos0, pool_buf, k_buf, v_buf, shift_prev, wkv0, p):
    B, T, _ = x.shape
    dt = x.dtype
    h = _rmsnorm(x, p['norm_g'], NORM_EPS)
    z = h @ p['w_in']
    u, g_pool, q, k, v, g_attn, rin, g_rwkv = _split(
        z, (D_POOL, D_POOL, D_ATTN, D_KV, D_KV, D_ATTN, D_SHIFT, D_RWKV))
    a_out, new_pool = _pool_mixer(u, pool_buf, pos0, p['pool_w'], p['pool_scale'])
    pos = pos0 + jnp.arange(T)
    q = _rope(_rmsnorm(q.reshape(B, T, N_HEADS, HEAD_DIM), p['q_g'], QK_EPS), pos)
    k = _rope(_rmsnorm(k.reshape(B, T, N_KV, HEAD_DIM), p['k_g'], QK_EPS), pos)
    v = v.reshape(B, T, N_KV, HEAD_DIM)
    if k_buf is None:
        b_out = _swa_prompt(q, k, v, p['sinks'])
        new_k, new_v = k[:, -WINDOW:], v[:, -WINDOW:]
    else:
        b_out, new_k, new_v = _swa_cached(q, k, v, k_buf, v_buf, pos0, p['sinks'])
    c_out, new_shift, new_wkv = _rwkv_mix(rin, shift_prev, wkv0, p)
    mix = jnp.concatenate([
        a_out.astype(dt) * jax.nn.silu(g_pool),
        b_out.astype(dt) * jax.nn.silu(g_attn),
        c_out.astype(dt) * jax.nn.silu(g_rwkv)], axis=-1)
    y = x + mix @ p['w_out']
    return y, (new_pool, new_k, new_v, new_shift, new_wkv)


def setup_inputs(seed: int = 0) -> dict:
    key = jax.random.key(seed)
    ks = jax.random.split(key, 32)
    f = jnp.float32
    nrm = lambda kk, shape, sc: jax.random.normal(kk, shape, f) * sc
    uni = lambda kk, shape, lo, hi: jax.random.uniform(kk, shape, f, lo, hi)
    return {
        'x_prompt': nrm(ks[0], (BATCH, SEQ, D_MODEL), 1.0),
        'x_sample': nrm(ks[1], (DEC_BATCH, DEC_SEQ, D_MODEL), 1.0),
        'state_pool': nrm(ks[2], (DEPTH, DEC_BATCH, POOL_BUF, D_POOL), 1.0),
        'cache_swa_k': nrm(ks[3], (DEPTH, DEC_BATCH, WINDOW, N_KV, HEAD_DIM), 1.0),
        'cache_swa_v': nrm(ks[4], (DEPTH, DEC_BATCH, WINDOW, N_KV, HEAD_DIM), 1.0),
        'state_rwkv_shift': nrm(ks[5], (DEPTH, DEC_BATCH, D_SHIFT), 1.0),
        'state_rwkv_wkv': nrm(ks[6], (DEPTH, DEC_BATCH, RWKV_HEADS, RWKV_HEAD, RWKV_HEAD), 0.3),
        'norm_g': 1.0 + nrm(ks[7], (DEPTH, D_MODEL), 0.05),
        'w_in': nrm(ks[8], (DEPTH, D_MODEL, D_IN), D_MODEL ** -0.5),
        'w_out': nrm(ks[9], (DEPTH, D_MIX, D_MODEL), D_MIX ** -0.5),
        'pool_w': nrm(ks[10], (DEPTH, POOL_GROUPS, POOL_CG, POOL_CG), POOL_CG ** -0.5),
        'pool_scale': 1.0 + nrm(ks[11], (DEPTH, D_POOL), 0.1),
        'q_norm_g': 1.0 + nrm(ks[12], (DEPTH, HEAD_DIM), 0.05),
        'k_norm_g': 1.0 + nrm(ks[13], (DEPTH, HEAD_DIM), 0.05),
        'attn_sinks': nrm(ks[14], (DEPTH, N_HEADS), 0.5),
        'rwkv_mu': uni(ks[15], (DEPTH, D_SHIFT), 0.0, 1.0),
        'rwkv_w0': uni(ks[16], (DEPTH, D_RWKV), -5.0, 1.0),
        'rwkv_w_up': nrm(ks[17], (DEPTH, LORA_W, D_RWKV), 0.5 * LORA_W ** -0.5),
        'rwkv_a0': nrm(ks[18], (DEPTH, D_RWKV), 0.5),
        'rwkv_a_up': nrm(ks[19], (DEPTH, LORA_A, D_RWKV), 0.5 * LORA_A ** -0.5),
        'rwkv_k_k': 0.85 + nrm(ks[20], (DEPTH, D_RWKV), 0.05),
        'rwkv_k_a': 1.0 + nrm(ks[21], (DEPTH, D_RWKV), 0.05),
        'rwkv_r_k': nrm(ks[22], (DEPTH, D_RWKV), 0.1),
        'rwkv_ln_g': 1.0 + nrm(ks[23], (DEPTH, D_RWKV), 0.05),
        'rwkv_ln_b': nrm(ks[24], (DEPTH, D_RWKV), 0.02),
    }


def reference(x_prompt, x_sample, state_pool, cache_swa_k, cache_swa_v, state_rwkv_shift, state_rwkv_wkv,
              norm_g, w_in, w_out, pool_w, pool_scale, q_norm_g, k_norm_g, attn_sinks,
              rwkv_mu, rwkv_w0, rwkv_w_up, rwkv_a0, rwkv_a_up, rwkv_k_k, rwkv_k_a, rwkv_r_k,
              rwkv_ln_g, rwkv_ln_b):
    Bp = x_prompt.shape[0]
    dt = x_prompt.dtype
    yp, ys = x_prompt, x_sample
    pool_p, pool_s, kp, ksmp, vp, vsmp, shp, shs, wkp, wks = [], [], [], [], [], [], [], [], [], []
    for l in range(DEPTH):
        p = {
            'norm_g': norm_g[l], 'w_in': w_in[l], 'w_out': w_out[l],
            'pool_w': pool_w[l], 'pool_scale': pool_scale[l],
            'q_g': q_norm_g[l], 'k_g': k_norm_g[l], 'sinks': attn_sinks[l],
            'mu': rwkv_mu[l], 'w0': rwkv_w0[l], 'w_up': rwkv_w_up[l], 'a0': rwkv_a0[l],
            'a_up': rwkv_a_up[l], 'k_k': rwkv_k_k[l], 'k_a': rwkv_k_a[l], 'r_k': rwkv_r_k[l],
            'ln_g': rwkv_ln_g[l], 'ln_b': rwkv_ln_b[l],
        }
        yp, (a1, b1, c1, d1, e1) = _layer(
            yp, 0,
            jnp.zeros((Bp, POOL_BUF, D_POOL), dt), None, None,
            jnp.zeros((Bp, D_SHIFT), dt),
            jnp.zeros((Bp, RWKV_HEADS, RWKV_HEAD, RWKV_HEAD), dt), p)
        ys, (a2, b2, c2, d2, e2) = _layer(
            ys, PAST_LEN, state_pool[l], cache_swa_k[l], cache_swa_v[l],
            state_rwkv_shift[l], state_rwkv_wkv[l], p)
        pool_p.append(a1); pool_s.append(a2)
        kp.append(b1); ksmp.append(b2)
        vp.append(c1); vsmp.append(c2)
        shp.append(d1); shs.append(d2)
        wkp.append(e1); wks.append(e2)
    return (yp, ys,
            jnp.stack(pool_p), jnp.stack(pool_s),
            jnp.stack(kp), jnp.stack(ksmp),
            jnp.stack(vp), jnp.stack(vsmp),
            jnp.stack(shp), jnp.stack(shs),
            jnp.stack(wkp), jnp.stack(wks))
```

```cpp
#include <hip/hip_runtime.h>
#include <hip/hip_cooperative_groups.h>
#include <cstdio>
#include <cstdint>
namespace cg = cooperative_groups;
namespace pg8 {
#define PG8_LAS __attribute__((address_space(3)))
typedef unsigned short bf16_t;
typedef short bf16x8 __attribute__((ext_vector_type(8)));
typedef float f32x4 __attribute__((ext_vector_type(4)));
typedef unsigned u32x4 __attribute__((ext_vector_type(4)));
constexpr int BM = 256, BK = 64, HALF = 128, HTB = HALF * BK * 2  , STAGE_BYTES = 8 * HTB, NXCD = 8, WGM = 8;

__host__ __device__ __forceinline__ int lds_byte(int r, int c) { const int st = (r >> 4) * 2 + (c >> 5), rr = r & 15, cc = c & 31, ob = rr * 64 + cc * 2; return st * 1024 + (ob ^ (((ob >> 9) & 1) << 5)); }
__host__ __device__ __forceinline__ void stage_rc(int b, int& R, int& C) { const int st = b / 1024, sb = b % 1024, swz = sb ^ (((sb >> 9) & 1) << 5); R = (st >> 1) * 16 + swz / 64; C = (st & 1) * 32 + (swz % 64) / 2; }
__host__ __device__ __forceinline__ int perm32(int rho) { const int n = rho >> 4, i = rho & 15; return 8 * (i >> 2) + 4 * n + (i & 3); }

struct Unit { int pm, pn; };
struct Gemm { const bf16_t* A; const bf16_t* Bt; int M, N, K; };

struct StaticOrder {
    int nM, nN, nwg, G, c;
    __host__ __device__ void init(int M, int N, int G_, int c_) { nM = M / BM; nN = N / BM; nwg = nM * nN; G = G_; c = c_; }
    __host__ __device__ bool next(int i, Unit& u) const {
        const long L = (long)i * G + c; if (L >= nwg) return false;
        int wgid = (int)L; { const int q = nwg / NXCD, r = nwg % NXCD, xcd = wgid % NXCD, off = wgid / NXCD; wgid = (xcd < r ? xcd * (q + 1) : r * (q + 1) + (xcd - r) * q) + off; }
        const int nig = WGM * nN, gid = wgid / nig, fm = gid * WGM, gsz = (nM - fm) < WGM ? (nM - fm) : WGM;
        u.pm = fm + ((wgid % nig) % gsz); u.pn = (wgid % nig) / gsz; return true;
    }
    __device__ __forceinline__ void a_ready(const Unit&) const {}
    __device__ __forceinline__ void done(const Unit&) const {}
};

template <class Epi, class Sched, bool STAMP = false>
__device__ __forceinline__ void gemm_phase(PG8_LAS unsigned char* lds, const Gemm g, const Sched& S, const Epi& E, unsigned long long* stamps) {
    int tid = threadIdx.x; asm volatile("" : "+v"(tid));
    const int wid = __builtin_amdgcn_readfirstlane(tid >> 6), lane = tid & 63, wr = wid >> 2, wc = wid & 3, fr = lane & 15, fq = lane >> 4;
    const int K = g.K, nt = K / BK;
    int ts_lo = 0, ts_hi = 0, nts = 0; const unsigned long long rt_entry = STAMP ? (unsigned long long)wall_clock64() : 0ull;
#define PG8_STAMP() do { if (STAMP && wid == 0 && nts < 64) { const unsigned long long _c = (unsigned long long)clock64(); \
        ts_lo = (lane == nts) ? (int)(unsigned)_c : ts_lo; ts_hi = (lane == nts) ? (int)(unsigned)(_c >> 32) : ts_hi; ++nts; } } while (0)
    PG8_STAMP();
    unsigned voffA[2], voffB[2];
#pragma unroll
    for (int i = 0; i < 2; ++i) { int R, C; stage_rc(tid * 16 + i * 8192, R, C); const int Rb = Epi::PERM ? ((R & ~31) + perm32(R & 31)) : R;
        voffA[i] = (unsigned)(R * K + C) * 2u; voffB[i] = (unsigned)(Rb * K + C) * 2u; }
    const size_t kstep = (size_t)(BK * 2);
    const size_t hstep = (size_t)HALF * K * 2;
    const size_t tstep = 2 * hstep;
    const unsigned ldsw = (unsigned)wid * 1024u;
    const int aoff = lds_byte(wr * 64 + fr, fq * 8), boff = lds_byte(wc * 32 + fr, fq * 8);
#define PG8_SA(b, h) (((b) * 2 + (h)) * HTB)
#define PG8_SB(b, h) ((4 + (b) * 2 + (h)) * HTB)
#define PG8_STAGE(bufoff, gbase, voff) do { _Pragma("unroll") for (int _i = 0; _i < 2; ++_i) \
        __builtin_amdgcn_global_load_lds((const unsigned*)((const char*)(gbase) + (voff)[_i]), (PG8_LAS unsigned*)(lds + (bufoff) + ldsw + _i * 8192), 16, 0, 0); } while (0)
#define PG8_LDA(dst, b, h) do { _Pragma("unroll") for (int m = 0; m < 4; ++m) _Pragma("unroll") for (int k = 0; k < 2; ++k) dst[m][k] = *(const PG8_LAS bf16x8*)(lds + PG8_SA(b, h) + aoff + m * 2048 + k * 1024); } while (0)
#define PG8_LDB(dst, b, h) do { _Pragma("unroll") for (int n = 0; n < 2; ++n) _Pragma("unroll") for (int k = 0; k < 2; ++k) dst[n][k] = *(const PG8_LAS bf16x8*)(lds + PG8_SB(b, h) + boff + n * 2048 + k * 1024); } while (0)
#define PG8_MMA(ai, bj, At, Bt) do { __builtin_amdgcn_s_setprio(1); _Pragma("unroll") for (int m = 0; m < 4; ++m) _Pragma("unroll") for (int n = 0; n < 2; ++n) _Pragma("unroll") for (int k = 0; k < 2; ++k) \
        acc[ai][bj][m][n] = __builtin_amdgcn_mfma_f32_16x16x32_bf16(Bt[n][k], At[m][k], acc[ai][bj][m][n], 0, 0, 0); __builtin_amdgcn_s_setprio(0); } while (0)
#define PG8_WAIT_V(n) asm volatile("s_waitcnt vmcnt(" #n ")" ::: "memory")
#define PG8_WAIT_L(n) asm volatile("s_waitcnt lgkmcnt(" #n ")" ::: "memory")
#define PG8_BAR __builtin_amdgcn_s_barrier()
#define PG8_SCHED __builtin_amdgcn_sched_barrier(0)
    Unit cur, nxt; int ui = 0;
    if (!S.next(0, cur)) return;
    f32x4 acc[2][2][4][2];
#pragma unroll
    for (int a = 0; a < 2; ++a)
#pragma unroll
        for (int b = 0; b < 2; ++b)
#pragma unroll
            for (int m = 0; m < 4; ++m)
#pragma unroll
                for (int n = 0; n < 2; ++n) acc[a][b][m][n] = (f32x4){0.f, 0.f, 0.f, 0.f};
    bf16x8 At[4][2], B0[2][2], B1[2][2];
    const char* cA = (const char*)g.A + (size_t)cur.pm * tstep; const char* cB = (const char*)g.Bt + (size_t)cur.pn * tstep;
    S.a_ready(cur);
    PG8_STAGE(PG8_SB(0, 0), cB, voffB); PG8_STAGE(PG8_SA(0, 0), cA, voffA); PG8_STAGE(PG8_SB(0, 1), cB + hstep, voffB); PG8_STAGE(PG8_SA(0, 1), cA + hstep, voffA);
    if (wr == 1) PG8_BAR;
    PG8_WAIT_V(4); PG8_BAR;
    PG8_STAGE(PG8_SB(1, 0), cB + kstep, voffB); PG8_STAGE(PG8_SA(1, 0), cA + kstep, voffA); PG8_STAGE(PG8_SB(1, 1), cB + hstep + kstep, voffB);
    PG8_WAIT_V(6); PG8_BAR;
    PG8_STAMP();
    for (;;) {
        const bool has_next = S.next(ui + 1, nxt);
        const char* nA = has_next ? (const char*)g.A + (size_t)nxt.pm * tstep : cA; const char* nB = has_next ? (const char*)g.Bt + (size_t)nxt.pn * tstep : cB;
        for (int t = 0; t < nt; t += 2) {
            const bool last = (t == nt - 2);
            const char* a1 = cA + (size_t)(t + 1) * kstep;
            const char* a2 = last ? nA : cA + (size_t)(t + 2) * kstep; const char* b2 = last ? nB : cB + (size_t)(t + 2) * kstep;
            const char* a3 = a2 + kstep; const char* b3 = b2 + kstep;
            if (last && has_next) S.a_ready(nxt);
            PG8_LDB(B0, 0, 0); PG8_SCHED; PG8_LDA(At, 0, 0); PG8_STAGE(PG8_SA(1, 1), a1 + hstep, voffA);
            PG8_WAIT_L(8); PG8_BAR; PG8_WAIT_L(0); PG8_MMA(0, 0, At, B0); PG8_BAR; PG8_SCHED;
            PG8_LDB(B1, 0, 1); PG8_STAGE(PG8_SB(0, 0), b2, voffB);
            PG8_BAR; PG8_WAIT_L(0); PG8_MMA(0, 1, At, B1); PG8_BAR;
            PG8_LDA(At, 0, 1); PG8_STAGE(PG8_SA(0, 0), a2, voffA);
            PG8_BAR; PG8_WAIT_L(0); PG8_MMA(1, 0, At, B0); PG8_BAR; PG8_SCHED;
            PG8_STAGE(PG8_SB(0, 1), b2 + hstep, voffB);
            PG8_WAIT_V(6); PG8_BAR; PG8_MMA(1, 1, At, B1); PG8_BAR;
            PG8_LDB(B0, 1, 0); PG8_SCHED; PG8_LDA(At, 1, 0); PG8_STAGE(PG8_SA(0, 1), a2 + hstep, voffA);
            PG8_WAIT_L(8); PG8_BAR; PG8_WAIT_L(0); PG8_MMA(0, 0, At, B0); PG8_BAR; PG8_SCHED;
            PG8_LDB(B1, 1, 1); PG8_STAGE(PG8_SB(1, 0), b3, voffB);
            PG8_BAR; PG8_WAIT_L(0); PG8_MMA(0, 1, At, B1); PG8_BAR;
            PG8_LDA(At, 1, 1); PG8_STAGE(PG8_SA(1, 0), a3, voffA);
            PG8_BAR; PG8_WAIT_L(0); PG8_MMA(1, 0, At, B0); PG8_BAR; PG8_SCHED;
            PG8_STAGE(PG8_SB(1, 1), b3 + hstep, voffB);
            PG8_WAIT_V(6); PG8_BAR; PG8_MMA(1, 1, At, B1); PG8_BAR;
        }
        PG8_STAMP();
        if constexpr (!Epi::AFTER_DRAIN) { E(acc, cur, wr, wc, fr, fq); S.done(cur); }
        PG8_STAMP();
        if (!has_next) break;
#pragma unroll
        for (int a = 0; a < 2; ++a)
#pragma unroll
            for (int b = 0; b < 2; ++b)
#pragma unroll
                for (int m = 0; m < 4; ++m)
#pragma unroll
                    for (int n = 0; n < 2; ++n) acc[a][b][m][n] = (f32x4){0.f, 0.f, 0.f, 0.f};
        cur = nxt; cA = nA; cB = nB; ++ui;
    }
    PG8_WAIT_V(0);
    if (wr == 0) PG8_BAR;
    PG8_BAR;
    if constexpr (Epi::AFTER_DRAIN) { E.fused(acc, cur, wr, wc, fr, fq, lds, wid, lane); S.done(cur); }
    PG8_STAMP();
    if (STAMP && wid == 0) { stamps[lane] = lane < nts ? (((unsigned long long)(unsigned)ts_hi << 32) | (unsigned)ts_lo) : 0ull;
        if (lane == 62) stamps[62] = rt_entry; if (lane == 63) stamps[63] = (unsigned long long)wall_clock64(); }
#undef PG8_STAMP
#undef PG8_SA
#undef PG8_SB
#undef PG8_STAGE
#undef PG8_LDA
#undef PG8_LDB
#undef PG8_MMA
#undef PG8_WAIT_V
#undef PG8_WAIT_L
#undef PG8_BAR
#undef PG8_SCHED
}
}

#define LAS __attribute__((address_space(3)))
typedef unsigned short bf16_t;
typedef short bf16x8 __attribute__((ext_vector_type(8)));
typedef float f32x2 __attribute__((ext_vector_type(2)));
typedef float f32x4 __attribute__((ext_vector_type(4)));
typedef float f32x16 __attribute__((ext_vector_type(16)));
typedef unsigned u32x2 __attribute__((ext_vector_type(2)));
typedef unsigned u32x4 __attribute__((ext_vector_type(4)));
typedef __bf16 bf2_t __attribute__((ext_vector_type(2)));
typedef _Float16 h2_t __attribute__((ext_vector_type(2)));

constexpr int DM = 1024, NB = 16, SEQ = 2048, MP = NB * SEQ, MS = 128, DIN = 2880, NPAD = 3072;
constexpr int DSH = 832, NLAYER = 2;
constexpr float LOG2E = 1.4426950408889634f;
constexpr float QSCALE = 0.125f * LOG2E;
constexpr size_t O_YP = 0, O_YS = 33554432, O_POOLP = 33685504, O_POOLS = 33808384, O_KP = 34791424, O_KS = 35315712,
                 O_VP = 39510016, O_VS = 40034304, O_SHP = 44228608, O_SHS = 44255232, O_WKP = 44468224, O_WKS = 44992512, O_END = 49186816;
constexpr size_t MiB = 1u << 20;
constexpr size_t WS_CTL = 0;
constexpr size_t WS_WIN = 1 * MiB;
constexpr size_t WS_WOUT = 13 * MiB;
constexpr size_t WS_ROPE = 17 * MiB;
constexpr size_t WS_XBS = 18 * MiB;
constexpr size_t WS_RSS = 18 * MiB + 512 * 1024;
constexpr size_t WS_MIXS = 19 * MiB;
constexpr size_t WS_ZS = 20 * MiB;
constexpr size_t WS_RS = 22 * MiB;
constexpr size_t WS_RKR = 24 * MiB;
constexpr size_t WS_PRM = 25 * MiB;
constexpr int PRM_POOLW = 0, PRM_POOLSC = 32768, PRM_QG = 33280, PRM_KG = 33408, PRM_SINK = 33536, PRM_MU = 33552, PRM_W0 = 35216, PRM_WUP = 35728,
              PRM_A0 = 52112, PRM_AUP = 52624, PRM_KK = 69008, PRM_KA = 69520, PRM_RK = 70032, PRM_LNG = 70544, PRM_LNB = 71056, PRM_END = 71568;
#define PRM(off) ((const float*)(ws + WS_PRM) + (off))
constexpr size_t WS_XB = 32 * MiB;
constexpr size_t WS_U = 96 * MiB;
constexpr size_t WS_Q = 112 * MiB;
constexpr size_t WS_K = 144 * MiB;
constexpr size_t WS_VT = 152 * MiB;
constexpr size_t WS_RIN = 160 * MiB;
constexpr size_t WS_GM = 216 * MiB;
constexpr size_t WS_PA = 280 * MiB;
constexpr size_t WS_PW = 344 * MiB;
constexpr size_t WS_PV = 376 * MiB;
constexpr size_t WS_ORAW = 408 * MiB;
constexpr size_t WS_END = 440 * MiB;

struct Params {
    const float* in[25];
    float* out;
    unsigned char* ws;
    int ph_lo, ph_hi;
};

__device__ __forceinline__ unsigned pk_bf16(float lo, float hi) { f32x2 v = {lo, hi}; bf2_t b = __builtin_convertvector(v, bf2_t); return __builtin_bit_cast(unsigned, b); }
__device__ __forceinline__ h2_t as_h2(unsigned u) { return __builtin_bit_cast(h2_t, u); }
__device__ __forceinline__ unsigned pk_f16(float lo, float hi) { h2_t h = {(_Float16)lo, (_Float16)hi}; return __builtin_bit_cast(unsigned, h); }
__device__ __forceinline__ float bf_lo(unsigned u) { return __uint_as_float(u << 16); }
__device__ __forceinline__ float bf_hi(unsigned u) { return __uint_as_float(u & 0xffff0000u); }
__device__ __forceinline__ float bf1(bf16_t b) { return __uint_as_float(((unsigned)b) << 16); }
__device__ __forceinline__ bf16_t f2bf(float f) { return (bf16_t)(pk_bf16(f, 0.f) & 0xffffu); }
__device__ __forceinline__ float fast_exp(float x) { return __builtin_amdgcn_exp2f(x * LOG2E); }
__device__ __forceinline__ float sigmoidf_(float x) { return __builtin_amdgcn_rcpf(1.0f + fast_exp(-x)); }
__device__ __forceinline__ float siluf_(float x) { return x * sigmoidf_(x); }
__device__ __forceinline__ float wave_sum(float v) {
#pragma unroll
    for (int o = 1; o < 64; o <<= 1) v += __shfl_xor(v, o);
    return v;
}
__device__ __forceinline__ float wave_max(float v) {
#pragma unroll
    for (int o = 1; o < 64; o <<= 1) v = fmaxf(v, __shfl_xor(v, o));
    return v;
}
__device__ __forceinline__ float sum16(float v) {
    v += __shfl_xor(v, 1); v += __shfl_xor(v, 2); v += __shfl_xor(v, 4); v += __shfl_xor(v, 8); return v;
}
__device__ __forceinline__ void store8_bf16(bf16_t* p, f32x4 a, f32x4 b) {
    u32x4 w; w.x = pk_bf16(a[0], a[1]); w.y = pk_bf16(a[2], a[3]); w.z = pk_bf16(b[0], b[1]); w.w = pk_bf16(b[2], b[3]);
    *(u32x4*)p = w;
}

__host__ __device__ __forceinline__ int src_col_in(int n) {
    const int pn = n >> 8, p = n & 255, bj = p >> 7, wc = (p >> 5) & 3, j = p & 31, nn = j >> 4, fq = (j >> 2) & 3, e = j & 3;
    const int i8 = 8 * fq + 4 * nn + e;
    const int gen = 128 * bj + 32 * wc + i8;
    const int hd = 64 * wc + 32 * bj + i8;
    switch (pn) {
        case 0: return gen;
        case 1: return 256 + gen;
        case 2: return 512 + hd;
        case 3: return 768 + hd;
        case 4: return 1024 + hd;
        case 5: return 1280 + gen;
        case 6: return 1536 + gen;
        case 7: return 1792 + gen;
        case 8: return 2048 + gen;
        case 9: return 2304 + gen;
        case 10: return 2624 + gen;
        default: return gen < 64 ? 2560 + gen : -1;
    }
}
__host__ __device__ __forceinline__ int src_col_out(int n) {
    const int pn = n >> 8, p = n & 255, bj = p >> 7, wc = (p >> 5) & 3, j = p & 31, nn = j >> 4, fq = (j >> 2) & 3, e = j & 3;
    return pn * 256 + 128 * bj + 32 * wc + 8 * fq + 4 * nn + e;
}

struct EpiIn {
    static constexpr bool PERM = false, AFTER_DRAIN = false;
    unsigned char* ws; float* out; const float* qg; const float* kg; int layer;
    __device__ __forceinline__ void operator()(const f32x4 (&acc)[2][2][4][2], const pg8::Unit& u, int wr, int wc, int fr, int fq) const {
        const int pn = u.pn;
        const int row0 = u.pm * 256 + wr * 64 + fr;
        const int i8 = 8 * fq;
        const float* RS = (const float*)(ws + WS_RS);
#pragma unroll
        for (int ai = 0; ai < 2; ++ai)
#pragma unroll
            for (int m = 0; m < 4; ++m) {
                const int r = row0 + ai * 128 + m * 16;
                const int t = r & (SEQ - 1), b = r >> 11;
                float ri;
                { const f32x4* rp = (const f32x4*)(RS + (size_t)r * 16); const f32x4 a0 = rp[0], a1 = rp[1], a2 = rp[2], a3 = rp[3];
                  const float ss = ((a0[0] + a0[1]) + (a0[2] + a0[3])) + ((a1[0] + a1[1]) + (a1[2] + a1[3])) + ((a2[0] + a2[1]) + (a2[2] + a2[3])) + ((a3[0] + a3[1]) + (a3[2] + a3[3]));
                  ri = 1.0f / sqrtf(ss * (1.0f / 1024.0f) + 1e-6f); }
                if (pn == 0) {
                    bf16_t* p = (bf16_t*)(ws + WS_U) + (size_t)r * 256 + 32 * wc + i8;
                    float* o = out + (long)O_POOLP + (((long)layer * NB + b) * 15 + (t - (SEQ - 15))) * 256 + 32 * wc + i8;
#pragma unroll
                    for (int bj = 0; bj < 2; ++bj) { const f32x4 v0 = acc[ai][bj][m][0] * ri, v1 = acc[ai][bj][m][1] * ri;
                        store8_bf16(p + 128 * bj, v0, v1);
                        if (t >= SEQ - 15) { *(f32x4*)(o + 128 * bj) = v0; *(f32x4*)(o + 128 * bj + 4) = v1; } }
                } else if (pn == 1 || pn == 5 || pn == 6 || pn == 10) {
                    const int cbase = (pn == 1) ? 0 : (pn == 5) ? 256 : (pn == 6) ? 512 : 768;
                    bf16_t* p = (bf16_t*)(ws + WS_GM) + (size_t)r * 1024 + cbase + 32 * wc + i8;
#pragma unroll
                    for (int bj = 0; bj < 2; ++bj) { f32x4 v0 = acc[ai][bj][m][0] * ri, v1 = acc[ai][bj][m][1] * ri;
#pragma unroll
                        for (int e = 0; e < 4; ++e) { v0[e] = siluf_(v0[e]); v1[e] = siluf_(v1[e]); }
                        store8_bf16(p + 128 * bj, v0, v1); }
                } else if (pn >= 7 && pn <= 9) {
                    const int cbase = (pn - 7) * 256 + 32 * wc + i8;
                    bf16_t* p = (bf16_t*)(ws + WS_RIN) + (size_t)r * DSH + cbase;
                    float* o = out + O_SHP + ((size_t)layer * NB + b) * DSH + cbase;
#pragma unroll
                    for (int bj = 0; bj < 2; ++bj) { const f32x4 v0 = acc[ai][bj][m][0] * ri, v1 = acc[ai][bj][m][1] * ri;
                        store8_bf16(p + 128 * bj, v0, v1);
                        if (t == SEQ - 1) { *(f32x4*)(o + 128 * bj) = v0; *(f32x4*)(o + 128 * bj + 4) = v1; } }
                } else if (pn == 11) {
                    if (wc < 2) { const int cbase = 768 + 32 * wc + i8;
                        const f32x4 v0 = acc[ai][0][m][0] * ri, v1 = acc[ai][0][m][1] * ri;
                        store8_bf16((bf16_t*)(ws + WS_RIN) + (size_t)r * DSH + cbase, v0, v1);
                        if (t == SEQ - 1) { float* o = out + O_SHP + ((size_t)layer * NB + b) * DSH + cbase; *(f32x4*)o = v0; *(f32x4*)(o + 4) = v1; } }
                } else if (pn == 4 && wc >= 2) {
                    const int h = wc - 2;
                    bf16_t* vt = (bf16_t*)(ws + WS_VT) + ((size_t)(b * 2 + h) * 64) * SEQ + t;
                    float* o = out + (long)O_VP + ((((long)layer * NB + b) * 128 + (t - (SEQ - 128))) * 2 + h) * 64 + i8;
#pragma unroll
                    for (int bj = 0; bj < 2; ++bj) { const f32x4 v0 = acc[ai][bj][m][0] * ri, v1 = acc[ai][bj][m][1] * ri;
#pragma unroll
                        for (int e = 0; e < 4; ++e) { vt[(size_t)(32 * bj + i8 + e) * SEQ] = f2bf(v0[e]); vt[(size_t)(32 * bj + i8 + 4 + e) * SEQ] = f2bf(v1[e]); }
                        if (t >= SEQ - 128) { *(f32x4*)(o + 32 * bj) = v0; *(f32x4*)(o + 32 * bj + 4) = v1; } }
                } else {
                    float ss = 0.f;
#pragma unroll
                    for (int bj = 0; bj < 2; ++bj)
#pragma unroll
                        for (int nn = 0; nn < 2; ++nn) { const f32x4 v = acc[ai][bj][m][nn]; ss += (v[0] * v[0] + v[1] * v[1]) + (v[2] * v[2] + v[3] * v[3]); }
                    ss += __shfl_xor(ss, 16); ss += __shfl_xor(ss, 32);
                    ss *= ri * ri;
                    float sc = ri / sqrtf(ss * (1.0f / 64.0f) + 1e-6f);
                    const float* g = (pn == 4) ? kg : qg;
                    const f32x4* cs = (const f32x4*)((const f32x2*)(ws + WS_ROPE) + (size_t)t * 32 + i8);
                    bf16_t* pq = (pn == 4) ? (bf16_t*)(ws + WS_K) + (size_t)r * 128 + wc * 64 + i8 : (bf16_t*)(ws + WS_Q) + (size_t)r * 512 + ((pn - 2) * 4 + wc) * 64 + i8;
                    float* o = out + (long)O_KP + ((((long)layer * NB + b) * 128 + (t - (SEQ - 128))) * 2 + wc) * 64 + i8;
                    const float osc = (pn == 4) ? 1.0f : QSCALE;
                    f32x4 lo[2], hi[2];
#pragma unroll
                    for (int nn = 0; nn < 2; ++nn) {
                        const f32x4 gl = *(const f32x4*)(g + i8 + 4 * nn), gh = *(const f32x4*)(g + 32 + i8 + 4 * nn);
                        const f32x4 a = acc[ai][0][m][nn] * sc * gl, bq = acc[ai][1][m][nn] * sc * gh; const f32x4 c0 = cs[2 * nn], c1 = cs[2 * nn + 1];
                        lo[nn][0] = a[0] * c0[0] - bq[0] * c0[1]; hi[nn][0] = a[0] * c0[1] + bq[0] * c0[0];
                        lo[nn][1] = a[1] * c0[2] - bq[1] * c0[3]; hi[nn][1] = a[1] * c0[3] + bq[1] * c0[2];
                        lo[nn][2] = a[2] * c1[0] - bq[2] * c1[1]; hi[nn][2] = a[2] * c1[1] + bq[2] * c1[0];
                        lo[nn][3] = a[3] * c1[2] - bq[3] * c1[3]; hi[nn][3] = a[3] * c1[3] + bq[3] * c1[2];
                    }
                    if (pn == 4 && t >= SEQ - 128) { *(f32x4*)o = lo[0]; *(f32x4*)(o + 4) = lo[1]; *(f32x4*)(o + 32) = hi[0]; *(f32x4*)(o + 36) = hi[1]; }
                    store8_bf16(pq, lo[0] * osc, lo[1] * osc); store8_bf16(pq + 32, hi[0] * osc, hi[1] * osc);
                }
                asm volatile("" ::: "memory");
            }
    }
};

struct EpiOut {
    static constexpr bool PERM = false, AFTER_DRAIN = false;
    const float* resid; float* out; bf16_t* XB; float* RS;
    __device__ __forceinline__ void operator()(const f32x4 (&acc)[2][2][4][2], const pg8::Unit& u, int wr, int wc, int fr, int fq) const {
        const int row0 = u.pm * 256 + wr * 64 + fr;
        const int cb = u.pn * 256 + 32 * wc + 8 * fq;
#pragma unroll
        for (int ai = 0; ai < 2; ++ai)
#pragma unroll
            for (int m = 0; m < 4; ++m) {
                const int r = row0 + ai * 128 + m * 16;
                const size_t off = (size_t)r * DM + cb;
                float ss = 0.f;
#pragma unroll
                for (int bj = 0; bj < 2; ++bj) {
                    const f32x4 r0 = *(const f32x4*)(resid + off + bj * 128), r1 = *(const f32x4*)(resid + off + bj * 128 + 4);
                    const f32x4 y0 = acc[ai][bj][m][0] + r0, y1 = acc[ai][bj][m][1] + r1;
                    *(f32x4*)(out + off + bj * 128) = y0; *(f32x4*)(out + off + bj * 128 + 4) = y1;
                    if (XB) { store8_bf16(XB + off + bj * 128, y0, y1);
#pragma unroll
                        for (int e = 0; e < 4; ++e) ss += y0[e] * y0[e] + y1[e] * y1[e]; }
                }
                if (XB) { ss += __shfl_xor(ss, 16); ss += __shfl_xor(ss, 32); if (fq == 0) RS[(size_t)r * 16 + u.pn * 4 + wc] = ss; }
            }
    }
};

__device__ __forceinline__ void p0_transpose_item(const float* W, int ldw, const float* g, bf16_t* WT, LAS float* scr, int item, int nblk, bool is_in, int lane) {
    const int kb = item / nblk, nb = item % nblk, k0 = 64 * kb, n0 = 32 * nb;
    const int sc = is_in ? src_col_in(n0 + (lane & 31)) : src_col_out(n0 + (lane & 31));
#pragma unroll 8
    for (int i = 0; i < 32; ++i) { const int kk = 2 * i + (lane >> 5); float v = 0.f;
        if (sc >= 0) { v = W[(size_t)(k0 + kk) * ldw + sc]; if (g) v *= g[k0 + kk]; }
        scr[kk * 33 + (lane & 31)] = v; }
    asm volatile("s_waitcnt lgkmcnt(0)" ::: "memory");
    const int c = lane & 7;
#pragma unroll
    for (int j = 0; j < 4; ++j) { const int n = (lane >> 3) + 8 * j; const LAS float* s = scr + (8 * c) * 33 + n;
        u32x4 o; o.x = pk_bf16(s[0 * 33], s[1 * 33]); o.y = pk_bf16(s[2 * 33], s[3 * 33]); o.z = pk_bf16(s[4 * 33], s[5 * 33]); o.w = pk_bf16(s[6 * 33], s[7 * 33]);
        *(u32x4*)(WT + (size_t)(n0 + n) * DM + k0 + 8 * c) = o; }
    asm volatile("s_waitcnt lgkmcnt(0)" ::: "memory");
}
__device__ __forceinline__ float row_to_bf16(const float* xrow, bf16_t* orow, int lane) {
    const f32x4* xr = (const f32x4*)xrow + lane;
    f32x4 v[4]; float s = 0.f;
#pragma unroll
    for (int j = 0; j < 4; ++j) { v[j] = xr[64 * j]; s += (v[j][0] * v[j][0] + v[j][1] * v[j][1]) + (v[j][2] * v[j][2] + v[j][3] * v[j][3]); }
    u32x2* o8 = (u32x2*)orow + lane;
#pragma unroll
    for (int j = 0; j < 4; ++j) { u32x2 w; w.x = pk_bf16(v[j][0], v[j][1]); w.y = pk_bf16(v[j][2], v[j][3]); o8[64 * j] = w; }
    return wave_sum(s);
}
__device__ __forceinline__ void p0_prologue(const Params& P, LAS unsigned char* lds, int G, int tid, int wid, int lane) {
    unsigned char* ws = P.ws;
    LAS float* scr = (LAS float*)(lds + wid * 16384);
    const int gw = blockIdx.x * 8 + wid, NGW = G * 8;
    constexpr int I_IN = 16 * 96, I_OUT = 16 * 32, NITEMS = 2 * I_IN + 2 * I_OUT;
    for (int it = gw; it < NITEMS; it += NGW) {
        int r = it;
        if (r < 2 * I_IN) { const int l = r / I_IN; r -= l * I_IN;
            p0_transpose_item(P.in[8] + (size_t)l * DM * DIN, DIN, P.in[7] + l * DM, (bf16_t*)(ws + WS_WIN) + (size_t)l * NPAD * DM, scr, r, 96, true, lane); continue; }
        r -= 2 * I_IN; { const int l = r / I_OUT; r -= l * I_OUT;
            p0_transpose_item(P.in[9] + (size_t)l * DM * DM, DM, nullptr, (bf16_t*)(ws + WS_WOUT) + (size_t)l * DM * DM, scr, r, 32, false, lane); }
    }
#define P0_COPY(idx, off, n) for (int e = blockIdx.x * 512 + tid; e < (n); e += G * 512) ((float*)(ws + WS_PRM))[(off) + e] = P.in[idx][e];
    P0_COPY(10, PRM_POOLW, 32768) P0_COPY(11, PRM_POOLSC, 512) P0_COPY(12, PRM_QG, 128) P0_COPY(13, PRM_KG, 128) P0_COPY(14, PRM_SINK, 16) P0_COPY(15, PRM_MU, 1664)
    P0_COPY(16, PRM_W0, 512) P0_COPY(17, PRM_WUP, 16384) P0_COPY(18, PRM_A0, 512) P0_COPY(19, PRM_AUP, 16384) P0_COPY(20, PRM_KK, 512) P0_COPY(21, PRM_KA, 512)
    P0_COPY(22, PRM_RK, 512) P0_COPY(23, PRM_LNG, 512) P0_COPY(24, PRM_LNB, 512)
    for (int e = blockIdx.x * 512 + tid; e < 2049 * 32; e += G * 512) {
        const int pi = e >> 5, i = e & 31; const int pos = pi < 2048 ? pi : 16384;
        const float fr = (float)pow(10000.0, -(double)i / 32.0);
        const float ang = (float)pos * fr;
        f32x2 cs; cs.x = (float)cos((double)ang); cs.y = (float)sin((double)ang);
        ((f32x2*)(ws + WS_ROPE))[e] = cs;
    }
    for (int m = gw; m < MP + MS; m += NGW) {
        if (m < MP) { const float s = row_to_bf16(P.in[0] + (size_t)m * DM, (bf16_t*)(ws + WS_XB) + (size_t)m * DM, lane);
            if (lane < 16) ((float*)(ws + WS_RS))[(size_t)m * 16 + lane] = lane == 0 ? s : 0.f; }
        else { const int ms = m - MP; const float s = row_to_bf16(P.in[1] + (size_t)ms * DM, (bf16_t*)(ws + WS_XBS) + (size_t)ms * DM, lane);
            ((float*)(ws + WS_RSS))[ms * 64 + lane] = lane == 0 ? s : 0.f; }
    }
}

template <bool IS_IN>
__device__ __forceinline__ void skinny_unit(const Params& P, int layer, int unit, int wid, int lane) {
    unsigned char* ws = P.ws;
    const bf16_t* A = IS_IN ? (const bf16_t*)(ws + WS_XBS) : (const bf16_t*)(ws + WS_MIXS);
    const bf16_t* Bt = IS_IN ? (const bf16_t*)(ws + WS_WIN) + (size_t)layer * NPAD * DM : (const bf16_t*)(ws + WS_WOUT) + (size_t)layer * DM * DM;
    const int n0 = unit * 16, r16 = lane & 15, kq = lane >> 4;
    const bf16x8* ap = (const bf16x8*)(A + (size_t)(16 * wid + r16) * DM + 8 * kq);
    const bf16x8* bp = (const bf16x8*)(Bt + (size_t)(n0 + r16) * DM + 8 * kq);
    f32x4 acc = {0.f, 0.f, 0.f, 0.f};
#pragma unroll 8
    for (int kk = 0; kk < 32; ++kk) acc = __builtin_amdgcn_mfma_f32_16x16x32_bf16(ap[kk * 4], bp[kk * 4], acc, 0, 0, 0);
    const int n = n0 + r16;
    if (IS_IN) {
        float rv = 0.f;
        const float* RSS = (const float*)(ws + WS_RSS);
        for (int rr = 0; rr < 16; ++rr) { const float s = wave_sum(RSS[(16 * wid + rr) * 64 + lane]); if (lane == rr) rv = 1.0f / sqrtf(s * (1.0f / 1024.0f) + 1e-6f); }
        const int lc = src_col_in(n);
        float* ZS = (float*)(ws + WS_ZS);
#pragma unroll
        for (int reg = 0; reg < 4; ++reg) { const float ri = __shfl(rv, 4 * kq + reg); if (lc >= 0) ZS[(size_t)(16 * wid + 4 * kq + reg) * DIN + lc] = acc[reg] * ri; }
    } else {
        const int lc = src_col_out(n);
        const float* resid = layer == 0 ? P.in[1] : P.out + O_YS;
        float* out = P.out + O_YS;
        bf16_t* XBS = (bf16_t*)(ws + WS_XBS); float* RSS = (float*)(ws + WS_RSS);
#pragma unroll
        for (int reg = 0; reg < 4; ++reg) { const int row = 16 * wid + 4 * kq + reg;
            const float y = resid[(size_t)row * DM + lc] + acc[reg];
            out[(size_t)row * DM + lc] = y;
            if (layer == 0) { XBS[(size_t)row * DM + lc] = f2bf(y); const float s = sum16(y * y); if (r16 == 0) RSS[row * 64 + unit] = s; } }
    }
}

__device__ __forceinline__ void pool_unit(const Params& P, int layer, int unit, LAS unsigned char* lds, int wid, int lane) {
    unsigned char* ws = P.ws;
    const bf16_t* U = (const bf16_t*)(ws + WS_U); bf16_t* GM = (bf16_t*)(ws + WS_GM);
    const int b = unit >> 4, chunk = unit & 15, g = wid & 3, half = wid >> 2;
    const int t0 = chunk * 128 + half * 64, W_ = 2 << g;
    const float* pw = PRM(PRM_POOLW) + ((size_t)(layer * 4 + g) * 64) * 64;
    float wreg[64];
#pragma unroll
    for (int c = 0; c < 64; ++c) wreg[c] = pw[c * 64 + lane];
    const float scale = PRM(PRM_POOLSC)[layer * 256 + 64 * g + lane];
    LAS float* sc = (LAS float*)(lds + wid * 1024);
    const bf16_t* ub = U + ((size_t)b * SEQ) * 256 + 64 * g + lane;
    float win = 0.f;
    for (int j = 1; j < W_; ++j) { const int tt = t0 - j; if (tt >= 0) win += bf1(ub[(size_t)tt * 256]); }
    for (int tq = 0; tq < 64; tq += 4) {
#pragma unroll
        for (int q = 0; q < 4; ++q) { const int t = t0 + tq + q;
            const float ut = bf1(ub[(size_t)t * 256]); win += ut;
            const int cnt = (t + 1) < W_ ? (t + 1) : W_;
            sc[q * 64 + lane] = win / (float)cnt - ut;
            if (t - W_ + 1 >= 0) win -= bf1(ub[(size_t)(t - W_ + 1) * 256]); }
        asm volatile("s_waitcnt lgkmcnt(0)" ::: "memory");
        float a4[4] = {0.f, 0.f, 0.f, 0.f};
#pragma unroll
        for (int c4 = 0; c4 < 16; ++c4) {
#pragma unroll
            for (int q = 0; q < 4; ++q) { const f32x4 pv = *(const LAS f32x4*)(sc + q * 64 + 4 * c4);
                a4[q] += pv[0] * wreg[4 * c4] + pv[1] * wreg[4 * c4 + 1] + pv[2] * wreg[4 * c4 + 2] + pv[3] * wreg[4 * c4 + 3]; } }
        asm volatile("s_waitcnt lgkmcnt(0)" ::: "memory");
#pragma unroll
        for (int q = 0; q < 4; ++q) { bf16_t* gp = GM + ((size_t)b * SEQ + t0 + tq + q) * 1024 + 64 * g + lane; *gp = f2bf(a4[q] * scale * bf1(*gp)); }
    }
}

constexpr int KS_STRIDE = 144, VS_STRIDE = 520, ATT_VOFF = 256 * KS_STRIDE;
__device__ __forceinline__ void attn_unit(const Params& P, int layer, int unit, LAS unsigned char* lds, int tid, int wid, int lane) {
    unsigned char* ws = P.ws;
    const bf16_t* Q = (const bf16_t*)(ws + WS_Q); const bf16_t* K = (const bf16_t*)(ws + WS_K); const bf16_t* VT = (const bf16_t*)(ws + WS_VT);
    bf16_t* GM = (bf16_t*)(ws + WS_GM);
    const int kvh = unit & 1, n = (unit >> 1) & 15, b = unit >> 5;
    const int tk0 = n * 128 - 128;
#pragma unroll
    for (int i = 0; i < 4; ++i) { const int idx = tid + 512 * i; const int row = idx >> 3, c = idx & 7; const int t = tk0 + row;
        u32x4 v = {0u, 0u, 0u, 0u}; if (t >= 0) v = *(const u32x4*)(K + ((size_t)b * SEQ + t) * 128 + kvh * 64 + c * 8);
        *(LAS u32x4*)(lds + row * KS_STRIDE + c * 16) = v; }
#pragma unroll
    for (int i = 0; i < 4; ++i) { const int idx = tid + 512 * i; const int d = idx >> 5, c = idx & 31; const int t = tk0 + 8 * c;
        u32x4 v = {0u, 0u, 0u, 0u}; if (t >= 0) v = *(const u32x4*)(VT + ((size_t)(b * 2 + kvh) * 64 + d) * SEQ + t);
        LAS u32x2* dst = (LAS u32x2*)(lds + ATT_VOFF + d * VS_STRIDE + c * 16); dst[0] = (u32x2){v.x, v.y}; dst[1] = (u32x2){v.z, v.w}; }
    __syncthreads();
    const int hq = wid >> 1, qh = wid & 1, head = kvh * 4 + hq;
    const int r31 = lane & 31, h = lane >> 5;
    const float sink2 = PRM(PRM_SINK)[layer * 8 + head] * LOG2E;
#pragma unroll 1
    for (int qb2 = 0; qb2 < 2; ++qb2) {
        const int qb = 2 * qh + qb2, i0 = 32 * qb;
        const bf16_t* qp = Q + ((size_t)b * SEQ + n * 128 + i0 + r31) * 512 + head * 64 + 8 * h;
        bf16x8 qf[4];
#pragma unroll
        for (int ks = 0; ks < 4; ++ks) qf[ks] = *(const bf16x8*)(qp + 16 * ks);
        f32x16 s[5];
#pragma unroll
        for (int kt = 0; kt < 5; ++kt) {
#pragma unroll
            for (int e = 0; e < 16; ++e) s[kt][e] = 0.f;
            const LAS unsigned char* kb = lds + (32 * (qb + kt) + r31) * KS_STRIDE + 16 * h;
#pragma unroll
            for (int ks = 0; ks < 4; ++ks) { const bf16x8 a = *(const LAS bf16x8*)(kb + 32 * ks); s[kt] = __builtin_amdgcn_mfma_f32_32x32x16_bf16(a, qf[ks], s[kt], 0, 0, 0); }
        }
        const int qi = 128 + i0 + r31;
        float mx = sink2;
#pragma unroll
        for (int kt = 0; kt < 5; ++kt)
#pragma unroll
            for (int e = 0; e < 16; ++e) { const int kidx = 32 * (qb + kt) + (e & 3) + 8 * (e >> 2) + 4 * h;
                const bool valid = (kidx <= qi) && (kidx + 127 >= qi) && (n > 0 || kidx >= 128);
                s[kt][e] = valid ? s[kt][e] : -INFINITY; mx = fmaxf(mx, s[kt][e]); }
        mx = fmaxf(mx, __shfl_xor(mx, 32));
        float sum = 0.f;
#pragma unroll
        for (int kt = 0; kt < 5; ++kt)
#pragma unroll
            for (int e = 0; e < 16; ++e) { const float p = __builtin_amdgcn_exp2f(s[kt][e] - mx); s[kt][e] = p; sum += p; }
        sum += __shfl_xor(sum, 32);
        const float inv = 1.0f / (sum + __builtin_amdgcn_exp2f(sink2 - mx));
        f32x16 o[2];
#pragma unroll
        for (int e = 0; e < 16; ++e) { o[0][e] = 0.f; o[1][e] = 0.f; }
#pragma unroll
        for (int kt = 0; kt < 5; ++kt)
#pragma unroll
            for (int s2 = 0; s2 < 2; ++s2) {
                u32x4 pw; pw.x = pk_bf16(s[kt][8 * s2 + 0] * inv, s[kt][8 * s2 + 1] * inv); pw.y = pk_bf16(s[kt][8 * s2 + 2] * inv, s[kt][8 * s2 + 3] * inv);
                pw.z = pk_bf16(s[kt][8 * s2 + 4] * inv, s[kt][8 * s2 + 5] * inv); pw.w = pk_bf16(s[kt][8 * s2 + 6] * inv, s[kt][8 * s2 + 7] * inv);
                const bf16x8 pf = __builtin_bit_cast(bf16x8, pw);
#pragma unroll
                for (int db = 0; db < 2; ++db) {
                    const LAS unsigned char* vb = lds + ATT_VOFF + (32 * db + r31) * VS_STRIDE + (32 * (qb + kt) + 16 * s2 + 4 * h) * 2;
                    const u32x2 v0 = *(const LAS u32x2*)vb, v1 = *(const LAS u32x2*)(vb + 16);
                    const u32x4 vw = {v0.x, v0.y, v1.x, v1.y};
                    o[db] = __builtin_amdgcn_mfma_f32_32x32x16_bf16(pf, __builtin_bit_cast(bf16x8, vw), o[db], 0, 0, 0);
                }
            }
#pragma unroll
        for (int db = 0; db < 2; ++db)
#pragma unroll
            for (int e = 0; e < 16; ++e) { const int q = i0 + (e & 3) + 8 * (e >> 2) + 4 * h;
                bf16_t* gp = GM + ((size_t)b * SEQ + n * 128 + q) * 1024 + 256 + head * 64 + 32 * db + r31; *gp = f2bf(o[db][e] * bf1(*gp)); }
    }
    __syncthreads();
}

__device__ __forceinline__ float tanhf_(float x) { const float e = fast_exp(2.0f * x); return 1.0f - 2.0f * __builtin_amdgcn_rcpf(e + 1.0f); }
__device__ __forceinline__ void prep_token(const Params& P, int layer, int r, int lane) {
    unsigned char* ws = P.ws;
    const bf16_t* RIN = (const bf16_t*)(ws + WS_RIN);
    const int b = r >> 11, t = r & (SEQ - 1), c0 = 4 * lane, hh = lane >> 4;
    const bf16_t* cur = RIN + (size_t)r * DSH; const bf16_t* prv = cur - DSH; const bool hp = t > 0;
    const float* mu = PRM(PRM_MU) + layer * DSH;
    float rs[4], ks[4], vs[4];
    { const u32x2 cr = *(const u32x2*)(cur + c0), ck = *(const u32x2*)(cur + 256 + c0), cv = *(const u32x2*)(cur + 512 + c0);
      u32x2 pr = {0u, 0u}, pk = {0u, 0u}, pv = {0u, 0u};
      if (hp) { pr = *(const u32x2*)(prv + c0); pk = *(const u32x2*)(prv + 256 + c0); pv = *(const u32x2*)(prv + 512 + c0); }
      const f32x4 mr = *(const f32x4*)(mu + c0), mk = *(const f32x4*)(mu + 256 + c0), mv = *(const f32x4*)(mu + 512 + c0);
      const float xr[4] = {bf_lo(cr.x), bf_hi(cr.x), bf_lo(cr.y), bf_hi(cr.y)}, yr[4] = {bf_lo(pr.x), bf_hi(pr.x), bf_lo(pr.y), bf_hi(pr.y)};
      const float xk[4] = {bf_lo(ck.x), bf_hi(ck.x), bf_lo(ck.y), bf_hi(ck.y)}, yk[4] = {bf_lo(pk.x), bf_hi(pk.x), bf_lo(pk.y), bf_hi(pk.y)};
      const float xv[4] = {bf_lo(cv.x), bf_hi(cv.x), bf_lo(cv.y), bf_hi(cv.y)}, yv[4] = {bf_lo(pv.x), bf_hi(pv.x), bf_lo(pv.y), bf_hi(pv.y)};
#pragma unroll
      for (int i = 0; i < 4; ++i) { rs[i] = xr[i] + (yr[i] - xr[i]) * mr[i]; ks[i] = xk[i] + (yk[i] - xk[i]) * mk[i]; vs[i] = xv[i] + (yv[i] - xv[i]) * mv[i]; } }
    float lv;
    { const float x = bf1(cur[768 + lane]); const float y = hp ? bf1(prv[768 + lane]) : 0.f; const float xs = x + (y - x) * mu[768 + lane]; lv = lane < 32 ? tanhf_(xs) : xs; }
    float lw[4] = {0.f, 0.f, 0.f, 0.f}, la[4] = {0.f, 0.f, 0.f, 0.f};
    const float* wup = PRM(PRM_WUP) + (size_t)layer * 32 * 256 + c0; const float* aup = PRM(PRM_AUP) + (size_t)layer * 32 * 256 + c0;
#pragma unroll 8
    for (int j = 0; j < 32; ++j) {
        const float sw = __builtin_bit_cast(float, __builtin_amdgcn_readlane(__builtin_bit_cast(int, lv), j));
        const float sa = __builtin_bit_cast(float, __builtin_amdgcn_readlane(__builtin_bit_cast(int, lv), 32 + j));
        const f32x4 wu = *(const f32x4*)(wup + j * 256), au = *(const f32x4*)(aup + j * 256);
#pragma unroll
        for (int i = 0; i < 4; ++i) { lw[i] += sw * wu[i]; la[i] += sa * au[i]; }
    }
    const f32x4 w0 = *(const f32x4*)(PRM(PRM_W0) + layer * 256 + c0), a0 = *(const f32x4*)(PRM(PRM_A0) + layer * 256 + c0);
    const f32x4 kkp = *(const f32x4*)(PRM(PRM_KK) + layer * 256 + c0), kap = *(const f32x4*)(PRM(PRM_KA) + layer * 256 + c0), rkp = *(const f32x4*)(PRM(PRM_RK) + layer * 256 + c0);
    float wv[4], av[4], kk[4], kt[4], bb[4];
    float ssq = 0.f, br = 0.f, kr = 0.f, rkr = 0.f;
#pragma unroll
    for (int i = 0; i < 4; ++i) {
        wv[i] = fast_exp(-0.6065306597126334f * sigmoidf_(w0[i] + lw[i]));
        av[i] = sigmoidf_(a0[i] + la[i]);
        kk[i] = ks[i] * kkp[i]; ssq += kk[i] * kk[i];
        kt[i] = ks[i] * (1.0f + (av[i] - 1.0f) * kap[i]);
        kr += kt[i] * rs[i]; rkr += rs[i] * kt[i] * rkp[i];
    }
    ssq = sum16(ssq);
    const float kn = 1.0f / fmaxf(sqrtf(ssq), 1e-12f);
#pragma unroll
    for (int i = 0; i < 4; ++i) { kk[i] *= kn; bb[i] = kk[i] * av[i]; br += bb[i] * rs[i]; }
    br = sum16(br); kr = sum16(kr); rkr = sum16(rkr);
    float wr[4];
#pragma unroll
    for (int i = 0; i < 4; ++i) wr[i] = wv[i] * rs[i] - br * kk[i];
    const size_t rec = ((size_t)(b * 4 + hh) * SEQ + t);
    const int l16 = lane & 15;
    u32x4* pa = (u32x4*)(ws + WS_PA) + rec * 32 + 2 * l16;
    pa[0] = (u32x4){pk_f16(kk[0], kk[1]), pk_f16(bb[0], bb[1]), pk_f16(kt[0], kt[1]), pk_f16(wr[0], wr[1])};
    pa[1] = (u32x4){pk_f16(kk[2], kk[3]), pk_f16(bb[2], bb[3]), pk_f16(kt[2], kt[3]), pk_f16(wr[2], wr[3])};
    *((f32x4*)(ws + WS_PW) + rec * 16 + l16) = (f32x4){wv[0], wv[1], wv[2], wv[3]};
    *((u32x4*)(ws + WS_PV) + rec * 16 + l16) = (u32x4){pk_f16(vs[0], vs[0] * kr), pk_f16(vs[1], vs[1] * kr), pk_f16(vs[2], vs[2] * kr), pk_f16(vs[3], vs[3] * kr)};
    if (l16 == 0) ((float*)(ws + WS_RKR))[(size_t)r * 4 + hh] = rkr;
}

__device__ __forceinline__ void decode_mix(const Params& P, int layer, int tok, LAS unsigned char* lds, int tid, int wid, int lane) {
    unsigned char* ws = P.ws;
    const float* z = (const float*)(ws + WS_ZS) + (size_t)tok * DIN;
    bf16_t* MIXS = (bf16_t*)(ws + WS_MIXS) + (size_t)tok * DM;
    LAS float* L = (LAS float*)lds;
    LAS float* pooled = L;
    LAS float* qs = L + 256;
    LAS float* knew = L + 768;
    LAS float* vnew = L + 896;
    LAS float* scs = L + 1024;
    LAS float* xs = L + 2048;
    LAS float* kkn = L + 2880;
    LAS float* bvec = L + 3136;
    LAS float* wvv = L + 3392;
    LAS float* ktv = L + 3648;
    LAS float* rrv = L + 3904;
    LAS float* vvv = L + 4160;
    LAS float* ov = L + 4416;
    LAS float* rkrs = L + 4672;
    const size_t lt = (size_t)layer * MS + tok;
    if (tid < 256) {
        const int c = tid, g = c >> 6, W_ = 2 << g;
        const float* buf = P.in[2] + lt * 15 * 256 + c;
        float* po = P.out + O_POOLS + lt * 15 * 256 + c;
        const float u = z[c];
        float win = u;
#pragma unroll 5
        for (int j = 0; j < 15; ++j) { const float e = buf[j * 256]; if (j >= 16 - W_) win += e; if (j >= 1) po[(j - 1) * 256] = e; }
        po[14 * 256] = u;
        pooled[c] = win / (float)W_ - u;
    }
    __syncthreads();
    if (tid < 256) {
        const int c = tid, g = c >> 6, d = c & 63;
        const float* pw = PRM(PRM_POOLW) + ((size_t)(layer * 4 + g) * 64) * 64 + d;
        float a = 0.f;
#pragma unroll 8
        for (int cc = 0; cc < 64; ++cc) a += pooled[64 * g + cc] * pw[cc * 64];
        MIXS[c] = f2bf(a * PRM(PRM_POOLSC)[layer * 256 + c] * siluf_(z[256 + c]));
    }
    const f32x2 cs = ((const f32x2*)(ws + WS_ROPE))[2048 * 32 + (lane & 31)];
    {
        const float x = z[512 + wid * 64 + lane];
        const float ss = wave_sum(x * x);
        const float xn = x * (1.0f / sqrtf(ss * (1.0f / 64.0f) + 1e-6f)) * PRM(PRM_QG)[layer * 64 + lane];
        const float pr = __shfl_xor(xn, 32);
        qs[wid * 64 + lane] = (lane < 32 ? xn * cs.x - pr * cs.y : pr * cs.y + xn * cs.x) * 0.125f;
    }
    if (wid < 2) {
        const float x = z[1024 + wid * 64 + lane];
        const float ss = wave_sum(x * x);
        const float xn = x * (1.0f / sqrtf(ss * (1.0f / 64.0f) + 1e-6f)) * PRM(PRM_KG)[layer * 64 + lane];
        const float pr = __shfl_xor(xn, 32);
        const float kv = lane < 32 ? xn * cs.x - pr * cs.y : pr * cs.y + xn * cs.x;
        knew[wid * 64 + lane] = kv;
        P.out[O_KS + (lt * 128 + 127) * 128 + wid * 64 + lane] = kv;
    } else if (wid < 4) {
        const float x = z[1152 + (wid - 2) * 64 + lane];
        vnew[(wid - 2) * 64 + lane] = x;
        P.out[O_VS + (lt * 128 + 127) * 128 + (wid - 2) * 64 + lane] = x;
    }
    const float* kc = P.in[3] + lt * 128 * 128; const float* vc = P.in[4] + lt * 128 * 128;
    {
        const f32x4* ks_ = (const f32x4*)(kc + 128); const f32x4* vs_ = (const f32x4*)(vc + 128);
        f32x4* kd = (f32x4*)(P.out + O_KS + lt * 128 * 128); f32x4* vd = (f32x4*)(P.out + O_VS + lt * 128 * 128);
        for (int i = tid; i < 127 * 32; i += 512) { kd[i] = ks_[i]; vd[i] = vs_[i]; }
    }
    __syncthreads();
    {
        const int kvh = wid >> 2;
#pragma unroll
        for (int jj = 0; jj < 2; ++jj) { const int j = lane + 64 * jj; float a = 0.f;
            if (j < 127) { const f32x4* kr_ = (const f32x4*)(kc + (size_t)(j + 1) * 128 + kvh * 64);
#pragma unroll 4
                for (int d4 = 0; d4 < 16; ++d4) { const f32x4 kq = kr_[d4]; const LAS float* qq = qs + wid * 64 + 4 * d4; a += kq[0] * qq[0] + kq[1] * qq[1] + kq[2] * qq[2] + kq[3] * qq[3]; } }
            else {
#pragma unroll 8
                for (int d = 0; d < 64; ++d) a += knew[kvh * 64 + d] * qs[wid * 64 + d]; }
            scs[wid * 128 + j] = a; }
    }
    __syncthreads();
    {
        const float sk = PRM(PRM_SINK)[layer * 8 + wid];
        const float s0 = scs[wid * 128 + lane], s1 = scs[wid * 128 + 64 + lane];
        const float m = fmaxf(wave_max(fmaxf(s0, s1)), sk);
        const float p0 = fast_exp(s0 - m), p1 = fast_exp(s1 - m);
        const float den = wave_sum(p0 + p1) + fast_exp(sk - m);
        scs[wid * 128 + lane] = p0 / den; scs[wid * 128 + 64 + lane] = p1 / den;
    }
    __syncthreads();
    {
        const int kvh = wid >> 2; float o = 0.f;
#pragma unroll 8
        for (int j = 0; j < 127; ++j) o += scs[wid * 128 + j] * vc[(size_t)(j + 1) * 128 + kvh * 64 + lane];
        o += scs[wid * 128 + 127] * vnew[kvh * 64 + lane];
        MIXS[256 + wid * 64 + lane] = f2bf(o * siluf_(z[1280 + wid * 64 + lane]));
    }
    const float* mu = PRM(PRM_MU) + layer * DSH;
    const float* shp = P.in[5] + lt * DSH;
    for (int i = tid; i < DSH; i += 512) { const float x = z[1792 + i]; P.out[O_SHS + lt * DSH + i] = x; xs[i] = x + (shp[i] - x) * mu[i]; }
    __syncthreads();
    if (tid < 256) {
        const int c = tid;
        float lw = 0.f, la = 0.f;
#pragma unroll 4
        for (int j = 0; j < 32; ++j) { lw += tanhf_(xs[768 + j]) * PRM(PRM_WUP)[((size_t)layer * 32 + j) * 256 + c]; la += xs[800 + j] * PRM(PRM_AUP)[((size_t)layer * 32 + j) * 256 + c]; }
        const float wv = fast_exp(-0.6065306597126334f * sigmoidf_(PRM(PRM_W0)[layer * 256 + c] + lw));
        const float av = sigmoidf_(PRM(PRM_A0)[layer * 256 + c] + la);
        const float rr = xs[c], kx = xs[256 + c], vx = xs[512 + c];
        float kk = kx * PRM(PRM_KK)[layer * 256 + c];
        const float ssq = wave_sum(kk * kk);
        kk = kk / fmaxf(sqrtf(ssq), 1e-12f);
        const float kt = kx * (1.0f + (av - 1.0f) * PRM(PRM_KA)[layer * 256 + c]);
        const float rkr = wave_sum(rr * kt * PRM(PRM_RK)[layer * 256 + c]);
        kkn[c] = kk; bvec[c] = kk * av; wvv[c] = wv; ktv[c] = kt; rrv[c] = rr; vvv[c] = vx;
        if (lane == 0) rkrs[wid] = rkr;
    }
    __syncthreads();
    {
        const int row = tid >> 1, half = tid & 1, hd = row >> 6;
        const f32x4* sp = (const f32x4*)(P.in[6] + (lt * 256 + row) * 64 + 32 * half);
        f32x4* so = (f32x4*)(P.out + O_WKS + (lt * 256 + row) * 64 + 32 * half);
        f32x4 S[8]; float sa = 0.f;
#pragma unroll
        for (int i = 0; i < 8; ++i) { S[i] = sp[i];
#pragma unroll
            for (int e = 0; e < 4; ++e) sa += S[i][e] * kkn[hd * 64 + 32 * half + 4 * i + e]; }
        sa += __shfl_xor(sa, 1);
        const float vr = vvv[row]; float o = 0.f;
#pragma unroll
        for (int i = 0; i < 8; ++i) {
#pragma unroll
            for (int e = 0; e < 4; ++e) { const int k = hd * 64 + 32 * half + 4 * i + e;
                const float sn = S[i][e] * wvv[k] - sa * bvec[k] + vr * ktv[k]; S[i][e] = sn; o += sn * rrv[k]; }
            so[i] = S[i]; }
        o += __shfl_xor(o, 1);
        if (half == 0) ov[row] = o;
    }
    __syncthreads();
    if (tid < 256) {
        const int c = tid;
        const float o = ov[c];
        const float mean = wave_sum(o) * (1.0f / 64.0f);
        const float dlt = o - mean;
        const float var = wave_sum(dlt * dlt) * (1.0f / 64.0f);
        const float on = dlt * (1.0f / sqrtf(var + 64e-5f)) * PRM(PRM_LNG)[layer * 256 + c] + PRM(PRM_LNB)[layer * 256 + c];
        MIXS[768 + c] = f2bf((on + rkrs[wid] * vvv[c]) * siluf_(z[2624 + c]));
    }
    __syncthreads();
}

constexpr int SC_TC = 64, SC_A = SC_TC * 512, SC_W = SC_TC * 256, SC_V = SC_TC * 64, SC_BUF = SC_A + SC_W + SC_V;
#define DPP_ADD(z, CTRL) ((z) + __builtin_bit_cast(float, __builtin_amdgcn_update_dpp(0, __builtin_bit_cast(int, (z)), (CTRL), 0xf, 0xf, true)))
__device__ __forceinline__ void scan_unit(const Params& P, int layer, int unit, LAS unsigned char* lds, int tid, int wid, int lane) {
    unsigned char* ws = P.ws;
    const int hb = unit >> 2, rg = unit & 3;
    const int p = lane & 31, rowl = wid * 2 + (lane >> 5), row = 16 * rg + rowl;
    const bool odd = (lane & 1) != 0;
    const unsigned char* gA = ws + WS_PA + (size_t)hb * SEQ * 512;
    const unsigned char* gW = ws + WS_PW + (size_t)hb * SEQ * 256;
    const unsigned char* gV = ws + WS_PV + ((size_t)hb * SEQ * 64 + 16 * rg) * 4;
    float* oraw = (float*)(ws + WS_ORAW) + ((size_t)(hb >> 2) * SEQ) * 256 + (hb & 3) * 64 + row;
    u32x4 ra[4], rw[2], rv = {0u, 0u, 0u, 0u};
#define SC_GLOAD(c) do { const size_t t0_ = (size_t)(c) * SC_TC; \
        _Pragma("unroll") for (int i = 0; i < 4; ++i) ra[i] = *(const u32x4*)(gA + t0_ * 512 + (size_t)(tid + 512 * i) * 16); \
        _Pragma("unroll") for (int i = 0; i < 2; ++i) rw[i] = *(const u32x4*)(gW + t0_ * 256 + (size_t)(tid + 512 * i) * 16); \
        if (tid < 256) rv = *(const u32x4*)(gV + (t0_ + (tid >> 2)) * 256 + (tid & 3) * 16); } while (0)
#define SC_LSTORE(buf) do { LAS unsigned char* B_ = lds + (buf) * SC_BUF; \
        _Pragma("unroll") for (int i = 0; i < 4; ++i) *(LAS u32x4*)(B_ + (tid + 512 * i) * 16) = ra[i]; \
        _Pragma("unroll") for (int i = 0; i < 2; ++i) *(LAS u32x4*)(B_ + SC_A + (tid + 512 * i) * 16) = rw[i]; \
        if (tid < 256) *(LAS u32x4*)(B_ + SC_A + SC_W + tid * 16) = rv; } while (0)
    float S0 = 0.f, S1 = 0.f;
    SC_GLOAD(0); SC_LSTORE(0);
    __syncthreads();
    for (int c = 0; c < SEQ / SC_TC; ++c) {
        if (c + 1 < SEQ / SC_TC) SC_GLOAD(c + 1);
        const LAS unsigned char* B = lds + (c & 1) * SC_BUF;
        const LAS unsigned char* pA = B + p * 16; const LAS unsigned char* pW = B + SC_A + p * 8; const LAS unsigned char* pV = B + SC_A + SC_W + rowl * 4;
        float* op = oraw + (size_t)c * SC_TC * 256;
#pragma unroll 4
        for (int tt = 0; tt < SC_TC; ++tt) {
            const u32x4 a = *(const LAS u32x4*)(pA + tt * 512);
            const f32x2 w = *(const LAS f32x2*)(pW + tt * 256);
            const unsigned vv = *(const LAS unsigned*)(pV + tt * 64);
            const unsigned ax_ = a[0], ay_ = a[1], az_ = a[2], aw_ = a[3];
            const h2_t hk = as_h2(ax_), hbv = as_h2(ay_), hkt = as_h2(az_), hwr = as_h2(aw_), hv = as_h2(vv);
            float pa = fmaf(S0, (float)hk.x, 0.f); pa = fmaf(S1, (float)hk.y, pa);
            float qa = fmaf(S0, (float)hwr.x, 0.f); qa = fmaf(S1, (float)hwr.y, qa);
            const float x = odd ? qa : pa, y = odd ? pa : qa;
            float zr = x + __builtin_bit_cast(float, __builtin_amdgcn_update_dpp(0, __builtin_bit_cast(int, y), 0xB1, 0xf, 0xf, true));
            zr = DPP_ADD(zr, 0x4E);
            zr = DPP_ADD(zr, 0x124);
            zr = DPP_ADD(zr, 0x128);
            { const auto sw = __builtin_amdgcn_permlane16_swap(__float_as_uint(zr), __float_as_uint(zr), false, false); zr = __uint_as_float(sw[0]) + __uint_as_float(sw[1]); }
            const float sa = __builtin_bit_cast(float, __builtin_amdgcn_update_dpp(0, __builtin_bit_cast(int, zr), 0xA0, 0xf, 0xf, true));
            const float vf = (float)hv.x;
            float t0 = fmaf(vf, (float)hkt.x, 0.f); t0 = fmaf(-sa, (float)hbv.x, t0); S0 = fmaf(S0, w.x, t0);
            float t1 = fmaf(vf, (float)hkt.y, 0.f); t1 = fmaf(-sa, (float)hbv.y, t1); S1 = fmaf(S1, w.y, t1);
            if (p == 1) op[(size_t)tt * 256] = zr + (float)hv.y;
        }
        if (c + 1 < SEQ / SC_TC) SC_LSTORE((c + 1) & 1);
        __syncthreads();
    }
    *(f32x2*)(P.out + O_WKP + (((size_t)layer * 64 + hb) * 64 + row) * 64 + 2 * p) = (f32x2){S0, S1};
}

__device__ __forceinline__ void post_token(const Params& P, int layer, int r, int lane) {
    unsigned char* ws = P.ws;
    const int b = r >> 11, t = r & (SEQ - 1), c0 = 4 * lane, hh = lane >> 4, l16 = lane & 15;
    const f32x4 o = *((const f32x4*)(ws + WS_ORAW) + (size_t)r * 64 + lane);
    const float mean = sum16((o[0] + o[1]) + (o[2] + o[3])) * (1.0f / 64.0f);
    const f32x4 d = o - mean;
    const float var = sum16((d[0] * d[0] + d[1] * d[1]) + (d[2] * d[2] + d[3] * d[3])) * (1.0f / 64.0f);
    const float rstd = 1.0f / sqrtf(var + 64e-5f);
    const f32x4 lg = *(const f32x4*)(PRM(PRM_LNG) + layer * 256 + c0), lb = *(const f32x4*)(PRM(PRM_LNB) + layer * 256 + c0);
    const float rkr = ((const float*)(ws + WS_RKR))[(size_t)r * 4 + hh];
    const u32x4 pv = *((const u32x4*)(ws + WS_PV) + ((size_t)(b * 4 + hh) * SEQ + t) * 16 + l16);
    const unsigned pv0 = pv[0], pv1 = pv[1], pv2 = pv[2], pv3 = pv[3];
    const float v[4] = {(float)as_h2(pv0).x, (float)as_h2(pv1).x, (float)as_h2(pv2).x, (float)as_h2(pv3).x};
    u32x2* gp = (u32x2*)((bf16_t*)(ws + WS_GM) + (size_t)r * 1024 + 768 + c0);
    const u32x2 gt = *gp;
    const float g[4] = {bf_lo(gt.x), bf_hi(gt.x), bf_lo(gt.y), bf_hi(gt.y)};
    float y[4];
#pragma unroll
    for (int i = 0; i < 4; ++i) y[i] = (d[i] * rstd * lg[i] + lb[i] + rkr * v[i]) * g[i];
    *gp = (u32x2){pk_bf16(y[0], y[1]), pk_bf16(y[2], y[3])};
}

constexpr int LDS_BYTES = 147456;
constexpr int NPHASE = 11;
__global__ void __launch_bounds__(512, 2) hymba_fwd(Params P) {
    extern __shared__ __attribute__((aligned(16))) unsigned char lds_raw[];
    LAS unsigned char* lds = (LAS unsigned char*)lds_raw;
    cg::grid_group grid = cg::this_grid();
    const int G = gridDim.x, bx = blockIdx.x;
#define FRESH_IDS int tid = threadIdx.x; asm volatile("" : "+v"(tid)); const int lane = tid & 63; const int wid = __builtin_amdgcn_readfirstlane(tid >> 6); (void)lane; (void)wid;
    unsigned char* ws = P.ws;
    const int lo = P.ph_lo, hi = P.ph_hi;
#define IN(k) (lo <= (k) && (k) < hi)
#define SYNC_AFTER(k) do { if (IN(k) && IN((k) + 1)) grid.sync(); } while (0)
#ifndef SKIP_P0
    if (IN(0)) { FRESH_IDS p0_prologue(P, lds, G, tid, wid, lane); }
#endif
    SYNC_AFTER(0);
    for (int layer = 0; layer < NLAYER; ++layer) {
        const int pb = 1 + 5 * layer;
        if (IN(pb)) {
            FRESH_IDS
#ifndef SKIP_SK
            for (int u = bx; u < NPAD / 16; u += G) skinny_unit<true>(P, layer, u, wid, lane);
#endif
            pg8::Gemm g{(const pg8::bf16_t*)(ws + WS_XB), (const pg8::bf16_t*)(ws + WS_WIN) + (size_t)layer * NPAD * DM, MP, NPAD, DM};
            pg8::StaticOrder S; S.init(MP, NPAD, G, bx);
            EpiIn E; E.ws = ws; E.out = P.out; E.qg = PRM(PRM_QG) + layer * 64; E.kg = PRM(PRM_KG) + layer * 64; E.layer = layer;
#ifndef SKIP_G1
            pg8::gemm_phase<EpiIn, pg8::StaticOrder, false>((PG8_LAS unsigned char*)lds, g, S, E, nullptr);
#endif
        }
        SYNC_AFTER(pb);
        if (IN(pb + 1)) {
            FRESH_IDS
#ifndef SKIP_DM
            for (int tok = bx; tok < MS; tok += G) decode_mix(P, layer, tok, lds, tid, wid, lane);
#endif
            __syncthreads();
#ifndef SKIP_PL
            for (int u = bx; u < 256; u += G) pool_unit(P, layer, u, lds, wid, lane);
#endif
            __syncthreads();
#ifndef SKIP_AT
            for (int u = bx; u < 512; u += G) attn_unit(P, layer, u, lds, tid, wid, lane);
#endif
#ifndef SKIP_PR
            for (int r = bx * 8 + wid; r < MP; r += G * 8) prep_token(P, layer, r, lane);
#endif
        }
        SYNC_AFTER(pb + 1);
        if (IN(pb + 2)) {
            FRESH_IDS
#ifndef SKIP_SC
            for (int u = bx; u < 256; u += G) { const int unit = ((u & 7) * 32 + (u >> 3)); scan_unit(P, layer, unit, lds, tid, wid, lane); __syncthreads(); }
#endif
        }
        SYNC_AFTER(pb + 2);
        if (IN(pb + 3)) {
            FRESH_IDS
#ifndef SKIP_PO
            for (int r = bx * 8 + wid; r < MP; r += G * 8) post_token(P, layer, r, lane);
#endif
        }
        SYNC_AFTER(pb + 3);
        if (IN(pb + 4)) {
            FRESH_IDS
#ifndef SKIP_SK
            for (int u = bx; u < DM / 16; u += G) skinny_unit<false>(P, layer, u, wid, lane);
#endif
            pg8::Gemm g{(const pg8::bf16_t*)(ws + WS_GM), (const pg8::bf16_t*)(ws + WS_WOUT) + (size_t)layer * DM * DM, MP, DM, DM};
            pg8::StaticOrder S; S.init(MP, DM, G, bx);
            EpiOut E; E.resid = layer == 0 ? P.in[0] : P.out + O_YP; E.out = P.out + O_YP;
            E.XB = layer == 0 ? (bf16_t*)(ws + WS_XB) : nullptr; E.RS = layer == 0 ? (float*)(ws + WS_RS) : nullptr;
#ifndef SKIP_G2
            pg8::gemm_phase<EpiOut, pg8::StaticOrder, false>((PG8_LAS unsigned char*)lds, g, S, E, nullptr);
#endif
        }
        if (layer + 1 < NLAYER) SYNC_AFTER(pb + 4);
    }
#undef IN
#undef SYNC_AFTER
}

#ifdef DBG_MASK
__global__ void dbg_scale(float* out) {
    const size_t G = gridDim.x, bx = blockIdx.x;
#define DBG_SCALE(o, lo_, hi_) if (((DBG_MASK | DBG_MASK2) >> (o)) & 1) { const float f_ = ((DBG_MASK >> (o)) & 1) ? DBG_FACTOR : DBG_FACTOR2; for (size_t i = (lo_) + bx * 256 + threadIdx.x; i < (hi_); i += G * 256) out[i] *= f_; }
    DBG_SCALE(0, O_YP, O_YS) DBG_SCALE(1, O_YS, O_POOLP) DBG_SCALE(2, O_POOLP, O_POOLS) DBG_SCALE(3, O_POOLS, O_KP) DBG_SCALE(4, O_KP, O_KS) DBG_SCALE(5, O_KS, O_VP)
    DBG_SCALE(6, O_VP, O_VS) DBG_SCALE(7, O_VS, O_SHP) DBG_SCALE(8, O_SHP, O_SHS) DBG_SCALE(9, O_SHS, O_WKP) DBG_SCALE(10, O_WKP, O_WKS) DBG_SCALE(11, O_WKS, O_END)
}
#endif
#ifndef MK_N_LAUNCHES
#define MK_N_LAUNCHES 1
#endif
extern "C" void kernel_launch(void* const* d_in, const int* in_sizes, int n_in, void* d_out, int out_size, void* d_ws, size_t ws_size, hipStream_t stream) {
    static int grid = 0;
    if (grid == 0) {
        if (n_in != 25 || out_size != (int)O_END || ws_size < WS_END) { fprintf(stderr, "kernel_launch: unexpected shapes: n_in %d out %d ws %zu\n", n_in, out_size, ws_size); grid = -1; return; }
        int dev = 0, cus = 0, per_cu = 0;
        if (hipGetDevice(&dev) != hipSuccess || hipDeviceGetAttribute(&cus, hipDeviceAttributeMultiprocessorCount, dev) != hipSuccess) { grid = -1; return; }
        if (hipFuncSetAttribute((const void*)hymba_fwd, hipFuncAttributeMaxDynamicSharedMemorySize, LDS_BYTES) != hipSuccess) { fprintf(stderr, "kernel_launch: hipFuncSetAttribute failed\n"); grid = -1; return; }
        if (hipOccupancyMaxActiveBlocksPerMultiprocessor(&per_cu, (const void*)hymba_fwd, 512, LDS_BYTES) != hipSuccess || per_cu < 1) { fprintf(stderr, "kernel_launch: occupancy query failed (%d)\n", per_cu); grid = -1; return; }
        grid = cus * 1;
    }
    if (grid < 0) return;
    Params p{};
    for (int i = 0; i < 25; ++i) p.in[i] = (const float*)d_in[i];
    p.out = (float*)d_out; p.ws = (unsigned char*)d_ws;
#if MK_N_LAUNCHES == 1
    p.ph_lo = 0; p.ph_hi = NPHASE;
    void* args[] = {&p};
    hipError_t e = hipLaunchCooperativeKernel((const void*)hymba_fwd, dim3(grid), dim3(512), args, LDS_BYTES, stream);
    if (e != hipSuccess) fprintf(stderr, "kernel_launch: cooperative launch failed: %s (grid %d)\n", hipGetErrorString(e), grid);
#ifdef DBG_MASK
    dbg_scale<<<1024, 256, 0, stream>>>((float*)d_out);
#endif
#else
    for (int ph = 0; ph < NPHASE; ++ph) {
        p.ph_lo = ph; p.ph_hi = ph + 1;
        void* args[] = {&p};
        hipError_t e = hipLaunchCooperativeKernel((const void*)hymba_fwd, dim3(grid), dim3(512), args, LDS_BYTES, stream);
        if (e != hipSuccess) { fprintf(stderr, "kernel_launch: launch %d failed: %s\n", ph, hipGetErrorString(e)); break; }
    }
#endif
}
```

```cpp
#include <hip/hip_runtime.h>
#ifndef DBG_DOUBLE
#define DBG_DOUBLE 0
#endif
#ifndef SCAN_IMPL
#define SCAN_IMPL 1
#endif
#ifndef DBG_CMP_SEL
#define DBG_CMP_SEL 0
#endif
#ifndef USE_CG_SYNC
#define INKERNEL_BAR_ZERO 1
#define USE_CG_SYNC 1
#endif
#include <hip/hip_cooperative_groups.h>
#include <cstdio>
#include <cstdint>
namespace cg = cooperative_groups;
namespace pg8 {
#define PG8_LAS __attribute__((address_space(3)))
typedef unsigned short bf16_t;
typedef short bf16x8 __attribute__((ext_vector_type(8)));
typedef float f32x4 __attribute__((ext_vector_type(4)));
typedef unsigned u32x4 __attribute__((ext_vector_type(4)));
constexpr int BM = 256, BK = 64, HALF = 128, HTB = HALF * BK * 2  , STAGE_BYTES = 8 * HTB, NXCD = 8, WGM = 8;

__host__ __device__ __forceinline__ int lds_byte(int r, int c) { const int st = (r >> 4) * 2 + (c >> 5), rr = r & 15, cc = c & 31, ob = rr * 64 + cc * 2; return st * 1024 + (ob ^ (((ob >> 9) & 1) << 5)); }
__host__ __device__ __forceinline__ void stage_rc(int b, int& R, int& C) { const int st = b / 1024, sb = b % 1024, swz = sb ^ (((sb >> 9) & 1) << 5); R = (st >> 1) * 16 + swz / 64; C = (st & 1) * 32 + (swz % 64) / 2; }
__host__ __device__ __forceinline__ int perm32(int rho) { const int n = rho >> 4, i = rho & 15; return 8 * (i >> 2) + 4 * n + (i & 3); }

struct Unit { int pm, pn; };
struct Gemm { const bf16_t* A; const bf16_t* Bt; int M, N, K; };

struct StaticOrder {
    int nM, nN, nwg, G, c;
    __host__ __device__ void init(int M, int N, int G_, int c_) { nM = M / BM; nN = N / BM; nwg = nM * nN; G = G_; c = c_; }
    __host__ __device__ bool next(int i, Unit& u) const {
        const long L = (long)i * G + c; if (L >= nwg) return false;
        int wgid = (int)L; { const int q = nwg / NXCD, r = nwg % NXCD, xcd = wgid % NXCD, off = wgid / NXCD; wgid = (xcd < r ? xcd * (q + 1) : r * (q + 1) + (xcd - r) * q) + off; }
        const int nig = WGM * nN, gid = wgid / nig, fm = gid * WGM, gsz = (nM - fm) < WGM ? (nM - fm) : WGM;
        u.pm = fm + ((wgid % nig) % gsz); u.pn = (wgid % nig) / gsz; return true;
    }
    __device__ __forceinline__ void a_ready(const Unit&) const {}
    __device__ __forceinline__ void done(const Unit&) const {}
};

struct NoPre { __device__ __forceinline__ void operator()() const {} };
template <class Epi, class Sched, bool STAMP = false, class Pre = NoPre>
__device__ __forceinline__ void gemm_phase(PG8_LAS unsigned char* lds, const Gemm g, const Sched& S, const Epi& E, unsigned long long* stamps, const Pre& pre_hook = Pre()) {
    int tid = threadIdx.x; asm volatile("" : "+v"(tid));
    const int wid = __builtin_amdgcn_readfirstlane(tid >> 6), lane = tid & 63, wr = wid >> 2, wc = wid & 3, fr = lane & 15, fq = lane >> 4;
    const int K = g.K, nt = K / BK;
    int ts_lo = 0, ts_hi = 0, nts = 0; const unsigned long long rt_entry = STAMP ? (unsigned long long)wall_clock64() : 0ull;
#define PG8_STAMP() do { if (STAMP && wid == 0 && nts < 64) { const unsigned long long _c = (unsigned long long)clock64(); \
        ts_lo = (lane == nts) ? (int)(unsigned)_c : ts_lo; ts_hi = (lane == nts) ? (int)(unsigned)(_c >> 32) : ts_hi; ++nts; } } while (0)
    PG8_STAMP();
    unsigned voffA[2], voffB[2];
#pragma unroll
    for (int i = 0; i < 2; ++i) { int R, C; stage_rc(tid * 16 + i * 8192, R, C); const int Rb = Epi::PERM ? ((R & ~31) + perm32(R & 31)) : R;
        voffA[i] = (unsigned)(R * K + C) * 2u; voffB[i] = (unsigned)(Rb * K + C) * 2u; }
    const size_t kstep = (size_t)(BK * 2);
    const size_t hstep = (size_t)HALF * K * 2;
    const size_t tstep = 2 * hstep;
    const unsigned ldsw = (unsigned)wid * 1024u;
    const int aoff = lds_byte(wr * 64 + fr, fq * 8), boff = lds_byte(wc * 32 + fr, fq * 8);
#define PG8_SA(b, h) (((b) * 2 + (h)) * HTB)
#define PG8_SB(b, h) ((4 + (b) * 2 + (h)) * HTB)
#define PG8_STAGE(bufoff, gbase, voff) do { _Pragma("unroll") for (int _i = 0; _i < 2; ++_i) \
        __builtin_amdgcn_global_load_lds((const unsigned*)((const char*)(gbase) + (voff)[_i]), (PG8_LAS unsigned*)(lds + (bufoff) + ldsw + _i * 8192), 16, 0, 0); } while (0)
#define PG8_LDA(dst, b, h) do { _Pragma("unroll") for (int m = 0; m < 4; ++m) _Pragma("unroll") for (int k = 0; k < 2; ++k) dst[m][k] = *(const PG8_LAS bf16x8*)(lds + PG8_SA(b, h) + aoff + m * 2048 + k * 1024); } while (0)
#define PG8_LDB(dst, b, h) do { _Pragma("unroll") for (int n = 0; n < 2; ++n) _Pragma("unroll") for (int k = 0; k < 2; ++k) dst[n][k] = *(const PG8_LAS bf16x8*)(lds + PG8_SB(b, h) + boff + n * 2048 + k * 1024); } while (0)
#define PG8_MMA(ai, bj, At, Bt) do { __builtin_amdgcn_s_setprio(1); _Pragma("unroll") for (int m = 0; m < 4; ++m) _Pragma("unroll") for (int n = 0; n < 2; ++n) _Pragma("unroll") for (int k = 0; k < 2; ++k) \
        acc[ai][bj][m][n] = __builtin_amdgcn_mfma_f32_16x16x32_bf16(Bt[n][k], At[m][k], acc[ai][bj][m][n], 0, 0, 0); __builtin_amdgcn_s_setprio(0); } while (0)
#define PG8_WAIT_V(n) asm volatile("s_waitcnt vmcnt(" #n ")" ::: "memory")
#define PG8_WAIT_L(n) asm volatile("s_waitcnt lgkmcnt(" #n ")" ::: "memory")
#define PG8_BAR __builtin_amdgcn_s_barrier()
#define PG8_SCHED __builtin_amdgcn_sched_barrier(0)
    Unit cur, nxt; int ui = 0;
    if (!S.next(0, cur)) return;
    float pre[8] = {0.f, 0.f, 0.f, 0.f, 0.f, 0.f, 0.f, 0.f};
    f32x4 acc[2][2][4][2];
#pragma unroll
    for (int a = 0; a < 2; ++a)
#pragma unroll
        for (int b = 0; b < 2; ++b)
#pragma unroll
            for (int m = 0; m < 4; ++m)
#pragma unroll
                for (int n = 0; n < 2; ++n) acc[a][b][m][n] = (f32x4){0.f, 0.f, 0.f, 0.f};
    bf16x8 At[4][2], B0[2][2], B1[2][2];
    const char* cA = (const char*)g.A + (size_t)cur.pm * tstep; const char* cB = (const char*)g.Bt + (size_t)cur.pn * tstep;
    S.a_ready(cur);
    PG8_STAGE(PG8_SB(0, 0), cB, voffB); PG8_STAGE(PG8_SA(0, 0), cA, voffA); PG8_STAGE(PG8_SB(0, 1), cB + hstep, voffB); PG8_STAGE(PG8_SA(0, 1), cA + hstep, voffA);
    pre_hook();
    if (wr == 1) PG8_BAR;
    PG8_WAIT_V(4); PG8_BAR;
    PG8_STAGE(PG8_SB(1, 0), cB + kstep, voffB); PG8_STAGE(PG8_SA(1, 0), cA + kstep, voffA); PG8_STAGE(PG8_SB(1, 1), cB + hstep + kstep, voffB);
    PG8_WAIT_V(6); PG8_BAR;
    PG8_STAMP();
    for (;;) {
        const bool has_next = S.next(ui + 1, nxt);
        const char* nA = has_next ? (const char*)g.A + (size_t)nxt.pm * tstep : cA; const char* nB = has_next ? (const char*)g.Bt + (size_t)nxt.pn * tstep : cB;
        for (int t = 0; t < nt; t += 2) {
            const bool last = (t == nt - 2);
            const char* a1 = cA + (size_t)(t + 1) * kstep;
            const char* a2 = last ? nA : cA + (size_t)(t + 2) * kstep; const char* b2 = last ? nB : cB + (size_t)(t + 2) * kstep;
            const char* a3 = a2 + kstep; const char* b3 = b2 + kstep;
            if (last && has_next) S.a_ready(nxt);
            if (t == nt - 4) E.preload(cur, wr, fr, pre);
            PG8_LDB(B0, 0, 0); PG8_SCHED; PG8_LDA(At, 0, 0); PG8_STAGE(PG8_SA(1, 1), a1 + hstep, voffA);
            PG8_WAIT_L(8); PG8_BAR; PG8_WAIT_L(0); PG8_MMA(0, 0, At, B0); PG8_BAR; PG8_SCHED;
            PG8_LDB(B1, 0, 1); PG8_STAGE(PG8_SB(0, 0), b2, voffB);
            PG8_BAR; PG8_WAIT_L(0); PG8_MMA(0, 1, At, B1); PG8_BAR;
            PG8_LDA(At, 0, 1); PG8_STAGE(PG8_SA(0, 0), a2, voffA);
            PG8_BAR; PG8_WAIT_L(0); PG8_MMA(1, 0, At, B0); PG8_BAR; PG8_SCHED;
            PG8_STAGE(PG8_SB(0, 1), b2 + hstep, voffB);
            PG8_WAIT_V(6); PG8_BAR; PG8_MMA(1, 1, At, B1); PG8_BAR;
            PG8_LDB(B0, 1, 0); PG8_SCHED; PG8_LDA(At, 1, 0); PG8_STAGE(PG8_SA(0, 1), a2 + hstep, voffA);
            PG8_WAIT_L(8); PG8_BAR; PG8_WAIT_L(0); PG8_MMA(0, 0, At, B0); PG8_BAR; PG8_SCHED;
            PG8_LDB(B1, 1, 1); PG8_STAGE(PG8_SB(1, 0), b3, voffB);
            PG8_BAR; PG8_WAIT_L(0); PG8_MMA(0, 1, At, B1); PG8_BAR;
            PG8_LDA(At, 1, 1); PG8_STAGE(PG8_SA(1, 0), a3, voffA);
            PG8_BAR; PG8_WAIT_L(0); PG8_MMA(1, 0, At, B0); PG8_BAR; PG8_SCHED;
            PG8_STAGE(PG8_SB(1, 1), b3 + hstep, voffB);
            PG8_WAIT_V(6); PG8_BAR; PG8_MMA(1, 1, At, B1); PG8_BAR;
        }
        PG8_STAMP();
        if constexpr (!Epi::AFTER_DRAIN) { if ((DBG_DOUBLE & 2048) && Epi::IDEMPOTENT) E(acc, cur, wr, wc, fr, fq, pre); E(acc, cur, wr, wc, fr, fq, pre); S.done(cur); }
        PG8_STAMP();
        if (!has_next) break;
#pragma unroll
        for (int a = 0; a < 2; ++a)
#pragma unroll
            for (int b = 0; b < 2; ++b)
#pragma unroll
                for (int m = 0; m < 4; ++m)
#pragma unroll
                    for (int n = 0; n < 2; ++n) acc[a][b][m][n] = (f32x4){0.f, 0.f, 0.f, 0.f};
        cur = nxt; cA = nA; cB = nB; ++ui;
    }
    PG8_WAIT_V(0);
    if (wr == 0) PG8_BAR;
    PG8_BAR;
    if constexpr (Epi::AFTER_DRAIN) { E.fused(acc, cur, wr, wc, fr, fq, lds, wid, lane); S.done(cur); }
    PG8_STAMP();
    if (STAMP && wid == 0) { stamps[lane] = lane < nts ? (((unsigned long long)(unsigned)ts_hi << 32) | (unsigned)ts_lo) : 0ull;
        if (lane == 62) stamps[62] = rt_entry; if (lane == 63) stamps[63] = (unsigned long long)wall_clock64(); }
#undef PG8_STAMP
#undef PG8_SA
#undef PG8_SB
#undef PG8_STAGE
#undef PG8_LDA
#undef PG8_LDB
#undef PG8_MMA
#undef PG8_WAIT_V
#undef PG8_WAIT_L
#undef PG8_BAR
#undef PG8_SCHED
}
}

#define LAS __attribute__((address_space(3)))
typedef unsigned short bf16_t;
typedef short bf16x8 __attribute__((ext_vector_type(8)));
typedef float f32x2 __attribute__((ext_vector_type(2)));
typedef float f32x4 __attribute__((ext_vector_type(4)));
typedef float f32x16 __attribute__((ext_vector_type(16)));
typedef unsigned u32x2 __attribute__((ext_vector_type(2)));
typedef unsigned u32x4 __attribute__((ext_vector_type(4)));
typedef __bf16 bf2_t __attribute__((ext_vector_type(2)));
typedef _Float16 h2_t __attribute__((ext_vector_type(2)));

constexpr int DM = 1024, NB = 16, SEQ = 2048, MP = NB * SEQ, MS = 128, DIN = 2880, NPAD = 3072;
constexpr int DSH = 832, NLAYER = 2;
constexpr float LOG2E = 1.4426950408889634f;
constexpr float QSCALE = 0.125f * LOG2E;
constexpr size_t O_YP = 0, O_YS = 33554432, O_POOLP = 33685504, O_POOLS = 33808384, O_KP = 34791424, O_KS = 35315712,
                 O_VP = 39510016, O_VS = 40034304, O_SHP = 44228608, O_SHS = 44255232, O_WKP = 44468224, O_WKS = 44992512, O_END = 49186816;
constexpr size_t MiB = 1u << 20;
constexpr size_t WS_CTL = 0;
constexpr size_t WS_WIN = 1 * MiB;
constexpr size_t WS_WOUT = 13 * MiB;
constexpr size_t WS_ROPE = 17 * MiB;
constexpr size_t WS_XBS = 18 * MiB;
constexpr size_t WS_RSS = 18 * MiB + 512 * 1024;
constexpr size_t WS_MIXS = 19 * MiB;
constexpr size_t WS_ZS = 20 * MiB;
constexpr size_t WS_RS = 22 * MiB;
constexpr size_t WS_RKR = 24 * MiB;
constexpr size_t WS_KRA = 24 * MiB + 512 * 1024;
constexpr size_t WS_PRM = 25 * MiB;
constexpr int PRM_POOLW = 0, PRM_POOLSC = 32768, PRM_QG = 33280, PRM_KG = 33408, PRM_SINK = 33536, PRM_MU = 33552, PRM_W0 = 35216, PRM_WUP = 35728,
              PRM_A0 = 52112, PRM_AUP = 52624, PRM_KK = 69008, PRM_KA = 69520, PRM_RK = 70032, PRM_LNG = 70544, PRM_LNB = 71056, PRM_END = 71568;
constexpr size_t WS_WUPF = WS_PRM + 512 * 1024;
#define PRM(off) ((const float*)(ws + WS_PRM) + (off))
__device__ __forceinline__ const float* inp_ptr(const unsigned char* ws, int k) {
    const unsigned long long v = ((const unsigned long long*)(ws + (size_t)32768))[k];
    const unsigned lo = __builtin_amdgcn_readfirstlane((unsigned)v), hi = __builtin_amdgcn_readfirstlane((unsigned)(v >> 32));
    return (const float*)(((unsigned long long)hi << 32) | lo);
}
#define INP(k) inp_ptr(ws, (k))
constexpr size_t WS_XB = 32 * MiB;
constexpr size_t WS_U = 96 * MiB;
constexpr size_t WS_Q = 112 * MiB;
constexpr size_t WS_K = 144 * MiB;
constexpr size_t WS_VT = 152 * MiB;
constexpr size_t WS_RIN = 160 * MiB;
constexpr size_t WS_GM = 216 * MiB;
constexpr size_t WS_PA = 280 * MiB;
constexpr size_t WS_PW = 344 * MiB;
constexpr size_t WS_PV = 376 * MiB;
constexpr size_t WS_ORAW = 408 * MiB;
constexpr size_t WS_PO = 28 * MiB;
#if SCAN_IMPL == 2
constexpr size_t WS_PB = 32 * MiB;
#else
constexpr size_t WS_PB = 280 * MiB;
#endif
constexpr size_t WS_ORAW2 = 440 * MiB;
constexpr size_t WS_END = 476 * MiB;

struct Params {
    const float* in[25];
    float* out;
    unsigned char* ws;
    int ph_lo, ph_hi;
};

__device__ __forceinline__ unsigned pk_bf16(float lo, float hi) { f32x2 v = {lo, hi}; bf2_t b = __builtin_convertvector(v, bf2_t); return __builtin_bit_cast(unsigned, b); }
__device__ __forceinline__ h2_t as_h2(unsigned u) { return __builtin_bit_cast(h2_t, u); }
__device__ __forceinline__ unsigned pk_f16(float lo, float hi) { h2_t h = {(_Float16)lo, (_Float16)hi}; return __builtin_bit_cast(unsigned, h); }
__device__ __forceinline__ float bf_lo(unsigned u) { return __uint_as_float(u << 16); }
__device__ __forceinline__ float bf_hi(unsigned u) { return __uint_as_float(u & 0xffff0000u); }
__device__ __forceinline__ float bf1(bf16_t b) { return __uint_as_float(((unsigned)b) << 16); }
__device__ __forceinline__ bf16_t f2bf(float f) { return (bf16_t)(pk_bf16(f, 0.f) & 0xffffu); }
__device__ __forceinline__ float fast_exp(float x) { return __builtin_amdgcn_exp2f(x * LOG2E); }
__device__ __forceinline__ float sigmoidf_(float x) { return __builtin_amdgcn_rcpf(1.0f + fast_exp(-x)); }
__device__ __forceinline__ float siluf_(float x) { return x * sigmoidf_(x); }
#define DPPF(z, CTRL) __builtin_bit_cast(float, __builtin_amdgcn_update_dpp(0, __builtin_bit_cast(int, (z)), (CTRL), 0xf, 0xf, true))
__device__ __forceinline__ float wave_sum(float v) {
    v += DPPF(v, 0xB1); v += DPPF(v, 0x4E); v += DPPF(v, 0x124); v += DPPF(v, 0x128);
    { const auto sw = __builtin_amdgcn_permlane16_swap(__float_as_uint(v), __float_as_uint(v), false, false); v = __uint_as_float(sw[0]) + __uint_as_float(sw[1]); }
    { const auto sw = __builtin_amdgcn_permlane32_swap(__float_as_uint(v), __float_as_uint(v), false, false); v = __uint_as_float(sw[0]) + __uint_as_float(sw[1]); }
    return v;
}
__device__ __forceinline__ float wave_max(float v) {
    v = fmaxf(v, DPPF(v, 0xB1)); v = fmaxf(v, DPPF(v, 0x4E)); v = fmaxf(v, DPPF(v, 0x124)); v = fmaxf(v, DPPF(v, 0x128));
    { const auto sw = __builtin_amdgcn_permlane16_swap(__float_as_uint(v), __float_as_uint(v), false, false); v = fmaxf(__uint_as_float(sw[0]), __uint_as_float(sw[1])); }
    { const auto sw = __builtin_amdgcn_permlane32_swap(__float_as_uint(v), __float_as_uint(v), false, false); v = fmaxf(__uint_as_float(sw[0]), __uint_as_float(sw[1])); }
    return v;
}
__device__ __forceinline__ float sum_x16_x32(float v) {
    { const auto sw = __builtin_amdgcn_permlane16_swap(__float_as_uint(v), __float_as_uint(v), false, false); v = __uint_as_float(sw[0]) + __uint_as_float(sw[1]); }
    { const auto sw = __builtin_amdgcn_permlane32_swap(__float_as_uint(v), __float_as_uint(v), false, false); v = __uint_as_float(sw[0]) + __uint_as_float(sw[1]); }
    return v;
}
__device__ __forceinline__ float sum16(float v) {
    v += __shfl_xor(v, 1); v += __shfl_xor(v, 2); v += __shfl_xor(v, 4); v += __shfl_xor(v, 8); return v;
}
#define DPPX(z, CTRL) __builtin_bit_cast(float, __builtin_amdgcn_update_dpp(0, __builtin_bit_cast(int, (z)), (CTRL), 0xf, 0xf, true))
__device__ __forceinline__ float sum16d(float v) {
    v += DPPX(v, 0xB1); v += DPPX(v, 0x4E); v += DPPX(v, 0x124); v += DPPX(v, 0x128); return v;
}
__device__ __forceinline__ void store8_bf16(bf16_t* p, f32x4 a, f32x4 b) {
    u32x4 w; w.x = pk_bf16(a[0], a[1]); w.y = pk_bf16(a[2], a[3]); w.z = pk_bf16(b[0], b[1]); w.w = pk_bf16(b[2], b[3]);
    *(u32x4*)p = w;
}

__host__ __device__ __forceinline__ int src_col_in(int n) {
    const int pn = n >> 8, p = n & 255, bj = p >> 7, wc = (p >> 5) & 3, j = p & 31, nn = j >> 4, fq = (j >> 2) & 3, e = j & 3;
    const int i8 = 8 * fq + 4 * nn + e;
    const int gen = 128 * bj + 32 * wc + i8;
    const int hd = 64 * wc + 32 * bj + i8;
    switch (pn) {
        case 0: return gen;
        case 1: return 256 + gen;
        case 2: return 512 + hd;
        case 3: return 768 + hd;
        case 4: return 1024 + hd;
        case 5: return 1280 + gen;
        case 6: return 1536 + gen;
        case 7: return 1792 + gen;
        case 8: return 2048 + gen;
        case 9: return 2304 + gen;
        case 10: return 2624 + gen;
        default: return gen < 64 ? 2560 + gen : -1;
    }
}
__host__ __device__ __forceinline__ int src_col_out(int n) {
    const int pn = n >> 8, p = n & 255, bj = p >> 7, wc = (p >> 5) & 3, j = p & 31, nn = j >> 4, fq = (j >> 2) & 3, e = j & 3;
    return pn * 256 + 128 * bj + 32 * wc + 8 * fq + 4 * nn + e;
}

struct EpiIn {
    static constexpr bool PERM = false, AFTER_DRAIN = false, IDEMPOTENT = true;
    unsigned char* ws; float* out; const float* qg; const float* kg; int layer;
    __device__ __forceinline__ void preload(const pg8::Unit& u, int wr, int fr, float (&pre)[8]) const {
        const float* RS = (const float*)(ws + WS_RS) + (size_t)layer * MP + u.pm * 256 + wr * 64 + fr;
#pragma unroll
        for (int g = 0; g < 8; ++g) pre[g] = RS[(g >> 2) * 128 + (g & 3) * 16];
    }
    template <int KIND>
    __device__ __forceinline__ void body(const f32x4 (&acc)[2][2][4][2], const pg8::Unit& u, int wr, int wc, int fr, int fq, const float (&pre)[8]) const {
        const int pn = u.pn;
        const int row0 = u.pm * 256 + wr * 64 + fr;
        const int i8 = 8 * fq;
        float rsv[2][4];
#pragma unroll
        for (int ai = 0; ai < 2; ++ai)
#pragma unroll
            for (int m = 0; m < 4; ++m) rsv[ai][m] = pre[ai * 4 + m];
        if constexpr (KIND == 5) {
            const float* g = (pn == 4) ? kg : qg;
            const f32x4 gl0 = *(const f32x4*)(g + i8), gl1 = *(const f32x4*)(g + i8 + 4), gh0 = *(const f32x4*)(g + 32 + i8), gh1 = *(const f32x4*)(g + 36 + i8);
            const float osc = (pn == 4) ? 1.0f : QSCALE;
            const int t0 = row0 & (SEQ - 1), b = row0 >> 11;
            const f32x4* cs0 = (const f32x4*)((const f32x2*)(ws + WS_ROPE) + (size_t)t0 * 32 + i8);
            f32x4 nc[4];
#pragma unroll
            for (int i = 0; i < 4; ++i) nc[i] = cs0[i];
#pragma unroll
            for (int gi = 0; gi < 8; ++gi) {
                const int ai = gi >> 2, m = gi & 3;
                const int r = row0 + ai * 128 + m * 16, t = t0 + ai * 128 + m * 16;
                const float ri = __builtin_amdgcn_rsqf(rsv[ai][m] * (1.0f / 1024.0f) + 1e-6f);
                f32x4 cc[4];
#pragma unroll
                for (int i = 0; i < 4; ++i) cc[i] = nc[i];
                if (gi < 7) { const f32x4* cn = cs0 + (size_t)((((gi + 1) >> 2) * 128 + ((gi + 1) & 3) * 16) * 16);
#pragma unroll
                    for (int i = 0; i < 4; ++i) nc[i] = cn[i]; }
                float ss = 0.f;
#pragma unroll
                for (int bj = 0; bj < 2; ++bj)
#pragma unroll
                    for (int nn = 0; nn < 2; ++nn) { const f32x4 v = acc[ai][bj][m][nn]; ss += (v[0] * v[0] + v[1] * v[1]) + (v[2] * v[2] + v[3] * v[3]); }
                ss = sum_x16_x32(ss);
                ss *= ri * ri;
                const float sc = ri * __builtin_amdgcn_rsqf(ss * (1.0f / 64.0f) + 1e-6f);
                bf16_t* pq = (pn == 4) ? (bf16_t*)(ws + WS_K) + (size_t)r * 128 + wc * 64 + i8 : (bf16_t*)(ws + WS_Q) + (size_t)r * 512 + ((pn - 2) * 4 + wc) * 64 + i8;
                float* o = out + (long)O_KP + ((((long)layer * NB + b) * 128 + (t - (SEQ - 128))) * 2 + wc) * 64 + i8;
                f32x4 lo[2], hi[2];
#pragma unroll
                for (int nn = 0; nn < 2; ++nn) {
                    const f32x4 a = acc[ai][0][m][nn] * sc * (nn ? gl1 : gl0), bq = acc[ai][1][m][nn] * sc * (nn ? gh1 : gh0); const f32x4 c0 = cc[2 * nn], c1 = cc[2 * nn + 1];
                    lo[nn][0] = a[0] * c0[0] - bq[0] * c0[1]; hi[nn][0] = a[0] * c0[1] + bq[0] * c0[0];
                    lo[nn][1] = a[1] * c0[2] - bq[1] * c0[3]; hi[nn][1] = a[1] * c0[3] + bq[1] * c0[2];
                    lo[nn][2] = a[2] * c1[0] - bq[2] * c1[1]; hi[nn][2] = a[2] * c1[1] + bq[2] * c1[0];
                    lo[nn][3] = a[3] * c1[2] - bq[3] * c1[3]; hi[nn][3] = a[3] * c1[3] + bq[3] * c1[2];
                }
                if (pn == 4 && t >= SEQ - 128) { *(f32x4*)o = lo[0]; *(f32x4*)(o + 4) = lo[1]; *(f32x4*)(o + 32) = hi[0]; *(f32x4*)(o + 36) = hi[1]; }
                store8_bf16(pq, lo[0] * osc, lo[1] * osc); store8_bf16(pq + 32, hi[0] * osc, hi[1] * osc);
                asm volatile("" ::: "memory");
            }
            return;
        }
#pragma unroll
        for (int ai = 0; ai < 2; ++ai)
#pragma unroll
            for (int m = 0; m < 4; ++m) {
                const int r = row0 + ai * 128 + m * 16;
                const int t = r & (SEQ - 1), b = r >> 11;
                const float ri = __builtin_amdgcn_rsqf(rsv[ai][m] * (1.0f / 1024.0f) + 1e-6f);
                if (KIND == 0) {
                    bf16_t* p = (bf16_t*)(ws + WS_U) + (size_t)r * 256 + 32 * wc + i8;
                    float* o = out + (long)O_POOLP + (((long)layer * NB + b) * 15 + (t - (SEQ - 15))) * 256 + 32 * wc + i8;
#pragma unroll
                    for (int bj = 0; bj < 2; ++bj) { const f32x4 v0 = acc[ai][bj][m][0] * ri, v1 = acc[ai][bj][m][1] * ri;
                        store8_bf16(p + 128 * bj, v0, v1);
                        if (t >= SEQ - 15) { *(f32x4*)(o + 128 * bj) = v0; *(f32x4*)(o + 128 * bj + 4) = v1; } }
                } else if (KIND == 1) {
                    const int cbase = (pn == 1) ? 0 : (pn == 5) ? 256 : (pn == 6) ? 512 : 768;
                    bf16_t* p = (bf16_t*)(ws + WS_GM) + (size_t)r * 1024 + cbase + 32 * wc + i8;
#pragma unroll
                    for (int bj = 0; bj < 2; ++bj) { f32x4 v0 = acc[ai][bj][m][0] * ri, v1 = acc[ai][bj][m][1] * ri;
#pragma unroll
                        for (int e = 0; e < 4; ++e) { v0[e] = siluf_(v0[e]); v1[e] = siluf_(v1[e]); }
                        store8_bf16(p + 128 * bj, v0, v1); }
                } else if (KIND == 2) {
                    const int cbase = (pn - 7) * 256 + 32 * wc + i8;
                    bf16_t* p = (bf16_t*)(ws + WS_RIN) + (size_t)r * DSH + cbase;
                    float* o = out + O_SHP + ((size_t)layer * NB + b) * DSH + cbase;
#pragma unroll
                    for (int bj = 0; bj < 2; ++bj) { const f32x4 v0 = acc[ai][bj][m][0] * ri, v1 = acc[ai][bj][m][1] * ri;
                        store8_bf16(p + 128 * bj, v0, v1);
                        if (t == SEQ - 1) { *(f32x4*)(o + 128 * bj) = v0; *(f32x4*)(o + 128 * bj + 4) = v1; } }
                } else if (KIND == 3) {
                    const int cbase = 768 + 32 * wc + i8;
                    const f32x4 v0 = acc[ai][0][m][0] * ri, v1 = acc[ai][0][m][1] * ri;
                    store8_bf16((bf16_t*)(ws + WS_RIN) + (size_t)r * DSH + cbase, v0, v1);
                    if (t == SEQ - 1) { float* o = out + O_SHP + ((size_t)layer * NB + b) * DSH + cbase; *(f32x4*)o = v0; *(f32x4*)(o + 4) = v1; }
                } else if (KIND == 4) {
                    const int h = wc - 2;
                    bf16_t* vt = (bf16_t*)(ws + WS_VT) + ((size_t)(b * 2 + h) * 64) * SEQ + t;
                    float* o = out + (long)O_VP + ((((long)layer * NB + b) * 128 + (t - (SEQ - 128))) * 2 + h) * 64 + i8;
#pragma unroll
                    for (int bj = 0; bj < 2; ++bj) { const f32x4 v0 = acc[ai][bj][m][0] * ri, v1 = acc[ai][bj][m][1] * ri;
#pragma unroll
                        for (int e = 0; e < 4; ++e) { vt[(size_t)(32 * bj + i8 + e) * SEQ] = f2bf(v0[e]); vt[(size_t)(32 * bj + i8 + 4 + e) * SEQ] = f2bf(v1[e]); }
                        if (t >= SEQ - 128) { *(f32x4*)(o + 32 * bj) = v0; *(f32x4*)(o + 32 * bj + 4) = v1; } }
                }
                asm volatile("" ::: "memory");
            }
    }
    __device__ __forceinline__ void operator()(const f32x4 (&acc)[2][2][4][2], const pg8::Unit& u, int wr, int wc, int fr, int fq, const float (&pre)[8]) const {
        asm volatile("" : "+v"(fr), "+v"(fq));
        const int pn = u.pn;
        if (pn == 0) body<0>(acc, u, wr, wc, fr, fq, pre);
        else if (pn == 1 || pn == 5 || pn == 6 || pn == 10) body<1>(acc, u, wr, wc, fr, fq, pre);
        else if (pn >= 7 && pn <= 9) body<2>(acc, u, wr, wc, fr, fq, pre);
        else if (pn == 11) { if (wc < 2) body<3>(acc, u, wr, wc, fr, fq, pre); }
        else if (pn == 4 && wc >= 2) body<4>(acc, u, wr, wc, fr, fq, pre);
        else body<5>(acc, u, wr, wc, fr, fq, pre);
    }
};

struct EpiOut {
    static constexpr bool PERM = false, AFTER_DRAIN = false, IDEMPOTENT = false;
    const float* resid; float* out; bf16_t* XB; float* RS; int layer;
    __device__ __forceinline__ void preload(const pg8::Unit&, int, int, float (&)[8]) const {}
    __device__ __forceinline__ void operator()(const f32x4 (&acc)[2][2][4][2], const pg8::Unit& u, int wr, int wc, int fr, int fq, const float (&)[8]) const {
        asm volatile("" : "+v"(fr), "+v"(fq));
        const int row0 = u.pm * 256 + wr * 64 + fr;
        const int cb = u.pn * 256 + 32 * wc + 8 * fq;
        const size_t off0 = (size_t)row0 * DM + cb;
#define EPO_OFF(g) ((size_t)(row0 + ((g) >> 2) * 128 + ((g) & 3) * 16) * DM + cb)
        u32x4 nb[8][2];
#pragma unroll
        for (int g = 0; g < 8; ++g)
#pragma unroll
            for (int bj = 0; bj < 2; ++bj) nb[g][bj] = *(const u32x4*)(XB + EPO_OFF(g) + bj * 128);
#pragma unroll
        for (int g = 0; g < 8; ++g) {
            const int ai = g >> 2, m = g & 3;
            const int r = row0 + ai * 128 + m * 16;
            const size_t off = EPO_OFF(g);
            float ss = 0.f;
#pragma unroll
            for (int bj = 0; bj < 2; ++bj) {
                const unsigned b0 = nb[g][bj][0], b1 = nb[g][bj][1], b2 = nb[g][bj][2], b3 = nb[g][bj][3];
                const f32x4 r0 = {bf_lo(b0), bf_hi(b0), bf_lo(b1), bf_hi(b1)}, r1 = {bf_lo(b2), bf_hi(b2), bf_lo(b3), bf_hi(b3)};
                const f32x4 y0 = acc[ai][bj][m][0] + r0, y1 = acc[ai][bj][m][1] + r1;
                if (layer == 0) { store8_bf16(XB + off + bj * 128, y0, y1);
#pragma unroll
                    for (int e = 0; e < 4; ++e) ss += y0[e] * y0[e] + y1[e] * y1[e]; }
                else { *(f32x4*)(out + off + bj * 128) = y0; *(f32x4*)(out + off + bj * 128 + 4) = y1; } }
            if (layer == 0) { ss = sum_x16_x32(ss);
                if (fq == 0) __hip_atomic_fetch_add(RS + r, ss, __ATOMIC_RELAXED, __HIP_MEMORY_SCOPE_AGENT); }
            asm volatile("" ::: "memory");
        }
#undef EPO_OFF
    }
};

__device__ __forceinline__ void p0_transpose_item(const float* W, int ldw, const float* g, bf16_t* WT, LAS float* scr, int item, int nblk, bool is_in, int lane) {
    const int kb = item / nblk, nb = item % nblk, k0 = 64 * kb, n0 = 32 * nb;
    const int sc = is_in ? src_col_in(n0 + (lane & 31)) : src_col_out(n0 + (lane & 31));
    float wv_[32], gv_[32];
#pragma unroll
    for (int i = 0; i < 32; ++i) { const int kk = 2 * i + (lane >> 5); wv_[i] = 0.f; gv_[i] = 1.f;
        if (sc >= 0) { wv_[i] = W[(size_t)(k0 + kk) * ldw + sc]; if (g) gv_[i] = g[k0 + kk]; } }
#pragma unroll
    for (int i = 0; i < 32; ++i) { const int kk = 2 * i + (lane >> 5); scr[kk * 33 + (lane & 31)] = wv_[i] * gv_[i]; }
    asm volatile("s_waitcnt lgkmcnt(0)" ::: "memory");
    const int c = lane & 7;
#pragma unroll
    for (int j = 0; j < 4; ++j) { const int n = (lane >> 3) + 8 * j; const LAS float* s = scr + (8 * c) * 33 + n;
        u32x4 o; o.x = pk_bf16(s[0 * 33], s[1 * 33]); o.y = pk_bf16(s[2 * 33], s[3 * 33]); o.z = pk_bf16(s[4 * 33], s[5 * 33]); o.w = pk_bf16(s[6 * 33], s[7 * 33]);
        *(u32x4*)(WT + (size_t)(n0 + n) * DM + k0 + 8 * c) = o; }
    asm volatile("s_waitcnt lgkmcnt(0)" ::: "memory");
}
__device__ __forceinline__ float row_to_bf16(const float* xrow, bf16_t* orow, int lane) {
    const f32x4* xr = (const f32x4*)xrow + lane;
    f32x4 v[4]; float s = 0.f;
#pragma unroll
    for (int j = 0; j < 4; ++j) { v[j] = xr[64 * j]; s += (v[j][0] * v[j][0] + v[j][1] * v[j][1]) + (v[j][2] * v[j][2] + v[j][3] * v[j][3]); }
    u32x2* o8 = (u32x2*)orow + lane;
#pragma unroll
    for (int j = 0; j < 4; ++j) { u32x2 w; w.x = pk_bf16(v[j][0], v[j][1]); w.y = pk_bf16(v[j][2], v[j][3]); o8[64 * j] = w; }
    return wave_sum(s);
}
__device__ __forceinline__ void p0_prologue(const Params& P, LAS unsigned char* lds, int G, int tid, int wid, int lane) {
    unsigned char* ws = P.ws;
    LAS float* scr = (LAS float*)(lds + wid * 16384);
    const int gw = blockIdx.x * 8 + wid, NGW = G * 8;
    constexpr int I_IN = 16 * 96, I_OUT = 16 * 32, NITEMS = 2 * I_IN + 2 * I_OUT;
    for (int it = gw; it < NITEMS; it += NGW) {
        int r = it;
        if (r < 2 * I_IN) { const int l = r / I_IN; r -= l * I_IN;
            p0_transpose_item(P.in[8] + (size_t)l * DM * DIN, DIN, P.in[7] + l * DM, (bf16_t*)(ws + WS_WIN) + (size_t)l * NPAD * DM, scr, r, 96, true, lane); continue; }
        r -= 2 * I_IN; { const int l = r / I_OUT; r -= l * I_OUT;
            p0_transpose_item(P.in[9] + (size_t)l * DM * DM, DM, nullptr, (bf16_t*)(ws + WS_WOUT) + (size_t)l * DM * DM, scr, r, 32, false, lane); }
    }
    if (blockIdx.x == 0 && tid < 7) ((unsigned long long*)(ws + WS_CTL + 32768))[tid] = (unsigned long long)P.in[tid];
#if INKERNEL_BAR_ZERO
    if (blockIdx.x == 0) for (int i = tid; i < 3584; i += 512) ((unsigned*)(ws + WS_CTL) + 4096)[i] = 0u;
#endif
    for (int e = blockIdx.x * 512 + tid; e < 32768; e += G * 512) {
        float v[15];
#define P0_LD(k, idx, n) v[k] = e < (n) ? P.in[idx][e] : 0.f;
        P0_LD(0, 10, 32768) P0_LD(1, 11, 512) P0_LD(2, 12, 128) P0_LD(3, 13, 128) P0_LD(4, 14, 16) P0_LD(5, 15, 1664) P0_LD(6, 16, 512) P0_LD(7, 17, 16384)
        P0_LD(8, 18, 512) P0_LD(9, 19, 16384) P0_LD(10, 20, 512) P0_LD(11, 21, 512) P0_LD(12, 22, 512) P0_LD(13, 23, 512) P0_LD(14, 24, 512)
#define P0_ST(k, off, n) if (e < (n)) ((float*)(ws + WS_PRM))[(off) + e] = v[k];
        P0_ST(0, PRM_POOLW, 32768) P0_ST(1, PRM_POOLSC, 512) P0_ST(2, PRM_QG, 128) P0_ST(3, PRM_KG, 128) P0_ST(4, PRM_SINK, 16) P0_ST(5, PRM_MU, 1664) P0_ST(6, PRM_W0, 512) P0_ST(7, PRM_WUP, 16384)
        P0_ST(8, PRM_A0, 512) P0_ST(9, PRM_AUP, 16384) P0_ST(10, PRM_KK, 512) P0_ST(11, PRM_KA, 512) P0_ST(12, PRM_RK, 512) P0_ST(13, PRM_LNG, 512) P0_ST(14, PRM_LNB, 512)
    }
    for (int e = blockIdx.x * 512 + tid; e < 2 * 2 * 16 * 64 * 8; e += G * 512) {
        const int j = e & 7, ln = (e >> 3) & 63, nb = (e >> 9) & 15, mat = (e >> 13) & 1, l = e >> 14;
        const float* up = P.in[mat ? 19 : 17] + (size_t)l * 32 * 256;
        ((bf16_t*)(ws + WS_WUPF))[e] = f2bf(up[(8 * (ln >> 4) + j) * 256 + 16 * nb + (ln & 15)]);
    }
    for (int e = blockIdx.x * 512 + tid; e < 2049 * 32; e += G * 512) {
        const int pi = e >> 5, i = e & 31; const int pos = pi < 2048 ? pi : 16384;
        const float fr = (float)pow(10000.0, -(double)i / 32.0);
        const float ang = (float)pos * fr;
        f32x2 cs; cs.x = cosf(ang); cs.y = sinf(ang);
        ((f32x2*)(ws + WS_ROPE))[e] = cs;
    }
    for (int m0 = gw; m0 < MP; m0 += 4 * NGW) {
        f32x4 v[4][4];
#pragma unroll
        for (int j = 0; j < 4; ++j) { const int m = m0 + j * NGW; if (m < MP) { const f32x4* xr = (const f32x4*)(P.in[0] + (size_t)m * DM) + lane;
#pragma unroll
            for (int c = 0; c < 4; ++c) v[j][c] = xr[64 * c]; } }
#pragma unroll
        for (int j = 0; j < 4; ++j) { const int m = m0 + j * NGW; if (m < MP) { float s_ = 0.f;
#pragma unroll
            for (int c = 0; c < 4; ++c) s_ += (v[j][c][0] * v[j][c][0] + v[j][c][1] * v[j][c][1]) + (v[j][c][2] * v[j][c][2] + v[j][c][3] * v[j][c][3]);
            u32x2* o8 = (u32x2*)((bf16_t*)(ws + WS_XB) + (size_t)m * DM) + lane;
#pragma unroll
            for (int c = 0; c < 4; ++c) { u32x2 w; w.x = pk_bf16(v[j][c][0], v[j][c][1]); w.y = pk_bf16(v[j][c][2], v[j][c][3]); o8[64 * c] = w; }
            s_ = wave_sum(s_);
            if (lane < 2) ((float*)(ws + WS_RS))[(size_t)lane * MP + m] = lane == 0 ? s_ : 0.f; } }
    }
    for (int ms = gw; ms < MS; ms += NGW) { const float s_ = row_to_bf16(P.in[1] + (size_t)ms * DM, (bf16_t*)(ws + WS_XBS) + (size_t)ms * DM, lane);
        ((float*)(ws + WS_RSS))[ms * 64 + lane] = lane == 0 ? s_ : 0.f; }
}

template <bool IS_IN>
__device__ __forceinline__ void skinny_unit(const Params& P, int layer, int unit, int wid, int lane) {
    unsigned char* ws = P.ws;
    const bf16_t* A = IS_IN ? (const bf16_t*)(ws + WS_XBS) : (const bf16_t*)(ws + WS_MIXS);
    const bf16_t* Bt = IS_IN ? (const bf16_t*)(ws + WS_WIN) + (size_t)layer * NPAD * DM : (const bf16_t*)(ws + WS_WOUT) + (size_t)layer * DM * DM;
    const int n0 = unit * 16, r16 = lane & 15, kq = lane >> 4;
    const bf16x8* ap = (const bf16x8*)(A + (size_t)(16 * wid + r16) * DM + 8 * kq);
    const bf16x8* bp = (const bf16x8*)(Bt + (size_t)(n0 + r16) * DM + 8 * kq);
    f32x4 acc = {0.f, 0.f, 0.f, 0.f};
    float rsv[16];
    if (IS_IN) { const float* RSS = (const float*)(ws + WS_RSS);
#pragma unroll
        for (int rr = 0; rr < 16; ++rr) rsv[rr] = RSS[(16 * wid + rr) * 64 + lane]; }
    const int kst = (unit * 5 + wid * 3) & 31;
#pragma unroll
    for (int hf = 0; hf < 2; ++hf) {
        bf16x8 av[16], bv[16];
#pragma unroll
        for (int i = 0; i < 16; ++i) { const int k = (kst + hf * 16 + i) & 31; av[i] = ap[k * 4]; bv[i] = bp[k * 4]; }
#pragma unroll
        for (int i = 0; i < 16; ++i) acc = __builtin_amdgcn_mfma_f32_16x16x32_bf16(av[i], bv[i], acc, 0, 0, 0);
    }
    const int n = n0 + r16;
    if (IS_IN) {
        float rv = 0.f;
#pragma unroll
        for (int rr = 0; rr < 16; ++rr) { const float s = wave_sum(rsv[rr]); rv = (lane == rr) ? s : rv; }
        rv = __builtin_amdgcn_rsqf(rv * (1.0f / 1024.0f) + 1e-6f);
        const int lc = src_col_in(n);
        float* ZS = (float*)(ws + WS_ZS);
#pragma unroll
        for (int reg = 0; reg < 4; ++reg) { const float ri = __shfl(rv, 4 * kq + reg); if (lc >= 0) ZS[(size_t)(16 * wid + 4 * kq + reg) * DIN + lc] = acc[reg] * ri; }
    } else {
        const int lc = src_col_out(n);
        const float* resid = layer == 0 ? INP(1) : P.out + O_YS;
        float* out = P.out + O_YS;
        bf16_t* XBS = (bf16_t*)(ws + WS_XBS); float* RSS = (float*)(ws + WS_RSS);
#pragma unroll
        for (int reg = 0; reg < 4; ++reg) { const int row = 16 * wid + 4 * kq + reg;
            const float y = resid[(size_t)row * DM + lc] + acc[reg];
            out[(size_t)row * DM + lc] = y;
            if (layer == 0) { XBS[(size_t)row * DM + lc] = f2bf(y); const float s = sum16d(y * y); if (r16 == 0) RSS[row * 64 + unit] = s; } }
    }
}

constexpr int PL_ROW = 144, PL_WAVE = 16 * PL_ROW;
template <int W_>
__device__ __forceinline__ void pool_wave(const Params& P, int layer, int b, int t0, int g, LAS unsigned char* lw, int lane, bool dry) {
    unsigned char* ws = P.ws;
    const bf16_t* ub = (const bf16_t*)(ws + WS_U) + ((size_t)b * SEQ) * 256 + 64 * g + lane;
    const int r16 = lane & 15, kq = lane >> 4;
    const float* pw = PRM(PRM_POOLW) + ((size_t)(layer * 4 + g) * 64) * 64 + r16;
    bf16x8 bfr[4][2];
#pragma unroll
    for (int nb = 0; nb < 4; ++nb)
#pragma unroll
        for (int kk = 0; kk < 2; ++kk) { u32x4 w;
            const float* q = pw + (size_t)(8 * kq + 32 * kk) * 64 + 16 * nb;
            w.x = pk_bf16(q[0], q[64]); w.y = pk_bf16(q[128], q[192]); w.z = pk_bf16(q[256], q[320]); w.w = pk_bf16(q[384], q[448]);
            bfr[nb][kk] = __builtin_bit_cast(bf16x8, w); }
    f32x4 scl[4];
#pragma unroll
    for (int nb = 0; nb < 4; ++nb) scl[nb] = *(const f32x4*)(PRM(PRM_POOLSC) + layer * 256 + 64 * g + 16 * nb + 4 * kq);
    float up[16], un[16];
#pragma unroll
    for (int j = 0; j < 16; ++j) { const int tt = t0 - 16 + j; up[j] = tt >= 0 ? bf1(ub[(long)tt * 256]) : 0.f; }
    float win = 0.f;
#pragma unroll
    for (int j = 1; j < W_; ++j) win += up[16 - j];
    bf16_t* gmb = (bf16_t*)(ws + WS_GM) + ((size_t)b * SEQ + t0 + r16) * 1024 + 64 * g + 4 * kq;
    bf16_t nr[16]; u32x2 ngt[4];
#pragma unroll
    for (int j = 0; j < 16; ++j) nr[j] = ub[(size_t)(t0 + j) * 256];
#pragma unroll
    for (int nb = 0; nb < 4; ++nb) ngt[nb] = *(const u32x2*)(gmb + 16 * nb);
    for (int tq = 0; tq < 64; tq += 16) {
#pragma unroll
        for (int j = 0; j < 16; ++j) un[j] = bf1(nr[j]);
        u32x2 gt[4];
#pragma unroll
        for (int nb = 0; nb < 4; ++nb) gt[nb] = ngt[nb];
        if (tq + 16 < 64) {
#pragma unroll
            for (int j = 0; j < 16; ++j) nr[j] = ub[(size_t)(t0 + tq + 16 + j) * 256];
#pragma unroll
            for (int nb = 0; nb < 4; ++nb) ngt[nb] = *(const u32x2*)(gmb + (size_t)(tq + 16) * 1024 + 16 * nb); }
#pragma unroll
        for (int j = 0; j < 16; ++j) { const int t = t0 + tq + j;
            win += un[j];
            const float pooled = (t + 1 >= W_) ? win * (1.0f / (float)W_) - un[j] : win / (float)(t + 1) - un[j];
            win -= (j - W_ + 1 >= 0) ? un[(j - W_ + 1) & 15] : up[(16 + j - W_ + 1) & 15];
            *(LAS bf16_t*)(lw + j * PL_ROW + lane * 2) = f2bf(pooled); }
        const bf16x8 a0 = *(const LAS bf16x8*)(lw + r16 * PL_ROW + (8 * kq) * 2), a1 = *(const LAS bf16x8*)(lw + r16 * PL_ROW + (8 * kq + 32) * 2);
#pragma unroll
        for (int nb = 0; nb < 4; ++nb) { f32x4 acc = {0.f, 0.f, 0.f, 0.f};
            acc = __builtin_amdgcn_mfma_f32_16x16x32_bf16(bfr[nb][0], a0, acc, 0, 0, 0);
            acc = __builtin_amdgcn_mfma_f32_16x16x32_bf16(bfr[nb][1], a1, acc, 0, 0, 0);
            const unsigned g0 = gt[nb].x, g1 = gt[nb].y;
            u32x2 w; w.x = pk_bf16(acc[0] * scl[nb][0] * bf_lo(g0), acc[1] * scl[nb][1] * bf_hi(g0)); w.y = pk_bf16(acc[2] * scl[nb][2] * bf_lo(g1), acc[3] * scl[nb][3] * bf_hi(g1));
            *(u32x2*)(gmb + (size_t)tq * 1024 + 16 * nb) = dry ? gt[nb] : w; }
#pragma unroll
        for (int j = 0; j < 16; ++j) up[j] = un[j];
    }
}
__device__ __forceinline__ void pool_unit(const Params& P, int layer, int unit, LAS unsigned char* lds, int wid, int lane, bool dry = false) {
    const int b = unit >> 4, chunk = unit & 15, g = wid & 3, half = wid >> 2;
    const int t0 = chunk * 128 + half * 64;
    LAS unsigned char* lw = lds + wid * 2560;
    if (g == 0) pool_wave<2>(P, layer, b, t0, g, lw, lane, dry);
    else if (g == 1) pool_wave<4>(P, layer, b, t0, g, lw, lane, dry);
    else if (g == 2) pool_wave<8>(P, layer, b, t0, g, lw, lane, dry);
    else pool_wave<16>(P, layer, b, t0, g, lw, lane, dry);
}

constexpr int KS_STRIDE = 144, VS_STRIDE = 520, ATT_VOFF = 256 * KS_STRIDE;
template <bool STAGE, bool COMPUTE>
__device__ __forceinline__ void attn_unit(const Params& P, int layer, int unit, LAS unsigned char* lds, LAS unsigned char* inv_strip, int tid, int wid, int lane, bool dry = false) {
    unsigned char* ws = P.ws;
    const bf16_t* Q = (const bf16_t*)(ws + WS_Q); const bf16_t* K = (const bf16_t*)(ws + WS_K); const bf16_t* VT = (const bf16_t*)(ws + WS_VT);
    bf16_t* GM = (bf16_t*)(ws + WS_GM);
    const int kvh = unit & 1, n = (unit >> 1) & 15, b = unit >> 5;
    const int tk0 = n * 128 - 128;
    if (STAGE) {
#pragma unroll
    for (int i = 0; i < 4; ++i) { const int idx = tid + 512 * i; const int row = idx >> 3, c = idx & 7; const int t = tk0 + row;
        u32x4 v = {0u, 0u, 0u, 0u}; if (t >= 0) v = *(const u32x4*)(K + ((size_t)b * SEQ + t) * 128 + kvh * 64 + c * 8);
        *(LAS u32x4*)(lds + row * KS_STRIDE + c * 16) = v; }
#pragma unroll
    for (int i = 0; i < 4; ++i) { const int idx = tid + 512 * i; const int d = idx >> 5, c = idx & 31; const int t = tk0 + 8 * c;
        u32x4 v = {0u, 0u, 0u, 0u}; if (t >= 0) v = *(const u32x4*)(VT + ((size_t)(b * 2 + kvh) * 64 + d) * SEQ + t);
        LAS u32x2* dst = (LAS u32x2*)(lds + ATT_VOFF + d * VS_STRIDE + c * 16); dst[0] = (u32x2){v.x, v.y}; dst[1] = (u32x2){v.z, v.w}; }
    }
    if (!COMPUTE) return;
    const int hq = wid >> 1, qh = wid & 1, head = kvh * 4 + hq;
    const int r31 = lane & 31, h = lane >> 5;
    const float sink2 = PRM(PRM_SINK)[layer * 8 + head] * LOG2E;
    const bf16_t* qp0 = Q + ((size_t)b * SEQ + n * 128 + 64 * qh + r31) * 512 + head * 64 + 8 * h;
    bf16x8 nq[4];
#pragma unroll
    for (int ks = 0; ks < 4; ++ks) nq[ks] = *(const bf16x8*)(qp0 + 16 * ks);
#pragma unroll 1
    for (int qb2 = 0; qb2 < 2; ++qb2) {
        const int qb = 2 * qh + qb2, i0 = 32 * qb;
        bf16x8 qf[4];
#pragma unroll
        for (int ks = 0; ks < 4; ++ks) qf[ks] = nq[ks];
        if (qb2 == 0) {
#pragma unroll
            for (int ks = 0; ks < 4; ++ks) nq[ks] = *(const bf16x8*)(qp0 + (size_t)32 * 512 + 16 * ks); }
        f32x16 s[5];
#pragma unroll
        for (int kt = 0; kt < 5; ++kt) {
#pragma unroll
            for (int e = 0; e < 16; ++e) s[kt][e] = 0.f;
            const LAS unsigned char* kb = lds + (32 * (qb + kt) + r31) * KS_STRIDE + 16 * h;
#pragma unroll
            for (int ks = 0; ks < 4; ++ks) { const bf16x8 a = *(const LAS bf16x8*)(kb + 32 * ks); s[kt] = __builtin_amdgcn_mfma_f32_32x32x16_bf16(a, qf[ks], s[kt], 0, 0, 0); }
        }
        const float dqf = (float)(r31 - 4 * h);
        float mx = sink2;
#pragma unroll
        for (int kt = 0; kt < 5; ++kt) { if ((n > 0) || (qb + kt >= 4)) {
#pragma unroll
            for (int e = 0; e < 16; ++e) mx = fmaxf(mx, s[kt][e]); } }
        mx = fmaxf(mx, __shfl_xor(mx, 32));
        float sum = 0.f;
#pragma unroll
        for (int kt = 0; kt < 5; ++kt) { if ((n > 0) || (qb + kt >= 4)) {
#pragma unroll
            for (int e = 0; e < 16; ++e) { const float ko = (float)((e & 3) + 8 * (e >> 2));
                float p = __builtin_amdgcn_exp2f(s[kt][e] - mx);
                if (kt == 0) p *= __builtin_amdgcn_fmed3f(ko - dqf, 0.f, 1.f);
                if (kt == 4) p *= __builtin_amdgcn_fmed3f(dqf - ko + 1.0f, 0.f, 1.f);
                s[kt][e] = p; sum += p; } }
          else {
#pragma unroll
            for (int e = 0; e < 16; ++e) s[kt][e] = 0.f; } }
        sum += __shfl_xor(sum, 32);
        const float inv = 1.0f / (sum + __builtin_amdgcn_exp2f(sink2 - mx));
        bf16_t* gbase = GM + ((size_t)b * SEQ + n * 128 + i0 + r31) * 1024 + 256 + head * 64 + 8 * h;
        u32x4 gts[2][2];
#pragma unroll
        for (int db = 0; db < 2; ++db)
#pragma unroll
            for (int k = 0; k < 2; ++k) gts[db][k] = *(const u32x4*)(gbase + 32 * db + 16 * k);
        f32x16 o[2];
#pragma unroll
        for (int e = 0; e < 16; ++e) { o[0][e] = 0.f; o[1][e] = 0.f; }
#pragma unroll
        for (int kt = 0; kt < 5; ++kt)
#pragma unroll
            for (int s2 = 0; s2 < 2; ++s2) {
                u32x4 pw; pw.x = pk_bf16(s[kt][8 * s2 + 0], s[kt][8 * s2 + 1]); pw.y = pk_bf16(s[kt][8 * s2 + 2], s[kt][8 * s2 + 3]);
                pw.z = pk_bf16(s[kt][8 * s2 + 4], s[kt][8 * s2 + 5]); pw.w = pk_bf16(s[kt][8 * s2 + 6], s[kt][8 * s2 + 7]);
                const bf16x8 pf = __builtin_bit_cast(bf16x8, pw);
#pragma unroll
                for (int db = 0; db < 2; ++db) {
                    const LAS unsigned char* vb = lds + ATT_VOFF + (32 * db + r31) * VS_STRIDE + (32 * (qb + kt) + 16 * s2 + 4 * h) * 2;
                    const u32x2 v0 = *(const LAS u32x2*)vb, v1 = *(const LAS u32x2*)(vb + 16);
                    const u32x4 vw = {v0.x, v0.y, v1.x, v1.y};
                    o[db] = __builtin_amdgcn_mfma_f32_32x32x16_bf16(__builtin_bit_cast(bf16x8, vw), pf, o[db], 0, 0, 0);
                }
            }
#pragma unroll
        for (int db = 0; db < 2; ++db)
#pragma unroll
            for (int k = 0; k < 2; ++k) {
                float v[8];
#pragma unroll
                for (int i = 0; i < 4; ++i) { const auto sw = __builtin_amdgcn_permlane32_swap(__float_as_uint(o[db][8 * k + i]), __float_as_uint(o[db][8 * k + 4 + i]), false, false);
                    v[i] = __uint_as_float(sw[0]) * inv; v[4 + i] = __uint_as_float(sw[1]) * inv; }
                const u32x4 gg = gts[db][k]; const unsigned g0 = gg[0], g1 = gg[1], g2 = gg[2], g3 = gg[3];
                u32x4 w; w.x = pk_bf16(v[0] * bf_lo(g0), v[1] * bf_hi(g0)); w.y = pk_bf16(v[2] * bf_lo(g1), v[3] * bf_hi(g1));
                w.z = pk_bf16(v[4] * bf_lo(g2), v[5] * bf_hi(g2)); w.w = pk_bf16(v[6] * bf_lo(g3), v[7] * bf_hi(g3));
                *(u32x4*)(gbase + 32 * db + 16 * k) = dry ? gg : w;
            }
    }
}

__device__ __forceinline__ float tanhf_(float x) { const float e = fast_exp(2.0f * x); return 1.0f - 2.0f * __builtin_amdgcn_rcpf(e + 1.0f); }
struct PrepRaw { u32x2 r, k, v; };
__device__ __forceinline__ PrepRaw prep_load(const bf16_t* row, int c0, int lane) {
    PrepRaw x; x.r = *(const u32x2*)(row + c0); x.k = *(const u32x2*)(row + 256 + c0); x.v = *(const u32x2*)(row + 512 + c0); return x;
}
struct PrepConst { f32x4 mr, mk, mv, w0, a0, kkp, kap, rkp; };
__device__ __forceinline__ void prep_token(const Params& P, int layer, int r, int lane, const LAS unsigned char* lup, int ti, const PrepRaw& cu, const PrepRaw& pv_, float (&om)[4], const PrepConst& C, float& keep_rkr, float& keep_kr) {
    unsigned char* ws = P.ws;
    const int b = r >> 11, t = r & (SEQ - 1), c0 = 4 * lane, hh = lane >> 4;
    float rs[4], ks[4], vs[4];
    { const u32x2 cr = cu.r, ck = cu.k, cv = cu.v, pr = pv_.r, pk = pv_.k, pv = pv_.v;
      const f32x4 mr = C.mr, mk = C.mk, mv = C.mv;
      const float xr[4] = {bf_lo(cr.x), bf_hi(cr.x), bf_lo(cr.y), bf_hi(cr.y)}, yr[4] = {bf_lo(pr.x), bf_hi(pr.x), bf_lo(pr.y), bf_hi(pr.y)};
      const float xk[4] = {bf_lo(ck.x), bf_hi(ck.x), bf_lo(ck.y), bf_hi(ck.y)}, yk[4] = {bf_lo(pk.x), bf_hi(pk.x), bf_lo(pk.y), bf_hi(pk.y)};
      const float xv[4] = {bf_lo(cv.x), bf_hi(cv.x), bf_lo(cv.y), bf_hi(cv.y)}, yv[4] = {bf_lo(pv.x), bf_hi(pv.x), bf_lo(pv.y), bf_hi(pv.y)};
#pragma unroll
      for (int i = 0; i < 4; ++i) { rs[i] = xr[i] + (yr[i] - xr[i]) * mr[i]; ks[i] = xk[i] + (yk[i] - xk[i]) * mk[i]; vs[i] = xv[i] + (yv[i] - xv[i]) * mv[i]; } }
    float lw[4], la[4];
    { const u32x2 hw = *(const LAS u32x2*)(lup + (size_t)ti * 512 + c0 * 2), ha = *(const LAS u32x2*)(lup + 8192 + (size_t)ti * 512 + c0 * 2);
      const unsigned w0_ = hw[0], w1_ = hw[1], a0_ = ha[0], a1_ = ha[1];
      lw[0] = (float)as_h2(w0_).x; lw[1] = (float)as_h2(w0_).y; lw[2] = (float)as_h2(w1_).x; lw[3] = (float)as_h2(w1_).y;
      la[0] = (float)as_h2(a0_).x; la[1] = (float)as_h2(a0_).y; la[2] = (float)as_h2(a1_).x; la[3] = (float)as_h2(a1_).y; }
    const f32x4 w0 = C.w0, a0 = C.a0, kkp = C.kkp, kap = C.kap, rkp = C.rkp;
    float wv[4], av[4], kk[4], kt[4], bb[4];
    float ssq = 0.f, br = 0.f, kr = 0.f, rkr = 0.f;
#pragma unroll
    for (int i = 0; i < 4; ++i) {
        wv[i] = fast_exp(-0.6065306597126334f * sigmoidf_(w0[i] + lw[i]));
        av[i] = sigmoidf_(a0[i] + la[i]);
        kk[i] = ks[i] * kkp[i]; ssq += kk[i] * kk[i];
        kt[i] = ks[i] * (1.0f + (av[i] - 1.0f) * kap[i]);
        kr += kt[i] * rs[i]; rkr += rs[i] * kt[i] * rkp[i];
    }
    ssq = sum16d(ssq);
    const float kn = fminf(__builtin_amdgcn_rsqf(ssq), 1e12f);
#pragma unroll
    for (int i = 0; i < 4; ++i) { kk[i] *= kn; bb[i] = kk[i] * av[i]; br += bb[i] * rs[i]; }
    br = sum16d(br); kr = sum16d(kr); rkr = sum16d(rkr);
    float wr[4];
#pragma unroll
    for (int i = 0; i < 4; ++i) wr[i] = wv[i] * rs[i] - br * kk[i];
    const size_t rec = ((size_t)(b * 4 + hh) * SEQ + t);
    const int l16 = lane & 15;
#if SCAN_IMPL != 1
    u32x4* pa = (u32x4*)(ws + WS_PA) + rec * 32 + 2 * l16;
    pa[0] = (u32x4){pk_f16(kk[0], kk[1]), pk_f16(bb[0], bb[1]), pk_f16(kt[0], kt[1]), pk_f16(wr[0], wr[1])};
    pa[1] = (u32x4){pk_f16(kk[2], kk[3]), pk_f16(bb[2], bb[3]), pk_f16(kt[2], kt[3]), pk_f16(wr[2], wr[3])};
    *((f32x4*)(ws + WS_PW) + rec * 16 + l16) = (f32x4){wv[0], wv[1], wv[2], wv[3]};
#endif
#if SCAN_IMPL != 0
    if (SCAN_IMPL == 1 || layer == 0) {
        float uk[4], uw[4], bh[4], kh[4];
#pragma unroll
        for (int i = 0; i < 4; ++i) { uk[i] = om[i] * kk[i]; uw[i] = om[i] * wr[i]; om[i] *= wv[i]; const float inv = __builtin_amdgcn_rcpf(om[i]); bh[i] = bb[i] * inv; kh[i] = kt[i] * (inv * 0.0625f); }
        { const bool odd = lane & 1;
          u32x2* pb = (u32x2*)(ws + WS_PB) + rec * 64 + (odd ? 16 + l16 - 1 : l16);
          const unsigned uk0 = pk_f16(uk[0], uk[1]), uk1 = pk_f16(uk[2], uk[3]), uw0 = pk_f16(uw[0], uw[1]), uw1 = pk_f16(uw[2], uw[3]);
          const unsigned bh0 = pk_f16(bh[0], bh[1]), bh1 = pk_f16(bh[2], bh[3]), kh0 = pk_f16(kh[0], kh[1]), kh1 = pk_f16(kh[2], kh[3]);
          const unsigned s0 = odd ? uk0 : uw0, s1 = odd ? uk1 : uw1, s2 = odd ? bh0 : kh0, s3 = odd ? bh1 : kh1;
          const unsigned q0 = (unsigned)__builtin_amdgcn_update_dpp(0, (int)s0, 0xB1, 0xf, 0xf, true), q1 = (unsigned)__builtin_amdgcn_update_dpp(0, (int)s1, 0xB1, 0xf, 0xf, true);
          const unsigned q2 = (unsigned)__builtin_amdgcn_update_dpp(0, (int)s2, 0xB1, 0xf, 0xf, true), q3 = (unsigned)__builtin_amdgcn_update_dpp(0, (int)s3, 0xB1, 0xf, 0xf, true);
          *(u32x4*)pb = odd ? (u32x4){q0, q1, uw0, uw1} : (u32x4){uk0, uk1, q0, q1};
          *(u32x4*)(pb + 32) = odd ? (u32x4){q2, q3, kh0, kh1} : (u32x4){bh0, bh1, q2, q3}; }
#if DBG_DOUBLE & 4096
        { u32x2* pd = (u32x2*)(ws + WS_PW) + (rec & 65535) * 64 + l16;
          pd[0] = (u32x2){pk_f16(uk[0], uk[1]), pk_f16(uk[2], uk[3])}; pd[16] = (u32x2){pk_f16(uw[0], uw[1]), pk_f16(uw[2], uw[3])};
          pd[32] = (u32x2){pk_f16(bh[0], bh[1]), pk_f16(bh[2], bh[3])}; pd[48] = (u32x2){pk_f16(kh[0], kh[1]), pk_f16(kh[2], kh[3])}; }
#endif
        if ((t & 15) == 15) *((f32x4*)(ws + WS_PO) + ((size_t)(b * 4 + hh) * (SEQ / 16) + (t >> 4)) * 16 + l16) = (f32x4){om[0], om[1], om[2], om[3]};
    }
#endif
    *((u32x4*)(ws + WS_PV) + rec * 16 + l16) = (u32x4){pk_f16(vs[0], vs[0] * kr), pk_f16(vs[1], vs[1] * kr), pk_f16(vs[2], vs[2] * kr), pk_f16(vs[3], vs[3] * kr)};
    if (l16 == ti) { keep_rkr = rkr; keep_kr = kr; }
}
__device__ __forceinline__ void prep_run(const Params& P, int layer, int r0, int lane, LAS unsigned char* lup) {
    unsigned char* ws = P.ws;
    const bf16_t* RIN = (const bf16_t*)(ws + WS_RIN);
    const int c0 = 4 * lane;
    {
        const int tok = lane & 15, kq = lane >> 4, r = r0 + tok; const bool hp = (r & (SEQ - 1)) != 0;
        const float* mu = PRM(PRM_MU) + layer * DSH + 768 + 8 * kq;
        const bf16_t* cw = RIN + (size_t)r * DSH + 768 + 8 * kq;
        const u32x4 cww = *(const u32x4*)cw, caw = *(const u32x4*)(cw + 32);
        u32x4 pww = {0u, 0u, 0u, 0u}, paw = {0u, 0u, 0u, 0u};
        if (hp) { pww = *(const u32x4*)(cw - DSH); paw = *(const u32x4*)(cw - DSH + 32); }
        const f32x4 mw0 = *(const f32x4*)mu, mw1 = *(const f32x4*)(mu + 4), ma0 = *(const f32x4*)(mu + 32), ma1 = *(const f32x4*)(mu + 36);
        u32x4 fw, fa;
#pragma unroll
        for (int q = 0; q < 4; ++q) { const unsigned cwq = cww[q], pwq = pww[q], caq = caw[q], paq = paw[q];
            const float mlo = q < 2 ? mw0[2 * q] : mw1[2 * q - 4], mhi = q < 2 ? mw0[2 * q + 1] : mw1[2 * q - 3];
            const float nlo = q < 2 ? ma0[2 * q] : ma1[2 * q - 4], nhi = q < 2 ? ma0[2 * q + 1] : ma1[2 * q - 3];
            const float xl = bf_lo(cwq), xh = bf_hi(cwq), yl = bf_lo(caq), yh = bf_hi(caq);
            fw[q] = pk_bf16(tanhf_(xl + (bf_lo(pwq) - xl) * mlo), tanhf_(xh + (bf_hi(pwq) - xh) * mhi));
            fa[q] = pk_bf16(yl + (bf_lo(paq) - yl) * nlo, yh + (bf_hi(paq) - yh) * nhi); }
        const bf16x8 Aw = __builtin_bit_cast(bf16x8, fw), Aa = __builtin_bit_cast(bf16x8, fa);
        const u32x4* bfw = (const u32x4*)(ws + WS_WUPF) + (size_t)layer * 2 * 16 * 64 + lane;
#pragma unroll 4
        for (int nb = 0; nb < 16; ++nb) {
            const u32x4 bw = bfw[nb * 64], ba = bfw[(16 + nb) * 64];
            f32x4 z = {0.f, 0.f, 0.f, 0.f};
            const f32x4 dw = __builtin_amdgcn_mfma_f32_16x16x32_bf16(Aw, __builtin_bit_cast(bf16x8, bw), z, 0, 0, 0);
            const f32x4 da = __builtin_amdgcn_mfma_f32_16x16x32_bf16(Aa, __builtin_bit_cast(bf16x8, ba), z, 0, 0, 0);
            LAS _Float16* dst = (LAS _Float16*)lup + (size_t)(4 * kq) * 256 + 16 * nb + tok;
#pragma unroll
            for (int reg = 0; reg < 4; ++reg) { dst[reg * 256] = (_Float16)dw[reg]; dst[4096 + reg * 256] = (_Float16)da[reg]; }
        }
        asm volatile("s_waitcnt lgkmcnt(0)" ::: "memory");
    }
    PrepRaw pv_; pv_.r = (u32x2){0u, 0u}; pv_.k = (u32x2){0u, 0u}; pv_.v = (u32x2){0u, 0u};
    if ((r0 & (SEQ - 1)) != 0) pv_ = prep_load(RIN + (size_t)(r0 - 1) * DSH, c0, lane);
    PrepRaw cu = prep_load(RIN + (size_t)r0 * DSH, c0, lane);
    float om[4] = {1.f, 1.f, 1.f, 1.f};
    PrepConst C;
    { const float* mu = PRM(PRM_MU) + layer * DSH;
      C.mr = *(const f32x4*)(mu + c0); C.mk = *(const f32x4*)(mu + 256 + c0); C.mv = *(const f32x4*)(mu + 512 + c0);
      C.w0 = *(const f32x4*)(PRM(PRM_W0) + layer * 256 + c0); C.a0 = *(const f32x4*)(PRM(PRM_A0) + layer * 256 + c0);
      C.kkp = *(const f32x4*)(PRM(PRM_KK) + layer * 256 + c0); C.kap = *(const f32x4*)(PRM(PRM_KA) + layer * 256 + c0); C.rkp = *(const f32x4*)(PRM(PRM_RK) + layer * 256 + c0); }
    float keep_rkr = 0.f, keep_kr = 0.f;
#pragma unroll 2
    for (int i = 0; i < 16; ++i) {
        PrepRaw nx = cu;
        if (i < 15) nx = prep_load(RIN + (size_t)(r0 + i + 1) * DSH, c0, lane);
        prep_token(P, layer, r0 + i, lane, lup, i, cu, pv_, om, C, keep_rkr, keep_kr);
        pv_ = cu; cu = nx;
    }
    { const size_t o = (size_t)(r0 + (lane & 15)) * 4 + (lane >> 4); ((float*)(ws + WS_RKR))[o] = keep_rkr; ((float*)(ws + WS_KRA))[o] = keep_kr; }
    asm volatile("s_waitcnt lgkmcnt(0)" ::: "memory");
}

__device__ __forceinline__ void decode_mix(const Params& P, int layer, int tok, int part, LAS unsigned char* lds, int tid, int wid, int lane) {
    unsigned char* ws = P.ws;
    const float* z = (const float*)(ws + WS_ZS) + (size_t)tok * DIN;
    bf16_t* MIXS = (bf16_t*)(ws + WS_MIXS) + (size_t)tok * DM;
    constexpr int DK_ROW = 528, DK_V = 67072, DK_SCR = 134144;
    LAS float* L = (LAS float*)(lds + DK_SCR);
    LAS float* pooled = L;
    LAS float* qs = L + 256;
    LAS float* knew = L + 768;
    LAS float* vnew = L + 896;
    LAS float* scs = L + 1024;
    LAS float* xs = (LAS float*)lds;
    LAS float* kkn = xs + 832;
    LAS float* bvec = kkn + 256;
    LAS float* wvv = bvec + 256;
    LAS float* ktv = wvv + 256;
    LAS float* rrv = ktv + 256;
    LAS float* vvv = rrv + 256;
    LAS float* ov = vvv + 256;
    LAS float* rkrs = ov + 256;
    const size_t lt = (size_t)layer * MS + tok;
    if (part == 0) {
    const float* kc = INP(3) + lt * 128 * 128; const float* vc = INP(4) + lt * 128 * 128;
    {
        const f32x4* ks_ = (const f32x4*)(kc + 128); const f32x4* vs_ = (const f32x4*)(vc + 128);
        f32x4* kd = (f32x4*)(P.out + O_KS + lt * 128 * 128); f32x4* vd = (f32x4*)(P.out + O_VS + lt * 128 * 128);
        f32x4 kt_[8], vt_[8];
#pragma unroll
        for (int q = 0; q < 8; ++q) { const int i = tid + 512 * q; if (i < 127 * 32) { kt_[q] = ks_[i]; vt_[q] = vs_[i]; } }
#pragma unroll
        for (int q = 0; q < 8; ++q) { const int i = tid + 512 * q; if (i < 127 * 32) { kd[i] = kt_[q]; vd[i] = vt_[q];
            *(LAS f32x4*)(lds + (i >> 5) * DK_ROW + (i & 31) * 16) = kt_[q]; *(LAS f32x4*)(lds + DK_V + (i >> 5) * DK_ROW + (i & 31) * 16) = vt_[q]; } }
    }
    const f32x2 cs = ((const f32x2*)(ws + WS_ROPE))[2048 * 32 + (lane & 31)];
    {
        const float x = z[512 + wid * 64 + lane];
        const float ss = wave_sum(x * x);
        const float xn = x * (1.0f / sqrtf(ss * (1.0f / 64.0f) + 1e-6f)) * PRM(PRM_QG)[layer * 64 + lane];
        const float pr = __shfl_xor(xn, 32);
        qs[wid * 64 + lane] = (lane < 32 ? xn * cs.x - pr * cs.y : pr * cs.y + xn * cs.x) * 0.125f;
    }
    if (wid < 2) {
        const float x = z[1024 + wid * 64 + lane];
        const float ss = wave_sum(x * x);
        const float xn = x * (1.0f / sqrtf(ss * (1.0f / 64.0f) + 1e-6f)) * PRM(PRM_KG)[layer * 64 + lane];
        const float pr = __shfl_xor(xn, 32);
        const float kv = lane < 32 ? xn * cs.x - pr * cs.y : pr * cs.y + xn * cs.x;
        knew[wid * 64 + lane] = kv;
        P.out[O_KS + (lt * 128 + 127) * 128 + wid * 64 + lane] = kv;
    } else if (wid < 4) {
        const float x = z[1152 + (wid - 2) * 64 + lane];
        vnew[(wid - 2) * 64 + lane] = x;
        P.out[O_VS + (lt * 128 + 127) * 128 + (wid - 2) * 64 + lane] = x;
    }
    __syncthreads();
    {
        const int kvh = wid >> 2;
#pragma unroll
        for (int jj = 0; jj < 2; ++jj) { const int j = lane + 64 * jj; float a = 0.f;
            if (j < 127) { const LAS f32x4* kr_ = (const LAS f32x4*)(lds + j * DK_ROW + kvh * 256);
#pragma unroll
                for (int d4 = 0; d4 < 16; ++d4) { const f32x4 kq = kr_[d4]; const LAS float* qq = qs + wid * 64 + 4 * d4; a += kq[0] * qq[0] + kq[1] * qq[1] + kq[2] * qq[2] + kq[3] * qq[3]; } }
            else {
#pragma unroll 8
                for (int d = 0; d < 64; ++d) a += knew[kvh * 64 + d] * qs[wid * 64 + d]; }
            scs[wid * 128 + j] = a; }
    }
    __syncthreads();
    {
        const float sk = PRM(PRM_SINK)[layer * 8 + wid];
        const float s0 = scs[wid * 128 + lane], s1 = scs[wid * 128 + 64 + lane];
        const float m = fmaxf(wave_max(fmaxf(s0, s1)), sk);
        const float p0 = fast_exp(s0 - m), p1 = fast_exp(s1 - m);
        const float den = wave_sum(p0 + p1) + fast_exp(sk - m);
        scs[wid * 128 + lane] = p0 / den; scs[wid * 128 + 64 + lane] = p1 / den;
    }
    __syncthreads();
    {
        const int kvh = wid >> 2; float o = 0.f;
        const LAS float* vb = (const LAS float*)(lds + DK_V) + kvh * 64 + lane;
#pragma unroll 16
        for (int j = 0; j < 127; ++j) o += scs[wid * 128 + j] * vb[j * (DK_ROW / 4)];
        o += scs[wid * 128 + 127] * vnew[kvh * 64 + lane];
        MIXS[256 + wid * 64 + lane] = f2bf(o * siluf_(z[1280 + wid * 64 + lane]));
    }
    } else {
    const int row = tid >> 1, half = tid & 1, hd = row >> 6;
    const f32x4* sp = (const f32x4*)(INP(6) + (lt * 256 + row) * 64 + 32 * half);
    f32x4 S[8];
#pragma unroll
    for (int i = 0; i < 8; ++i) S[i] = sp[i];
    const float* mu = PRM(PRM_MU) + layer * DSH;
    const float* shp = INP(5) + lt * DSH;
    { const int i0 = tid, i1 = tid + 512;
      float x0 = 0.f, x1 = 0.f, s0 = 0.f, s1 = 0.f, m0 = 0.f, m1 = 0.f;
      if (i0 < DSH) { x0 = z[1792 + i0]; s0 = shp[i0]; m0 = mu[i0]; }
      if (i1 < DSH) { x1 = z[1792 + i1]; s1 = shp[i1]; m1 = mu[i1]; }
      if (i0 < DSH) { P.out[O_SHS + lt * DSH + i0] = x0; xs[i0] = x0 + (s0 - x0) * m0; }
      if (i1 < DSH) { P.out[O_SHS + lt * DSH + i1] = x1; xs[i1] = x1 + (s1 - x1) * m1; } }
    if (tid >= 256) {
        const int c = tid - 256, g = c >> 6, W_ = 2 << g;
        const float* buf = INP(2) + lt * 15 * 256 + c;
        float* po = P.out + O_POOLS + lt * 15 * 256 + c;
        const float u = z[c];
        float eb[15];
#pragma unroll
        for (int j = 0; j < 15; ++j) eb[j] = buf[j * 256];
        float win = u;
#pragma unroll
        for (int j = 0; j < 15; ++j) { if (j >= 16 - W_) win += eb[j]; if (j >= 1) po[(j - 1) * 256] = eb[j]; }
        po[14 * 256] = u;
        pooled[c] = win / (float)W_ - u;
    }
    __syncthreads();
    if (tid >= 256) {
        const int c = tid - 256, g = c >> 6, d = c & 63;
        const float* pw = PRM(PRM_POOLW) + ((size_t)(layer * 4 + g) * 64) * 64 + d;
        float a = 0.f;
#pragma unroll 32
        for (int cc = 0; cc < 64; ++cc) a += pooled[64 * g + cc] * pw[cc * 64];
        MIXS[c] = f2bf(a * PRM(PRM_POOLSC)[layer * 256 + c] * siluf_(z[256 + c]));
    }
    if (tid < 256) {
        const int c = tid;
        float lw = 0.f, la = 0.f;
#pragma unroll 16
        for (int j = 0; j < 32; ++j) { lw += tanhf_(xs[768 + j]) * PRM(PRM_WUP)[((size_t)layer * 32 + j) * 256 + c]; la += xs[800 + j] * PRM(PRM_AUP)[((size_t)layer * 32 + j) * 256 + c]; }
        const float wv = fast_exp(-0.6065306597126334f * sigmoidf_(PRM(PRM_W0)[layer * 256 + c] + lw));
        const float av = sigmoidf_(PRM(PRM_A0)[layer * 256 + c] + la);
        const float rr = xs[c], kx = xs[256 + c], vx = xs[512 + c];
        float kk = kx * PRM(PRM_KK)[layer * 256 + c];
        const float ssq = wave_sum(kk * kk);
        kk = kk / fmaxf(sqrtf(ssq), 1e-12f);
        const float kt = kx * (1.0f + (av - 1.0f) * PRM(PRM_KA)[layer * 256 + c]);
        const float rkr = wave_sum(rr * kt * PRM(PRM_RK)[layer * 256 + c]);
        kkn[c] = kk; bvec[c] = kk * av; wvv[c] = wv; ktv[c] = kt; rrv[c] = rr; vvv[c] = vx;
        if (lane == 0) rkrs[wid] = rkr;
    }
    __syncthreads();
    {
        f32x4* so = (f32x4*)(P.out + O_WKS + (lt * 256 + row) * 64 + 32 * half);
        float sa = 0.f;
#pragma unroll
        for (int i = 0; i < 8; ++i) {
#pragma unroll
            for (int e = 0; e < 4; ++e) sa += S[i][e] * kkn[hd * 64 + 32 * half + 4 * i + e]; }
        sa += __shfl_xor(sa, 1);
        const float vr = vvv[row]; float o = 0.f;
#pragma unroll
        for (int i = 0; i < 8; ++i) {
#pragma unroll
            for (int e = 0; e < 4; ++e) { const int k = hd * 64 + 32 * half + 4 * i + e;
                const float sn = S[i][e] * wvv[k] - sa * bvec[k] + vr * ktv[k]; S[i][e] = sn; o += sn * rrv[k]; }
            so[i] = S[i]; }
        o += __shfl_xor(o, 1);
        if (half == 0) ov[row] = o;
    }
    __syncthreads();
    if (tid < 256) {
        const int c = tid;
        const float o = ov[c];
        const float mean = wave_sum(o) * (1.0f / 64.0f);
        const float dlt = o - mean;
        const float var = wave_sum(dlt * dlt) * (1.0f / 64.0f);
        const float on = dlt * (1.0f / sqrtf(var + 64e-5f)) * PRM(PRM_LNG)[layer * 256 + c] + PRM(PRM_LNB)[layer * 256 + c];
        MIXS[768 + c] = f2bf((on + rkrs[wid] * vvv[c]) * siluf_(z[2624 + c]));
    }
    }
    __syncthreads();
}

constexpr int SC_TC = 32, SC_A1A = 0, SC_A1B = SC_TC * 256, SC_A2A = 2 * SC_TC * 256, SC_A2B = 3 * SC_TC * 256, SC_W = 4 * SC_TC * 256, SC_V = 5 * SC_TC * 256, SC_BUF = SC_V + SC_TC * 128;
#define DPP_ADD(z, CTRL) ((z) + __builtin_bit_cast(float, __builtin_amdgcn_update_dpp(0, __builtin_bit_cast(int, (z)), (CTRL), 0xf, 0xf, true)))
__device__ __forceinline__ void scan_unit(const Params& P, int layer, int unit, LAS unsigned char* lds, int tid, int wid, int lane) {
    unsigned char* ws = P.ws;
    const int hb = unit >> 2, rg = unit & 3;
    const int p = lane & 15, rowl = (wid & 3) * 4 + (lane >> 4), row = 16 * rg + rowl;
    const bool odd = (lane & 1) != 0, worker = wid < 4;
    const unsigned char* gA = ws + WS_PA + (size_t)hb * SEQ * 512;
    const unsigned char* gW = ws + WS_PW + (size_t)hb * SEQ * 256;
    const unsigned char* gV = ws + WS_PV + ((size_t)hb * SEQ * 64 + 16 * rg) * 4;
    const int stid = tid - 256;
    u32x4 ra[4], rw[2], rv = {0u, 0u, 0u, 0u};
#define SC_GLOAD(c) do { if (!worker) { const size_t t0_ = (size_t)(c) * SC_TC; \
        _Pragma("unroll") for (int i = 0; i < 4; ++i) ra[i] = *(const u32x4*)(gA + t0_ * 512 + (size_t)(stid + 256 * i) * 16); \
        _Pragma("unroll") for (int i = 0; i < 2; ++i) rw[i] = *(const u32x4*)(gW + t0_ * 256 + (size_t)(stid + 256 * i) * 16); \
        if (stid < 128) rv = *(const u32x4*)(gV + (t0_ + (stid >> 2)) * 256 + (stid & 3) * 16); } } while (0)
#define SC_LSTORE(buf) do { if (!worker) { LAS unsigned char* B_ = lds + (buf) * SC_BUF; \
        _Pragma("unroll") for (int i = 0; i < 4; ++i) { const int idx = stid + 256 * i; const int tk_ = idx >> 5, pr_ = idx & 31, sl_ = pr_ >> 1, hf_ = pr_ & 1; \
            const unsigned x0 = ra[i][0], x1 = ra[i][1], x2 = ra[i][2], x3 = ra[i][3]; const h2_t h0 = as_h2(x0), h1 = as_h2(x1), h2 = as_h2(x2), h3 = as_h2(x3); \
            *(LAS f32x4*)(B_ + (hf_ ? SC_A1B : SC_A1A) + tk_ * 256 + sl_ * 16) = (f32x4){(float)h0.x, (float)h3.x, (float)h0.y, (float)h3.y}; \
            *(LAS f32x2*)(B_ + SC_A2A + tk_ * 256 + sl_ * 16 + hf_ * 8) = (f32x2){(float)h1.x, (float)h1.y}; \
            *(LAS f32x2*)(B_ + SC_A2B + tk_ * 256 + sl_ * 16 + hf_ * 8) = (f32x2){(float)h2.x, (float)h2.y}; } \
        _Pragma("unroll") for (int i = 0; i < 2; ++i) *(LAS u32x4*)(B_ + SC_W + (stid + 256 * i) * 16) = rw[i]; \
        if (stid < 128) { const unsigned y0 = rv[0], y1 = rv[1], y2 = rv[2], y3 = rv[3]; const h2_t g0 = as_h2(y0), g1 = as_h2(y1), g2 = as_h2(y2), g3 = as_h2(y3); \
            *(LAS f32x4*)(B_ + SC_V + stid * 32) = (f32x4){(float)g0.x, (float)g0.y, (float)g1.x, (float)g1.y}; \
            *(LAS f32x4*)(B_ + SC_V + stid * 32 + 16) = (f32x4){(float)g2.x, (float)g2.y, (float)g3.x, (float)g3.y}; } } } while (0)
    f32x2 Sa = {0.f, 0.f}, Sb = {0.f, 0.f};
    SC_GLOAD(0); SC_LSTORE(0);
    __syncthreads();
    const __amdgpu_buffer_rsrc_t orsrc = __builtin_amdgcn_make_buffer_rsrc((void*)(ws + WS_ORAW), 0, 32 * 1024 * 1024, 0x00020000);
    const unsigned obase = (unsigned)((((size_t)(hb >> 2) * SEQ) * 256 + (hb & 3) * 64 + row) * 4);
    for (int c = 0; c < SEQ / SC_TC; ++c) {
        if (c + 1 < SEQ / SC_TC) SC_GLOAD(c + 1);
        if (worker) {
            const LAS unsigned char* B = lds + (c & 1) * SC_BUF + p * 16;
            const LAS unsigned char* pV = lds + (c & 1) * SC_BUF + SC_V + rowl * 8;
            unsigned ooff = (p == 1) ? obase + (unsigned)c * (SC_TC * 1024) : 0x7fffff00u;
            f32x4 n1a = *(const LAS f32x4*)(B + SC_A1A), n1b = *(const LAS f32x4*)(B + SC_A1B), n2a = *(const LAS f32x4*)(B + SC_A2A), n2b = *(const LAS f32x4*)(B + SC_A2B), nw = *(const LAS f32x4*)(B + SC_W);
            f32x2 nv = *(const LAS f32x2*)pV;
#pragma unroll 8
            for (int tt = 0; tt < SC_TC; ++tt) {
                const f32x4 a1a = n1a, a1b = n1b, bb = n2a, kt = n2b, w = nw; const f32x2 v2 = nv;
                { const int o_ = (tt + 1) * 256;
                  n1a = *(const LAS f32x4*)(B + SC_A1A + o_); n1b = *(const LAS f32x4*)(B + SC_A1B + o_); n2a = *(const LAS f32x4*)(B + SC_A2A + o_); n2b = *(const LAS f32x4*)(B + SC_A2B + o_);
                  nw = *(const LAS f32x4*)(B + SC_W + o_); nv = *(const LAS f32x2*)(pV + (tt + 1) * 128); }
                f32x2 pq = (f32x2){a1a[0], a1a[1]} * Sa[0] + (f32x2){a1a[2], a1a[3]} * Sa[1];
                pq = pq + (f32x2){a1b[0], a1b[1]} * Sb[0] + (f32x2){a1b[2], a1b[3]} * Sb[1];
                const float x = odd ? pq[1] : pq[0], y = odd ? pq[0] : pq[1];
                float zr = x + __builtin_bit_cast(float, __builtin_amdgcn_update_dpp(0, __builtin_bit_cast(int, y), 0xB1, 0xf, 0xf, true));
                zr = DPP_ADD(zr, 0x4E);
                zr = DPP_ADD(zr, 0x124);
                zr = DPP_ADD(zr, 0x128);
                const float nsa = -__builtin_bit_cast(float, __builtin_amdgcn_update_dpp(0, __builtin_bit_cast(int, zr), 0xA0, 0xf, 0xf, true));
                Sa = Sa * (f32x2){w[0], w[1]} + ((f32x2){bb[0], bb[1]} * nsa + (f32x2){kt[0], kt[1]} * v2[0]);
                Sb = Sb * (f32x2){w[2], w[3]} + ((f32x2){bb[2], bb[3]} * nsa + (f32x2){kt[2], kt[3]} * v2[0]);
                __builtin_amdgcn_raw_buffer_store_b32(__float_as_uint(zr + v2[1]), orsrc, ooff, 0, 0);
                ooff += 1024u;
            }
        }
        if (c + 1 < SEQ / SC_TC) SC_LSTORE((c + 1) & 1);
        __syncthreads();
    }
    if (worker) *(f32x4*)(P.out + O_WKP + (((size_t)layer * 64 + hb) * 64 + row) * 64 + 4 * p) = (f32x4){Sa[0], Sa[1], Sb[0], Sb[1]};
#undef SC_GLOAD
#undef SC_LSTORE
}

typedef _Float16 half8 __attribute__((ext_vector_type(8)));
typedef _Float16 half4 __attribute__((ext_vector_type(4)));
constexpr int MS_TROW = 144, MS_TILE = 16 * MS_TROW;
constexpr int MS_UK = 0, MS_UW = MS_TILE, MS_A5 = 2 * MS_TILE, MS_OM = MS_A5 + 4096, MS_A3 = MS_OM + 256, MS_A4 = MS_A3 + 1024, MS_VB = MS_A4 + 1024, MS_IMG = MS_VB + 4 * 512;
constexpr int MS_SCR = 2 * MS_TILE, MS_SCR0 = 8 * MS_IMG;
#define MFMA16H(a, b, c) __builtin_amdgcn_mfma_f32_16x16x32_f16((a), (b), (c), 0, 0, 0)
__device__ __forceinline__ half8 pack_h8(f32x4 lo, f32x4 hi) { half8 h; h[0] = (_Float16)lo[0]; h[1] = (_Float16)lo[1]; h[2] = (_Float16)lo[2]; h[3] = (_Float16)lo[3];
    h[4] = (_Float16)hi[0]; h[5] = (_Float16)hi[1]; h[6] = (_Float16)hi[2]; h[7] = (_Float16)hi[3]; return h; }
__device__ __forceinline__ half8 pack_h8v(f32x4 lo, half4 hi) { half8 h; h[0] = (_Float16)lo[0]; h[1] = (_Float16)lo[1]; h[2] = (_Float16)lo[2]; h[3] = (_Float16)lo[3];
    h[4] = hi[0]; h[5] = hi[1]; h[6] = hi[2]; h[7] = hi[3]; return h; }

struct MsRegs { half8 f[4][2]; float om; float krj; unsigned vraw[4][4]; };
__device__ __forceinline__ void mscan_load(const unsigned char* ws, int hb, int c, int lane, MsRegs& R) {
    const int r = lane & 15, q = lane >> 4;
    const size_t t0 = (size_t)c * 16;
    const unsigned char* gB = ws + WS_PB + ((size_t)hb * SEQ + t0 + r) * 512 + (size_t)q * 16;
#pragma unroll
    for (int m = 0; m < 4; ++m)
#pragma unroll
        for (int s2 = 0; s2 < 2; ++s2) R.f[m][s2] = *(const half8*)(gB + m * 128 + s2 * 64);
    R.om = ((const float*)(ws + WS_PO))[((size_t)hb * (SEQ / 16) + c) * 64 + lane];
    R.krj = ((const float*)(ws + WS_KRA))[((size_t)(hb >> 2) * SEQ + t0 + r) * 4 + (hb & 3)];
    const unsigned* gV = (const unsigned*)(ws + WS_PV) + ((size_t)hb * SEQ + t0 + 4 * q) * 64 + r;
#pragma unroll
    for (int rg = 0; rg < 4; ++rg)
#pragma unroll
        for (int e = 0; e < 4; ++e) R.vraw[rg][e] = gV[(size_t)e * 64 + 16 * rg];
}
__device__ __forceinline__ void mscan_build(const MsRegs& R, LAS unsigned char* img, LAS unsigned char* scr, int lane) {
    const int r = lane & 15, q = lane >> 4, k = lane;
    LAS unsigned char* tBH = scr; LAS unsigned char* tKH = scr + MS_TILE;
#pragma unroll
    for (int s2 = 0; s2 < 2; ++s2) { const int co = r * MS_TROW + (8 * q + 32 * s2) * 2;
        *(LAS half8*)(img + MS_UK + co) = R.f[0][s2]; *(LAS half8*)(img + MS_UW + co) = R.f[1][s2];
        *(LAS half8*)(tBH + co) = R.f[2][s2]; *(LAS half8*)(tKH + co) = R.f[3][s2]; }
    f32x4 be = {0.f, 0.f, 0.f, 0.f}, ga = be, bp = be, gp = be, gaT = be, beT = be;
#pragma unroll
    for (int s2 = 0; s2 < 2; ++s2) { const half8 fUK = R.f[0][s2], fUW = R.f[1][s2], fBH = R.f[2][s2], fKH = R.f[3][s2];
        be = MFMA16H(fBH, fUK, be); ga = MFMA16H(fKH, fUK, ga); bp = MFMA16H(fBH, fUW, bp); gp = MFMA16H(fKH, fUW, gp); gaT = MFMA16H(fUK, fKH, gaT); beT = MFMA16H(fUK, fBH, beT); }
#pragma unroll
    for (int reg = 0; reg < 4; ++reg) { const int i = 4 * q + reg; const bool up = i < r, lo = r < i;
        be[reg] = up ? be[reg] : 0.f; ga[reg] = up ? ga[reg] : 0.f; bp[reg] = up ? bp[reg] : 0.f; gp[reg] = up ? gp[reg] : 0.f;
        gaT[reg] = lo ? gaT[reg] : 0.f; beT[reg] = lo ? beT[reg] : 0.f; }
    ga = ga * 16.0f; gp = gp * 16.0f; gaT = gaT * 16.0f;
#define MS_H4(x) ({ half4 h_; h_[0] = (_Float16)(x)[0]; h_[1] = (_Float16)(x)[1]; h_[2] = (_Float16)(x)[2]; h_[3] = (_Float16)(x)[3]; h_; })
#define MS_MM(xt, y) __builtin_amdgcn_mfma_f32_16x16x16f16(MS_H4(xt), MS_H4(y), ((f32x4){0.f, 0.f, 0.f, 0.f}), 0, 0, 0)
    const f32x4 nN = -be, nNT = -beT;
    const f32x4 N2 = MS_MM(nNT, nN), N2T = MS_MM(nN, nNT);
    const f32x4 N4 = MS_MM(N2T, N2), N4T = MS_MM(N2, N2T);
    const f32x4 N8 = MS_MM(N4T, N4);
    const f32x4 N3 = MS_MM(nNT, N2), N3T = MS_MM(N2, nNT);
    f32x4 P1 = nN + N2 + N3, P1T = nNT + N2T + N3T;
#pragma unroll
    for (int reg = 0; reg < 4; ++reg) { const float d = (4 * q + reg == r) ? 1.0f : 0.f; P1[reg] += d; P1T[reg] += d; }
    const f32x4 P2 = P1 + MS_MM(P1T, N4), P2T = P1T + MS_MM(N4, P1T);
    const f32x4 Tm = P2 + MS_MM(P2T, N8);
    const f32x4 g2 = MS_MM(gaT, Tm);
    { half8 h3; h3[0] = (_Float16)Tm[0]; h3[1] = (_Float16)Tm[1]; h3[2] = (_Float16)Tm[2]; h3[3] = (_Float16)Tm[3]; h3[4] = (_Float16)g2[0]; h3[5] = (_Float16)g2[1]; h3[6] = (_Float16)g2[2]; h3[7] = (_Float16)g2[3];
      *(LAS half8*)(img + MS_A3 + lane * 16) = h3; }
    { half8 h4;
#pragma unroll
      for (int e = 0; e < 4; ++e) { h4[e] = (_Float16)(-bp[e]); h4[4 + e] = (_Float16)(gp[e] + ((4 * q + e == r) ? R.krj : 0.f)); }
      *(LAS half8*)(img + MS_A4 + lane * 16) = h4; }
#pragma unroll
    for (int rg = 0; rg < 4; ++rg) { half4 hv;
#pragma unroll
      for (int e = 0; e < 4; ++e) { const unsigned u = R.vraw[rg][e]; hv[e] = as_h2(u).x; }
      *(LAS half4*)(img + MS_VB + rg * 512 + lane * 8) = hv; }
    asm volatile("s_waitcnt lgkmcnt(0)" ::: "memory");
    const float om = R.om;
    {
        const _Float16 omb = (_Float16)(-om), omk = (_Float16)(om * 16.0f);
        _Float16 bvv[16], kvv[16];
#pragma unroll
        for (int i = 0; i < 16; ++i) { bvv[i] = *(const LAS _Float16*)(tBH + i * MS_TROW + k * 2); kvv[i] = *(const LAS _Float16*)(tKH + i * MS_TROW + k * 2); }
        asm volatile("" ::: "memory");
#pragma unroll
        for (int qq = 0; qq < 4; ++qq) { half8 h;
#pragma unroll
            for (int e = 0; e < 4; ++e) { h[e] = bvv[4 * qq + e] * omb; h[4 + e] = kvv[4 * qq + e] * omk; }
            *(LAS half8*)(img + MS_A5 + ((k >> 4) * 64 + qq * 16 + (k & 15)) * 16) = h; }
    }
    *(LAS float*)(img + MS_OM + (((k >> 2) & 3) * 16 + (k >> 4) * 4 + (k & 3)) * 4) = om;
    asm volatile("s_waitcnt lgkmcnt(0)" ::: "memory");
}

struct MsOps { half8 uk0, uk1, uw0, uw1, a3, a4, a5[4]; half4 vb; f32x4 om[4]; };
__device__ __forceinline__ void mscan_ops_load(const LAS unsigned char* I, int rg, int lane, MsOps& o) {
    const int r = lane & 15, q = lane >> 4;
#define MS_UFRAG(T_, s_) ({ const half4 lo_ = *(const LAS half4*)(I + (T_) + r * MS_TROW + (32 * (s_) + 4 * q) * 2), hi_ = *(const LAS half4*)(I + (T_) + r * MS_TROW + (32 * (s_) + 16 + 4 * q) * 2); \
        half8 h_; h_[0] = lo_[0]; h_[1] = lo_[1]; h_[2] = lo_[2]; h_[3] = lo_[3]; h_[4] = hi_[0]; h_[5] = hi_[1]; h_[6] = hi_[2]; h_[7] = hi_[3]; h_; })
    o.uk0 = MS_UFRAG(MS_UK, 0); o.uk1 = MS_UFRAG(MS_UK, 1); o.uw0 = MS_UFRAG(MS_UW, 0); o.uw1 = MS_UFRAG(MS_UW, 1);
    o.vb = *(const LAS half4*)(I + MS_VB + rg * 512 + lane * 8);
    o.a3 = *(const LAS half8*)(I + MS_A3 + lane * 16); o.a4 = *(const LAS half8*)(I + MS_A4 + lane * 16);
#pragma unroll
    for (int kb = 0; kb < 4; ++kb) { o.a5[kb] = *(const LAS half8*)(I + MS_A5 + (kb * 64 + lane) * 16); o.om[kb] = *(const LAS f32x4*)(I + MS_OM + (q * 16 + kb * 4) * 4); }
}
__device__ __forceinline__ void mscan_unit(const Params& P, int layer, int hb, LAS unsigned char* lds, int wid, int lane) {
    unsigned char* ws = P.ws;
    const int r = lane & 15, q = lane >> 4;
    const int rg = wid & 3;
    f32x4 Sacc[4];
#pragma unroll
    for (int kb = 0; kb < 4; ++kb) Sacc[kb] = (f32x4){0.f, 0.f, 0.f, 0.f};
    bf16_t* oraw = (bf16_t*)(ws + WS_ORAW) + ((size_t)(hb >> 2) * SEQ) * 256 + (hb & 3) * 64 + 16 * rg + r;
    const bool builder = wid >= 4;
    const int bw = wid - 4;
    constexpr int NR = SEQ / 64;
    MsRegs R;
    if (builder) { mscan_load(ws, hb, bw, lane, R); mscan_build(R, lds + bw * MS_IMG, lds + MS_SCR0 + bw * MS_SCR, lane); mscan_load(ws, hb, 4 + bw, lane, R); }
    __syncthreads();
    for (int rd = 0; rd < SEQ / 64; ++rd) {
        if (builder) { if (rd + 1 < NR) { mscan_build(R, lds + (((rd + 1) & 1) * 4 + bw) * MS_IMG, lds + MS_SCR0 + bw * MS_SCR, lane);
                                             if (rd + 2 < NR) mscan_load(ws, hb, 4 * (rd + 2) + bw, lane, R); } }
        else {
            MsOps cur, nxt;
            mscan_ops_load(lds + ((rd & 1) * 4) * MS_IMG, rg, lane, cur);
#pragma unroll
            for (int cc = 0; cc < 4; ++cc) {
                if (cc < 3) mscan_ops_load(lds + ((rd & 1) * 4 + cc + 1) * MS_IMG, rg, lane, nxt);
                asm volatile("" ::: "memory");
                const half8 bS0 = pack_h8(Sacc[0], Sacc[1]), bS1 = pack_h8(Sacc[2], Sacc[3]);
                f32x4 DT = {0.f, 0.f, 0.f, 0.f}, ET = DT;
                DT = MFMA16H(cur.uk0, bS0, DT); DT = MFMA16H(cur.uk1, bS1, DT);
                ET = MFMA16H(cur.uw0, bS0, ET); ET = MFMA16H(cur.uw1, bS1, ET);
                f32x4 SA = {0.f, 0.f, 0.f, 0.f};
                SA = MFMA16H(cur.a3, pack_h8v(DT, cur.vb), SA);
                const half8 b3 = pack_h8v(SA, cur.vb);
                const f32x4 OT = MFMA16H(cur.a4, b3, ET);
                bf16_t* op = oraw + ((size_t)(rd * 4 + cc) * 16 + 4 * q) * 256;
#pragma unroll
                for (int reg = 0; reg < 4; ++reg) op[(size_t)reg * 256] = f2bf(OT[reg]);
#pragma unroll
                for (int kb = 0; kb < 4; ++kb) Sacc[kb] = MFMA16H(cur.a5[kb], b3, Sacc[kb] * cur.om[kb]);
                if (cc < 3) cur = nxt;
            }
        }
        __syncthreads();
    }
    if (!builder) {
        float* so = P.out + O_WKP + (((size_t)layer * 64 + hb) * 64 + 16 * rg + r) * 64;
#pragma unroll
        for (int kb = 0; kb < 4; ++kb) *(f32x4*)(so + 16 * kb + 4 * q) = Sacc[kb];
    }
}

__device__ __forceinline__ void post_token4(const Params& P, int layer, int r0, int rstride, int lane, const f32x4 lg, const f32x4 lb, bool dry = false) {
    unsigned char* ws = P.ws;
    const int c0 = 4 * lane, hh = lane >> 4, l16 = lane & 15;
    f32x4 o[4]; float rkr[4]; u32x4 pv[4]; u32x2 gt[4];
#pragma unroll
    for (int j = 0; j < 4; ++j) { const int r = r0 + j * rstride, b = r >> 11, t = r & (SEQ - 1);
        { const u32x2 ob = *((const u32x2*)(ws + WS_ORAW) + (size_t)r * 64 + lane); const unsigned o0 = ob.x, o1 = ob.y; o[j] = (f32x4){bf_lo(o0), bf_hi(o0), bf_lo(o1), bf_hi(o1)}; }
        rkr[j] = ((const float*)(ws + WS_RKR))[(size_t)r * 4 + hh];
        pv[j] = *((const u32x4*)(ws + WS_PV) + ((size_t)(b * 4 + hh) * SEQ + t) * 16 + l16);
        gt[j] = *(const u32x2*)((bf16_t*)(ws + WS_GM) + (size_t)r * 1024 + 768 + c0); }
#pragma unroll
    for (int j = 0; j < 4; ++j) { const int r = r0 + j * rstride;
        const f32x4 oo = o[j];
        const float mean = sum16d((oo[0] + oo[1]) + (oo[2] + oo[3])) * (1.0f / 64.0f);
        const f32x4 d = oo - mean;
        const float var = sum16d((d[0] * d[0] + d[1] * d[1]) + (d[2] * d[2] + d[3] * d[3])) * (1.0f / 64.0f);
        const float rstd = __builtin_amdgcn_rsqf(var + 64e-5f);
        const u32x4 pw = pv[j]; const unsigned pv0 = pw[0], pv1 = pw[1], pv2 = pw[2], pv3 = pw[3];
        const float v[4] = {(float)as_h2(pv0).x, (float)as_h2(pv1).x, (float)as_h2(pv2).x, (float)as_h2(pv3).x};
        const u32x2 gq = gt[j]; const unsigned g0 = gq.x, g1 = gq.y;
        const float g[4] = {bf_lo(g0), bf_hi(g0), bf_lo(g1), bf_hi(g1)};
        float y[4];
#pragma unroll
        for (int i = 0; i < 4; ++i) y[i] = (d[i] * rstd * lg[i] + lb[i] + rkr[j] * v[i]) * g[i];
        *(u32x2*)((bf16_t*)(ws + WS_GM) + (size_t)r * 1024 + 768 + c0) = dry ? gq : (u32x2){pk_bf16(y[0], y[1]), pk_bf16(y[2], y[3])}; }
}

#define XB_TMO      128
#define XB_XCNT(j)  (256  + 64 * (j))
#define XB_XSUB(j)  (1280 + 64 * (j))
#define XB_XGEN(j)  (2304 + 64 * (j))
#define XB_TOP      3328
#define XB_TOPGEN   3392
#define XCD_BAR_WORDS 3456
#define XB_SPIN_CAP (1u << 18)

__device__ __forceinline__ unsigned xb_ld(unsigned* p)              { return __hip_atomic_load(p, __ATOMIC_RELAXED, __HIP_MEMORY_SCOPE_AGENT); }
__device__ __forceinline__ unsigned xb_add(unsigned* p, unsigned v) { return __hip_atomic_fetch_add(p, v, __ATOMIC_RELAXED, __HIP_MEMORY_SCOPE_AGENT); }
__device__ __forceinline__ unsigned xb_xcc_id() { return (unsigned)__builtin_amdgcn_s_getreg((3 << 11) | 20) & 0xFu; }
#define XB_SPIN(cond, bar) do { unsigned _sp = 0; while (cond) { __builtin_amdgcn_s_sleep(1); \
    if ((++_sp & 255u) == 0u) { if (xb_ld(&(bar)[XB_TMO])) break; if (_sp > XB_SPIN_CAP) { atomicAdd(&(bar)[XB_TMO], 1u); break; } } } } while (0)

struct XcdBarrier {
    unsigned* bar; unsigned x;
    volatile LAS unsigned* st;
};

__device__ __forceinline__ XcdBarrier xcd_barrier_post(unsigned* bar, volatile LAS unsigned* st) {
    XcdBarrier b; b.bar = bar; b.x = xb_xcc_id(); b.st = st;
    if (threadIdx.x == 0) (void)xb_add(&bar[XB_XCNT(b.x)], 1u);
    return b;
}
__device__ __forceinline__ void xcd_barrier_complete(unsigned* bar, unsigned x, unsigned& nloc, unsigned& nx) {
    const unsigned G = gridDim.x * gridDim.y * gridDim.z;
    unsigned sum, cnt, mine, sp = 0u;
    for (;;) {
        sum = 0u; cnt = 0u; mine = 0u;
#pragma unroll
        for (unsigned j = 0; j < 16; ++j) { const unsigned c = xb_ld(&bar[XB_XCNT(j)]); sum += c; cnt += (c > 0u) ? 1u : 0u; mine = (j == x) ? c : mine; }
        if (sum == G) break;
        __builtin_amdgcn_s_sleep(1);
        if ((++sp & 255u) == 0u) { if (xb_ld(&bar[XB_TMO])) break; if (sp > XB_SPIN_CAP) { atomicAdd(&bar[XB_TMO], 1u); break; } }
    }
    nloc = mine > 0u ? mine : 1u; nx = cnt > 0u ? cnt : 1u;
}

__device__ __forceinline__ void xcd_barrier(const XcdBarrier& b) {
    asm volatile("s_waitcnt vmcnt(0)" ::: "memory");
    __syncthreads();
    if (threadIdx.x == 0) {
        unsigned* bar = b.bar;
        __builtin_amdgcn_s_waitcnt(0);
        unsigned nloc = b.st[0], nx = b.st[1];
        if (nloc == 0u) { xcd_barrier_complete(bar, b.x, nloc, nx); b.st[0] = nloc; b.st[1] = nx; }
        const unsigned old = xb_add(&bar[XB_XSUB(b.x)], 1u);
        const unsigned gen = old / nloc;
        if (old + 1u == (gen + 1u) * nloc) {
            __builtin_amdgcn_fence(__ATOMIC_RELEASE, "agent");
            asm volatile("s_waitcnt vmcnt(0)" ::: "memory");
            const unsigned og = xb_add(&bar[XB_TOP], 1u);
            const unsigned tg = og / nx;
            if (og + 1u == (tg + 1u) * nx) xb_add(&bar[XB_TOPGEN], 1u);
            else XB_SPIN(xb_ld(&bar[XB_TOPGEN]) == tg, bar);
            __builtin_amdgcn_fence(__ATOMIC_ACQUIRE, "agent");
            xb_add(&bar[XB_XGEN(b.x)], 1u);
            asm volatile("s_waitcnt vmcnt(0)" ::: "memory");
        } else {
            XB_SPIN(xb_ld(&bar[XB_XGEN(b.x)]) == gen, bar);
            __builtin_amdgcn_fence(__ATOMIC_ACQUIRE, "agent");
            asm volatile("s_waitcnt vmcnt(0)" ::: "memory");
        }
    }
    __syncthreads();
}

constexpr int LDS_BYTES = 147456;
constexpr int NPHASE = 11;
template <bool IS_IN>
struct SkinnyPre { const Params& P; int layer, bx, G, wid, lane;
    __device__ __forceinline__ void operator()() const { for (int u = bx; u < (IS_IN ? NPAD / 16 : DM / 16); u += G) skinny_unit<IS_IN>(P, layer, u, wid, lane); } };
#ifndef CODE_PF
#define CODE_PF 0
#endif
__device__ __forceinline__ void code_prefetch(unsigned long long pc0, int tid) {
    const volatile __attribute__((address_space(1))) unsigned* p = (const volatile __attribute__((address_space(1))) unsigned*)(pc0 + (unsigned long long)tid * 64ull);
    unsigned s_ = 0;
#pragma unroll
    for (int k = 0; k < 5; ++k) if (k * 512 + tid < 2240) s_ += p[k * 8192];
    asm volatile("" :: "v"(s_));
}
__global__ void __launch_bounds__(512, 2) hymba_fwd(Params P) {
    extern __shared__ __attribute__((aligned(16))) unsigned char lds_raw[];
    LAS unsigned char* lds = (LAS unsigned char*)lds_raw;
    cg::grid_group grid = cg::this_grid();
    unsigned long long pc0; asm volatile("s_getpc_b64 %0" : "=s"(pc0));
    if (CODE_PF & 1) code_prefetch(pc0, threadIdx.x);
    {
        volatile LAS unsigned* st = (volatile LAS unsigned*)(lds + 147392);
        if (threadIdx.x == 0) { st[0] = 0u; st[1] = 0u; st[2] = 0u; st[3] = 0u; }
        __syncthreads();
    }
#if INKERNEL_BAR_ZERO
    const XcdBarrier xbar = {(unsigned*)(P.ws + WS_CTL) + 4096, xb_xcc_id(), (volatile LAS unsigned*)(lds + 147392)};
    static_assert(XCD_BAR_WORDS <= 3584, "the prologue zeroes 3584 barrier words");
#else
    const XcdBarrier xbar = xcd_barrier_post((unsigned*)(P.ws + WS_CTL) + 4096, (volatile LAS unsigned*)(lds + 147392));
#endif
    const int G = gridDim.x, bx = blockIdx.x;
#define FRESH_IDS int tid = threadIdx.x; asm volatile("" : "+v"(tid)); const int lane = tid & 63; const int wid = __builtin_amdgcn_readfirstlane(tid >> 6); (void)lane; (void)wid; if (CODE_PF & 2) code_prefetch(pc0, tid);
    unsigned char* ws = P.ws;
    const int lo = P.ph_lo, hi = P.ph_hi;
#define IN(k) (lo <= (k) && (k) < hi)
#ifdef DBG_TS
#define TSTAMP(k) do { if (bx == 0 && threadIdx.x == 0) ((unsigned long long*)(ws + WS_CTL + 4096))[(k)] = __builtin_amdgcn_s_memrealtime(); } while (0)
#else
#define TSTAMP(k) do {} while (0)
#endif
#define SYNC_AFTER(k) do { if (IN(k) && IN((k) + 1)) { if ((k) == 0 && USE_CG_SYNC) grid.sync(); else xcd_barrier(xbar); if (DBG_DOUBLE & 8) xcd_barrier(xbar); } TSTAMP((k) + 1); } while (0)
    TSTAMP(0);
#ifndef SKIP_P0
    if (IN(0)) { FRESH_IDS for (int rep = 0; rep < ((DBG_DOUBLE & 32) ? 2 : 1); ++rep) p0_prologue(P, lds, G, tid, wid, lane); }
#endif
    SYNC_AFTER(0);
#if INKERNEL_BAR_ZERO
    if (threadIdx.x == 0) (void)xb_add(&xbar.bar[XB_XCNT(xbar.x)], 1u);
#endif
    for (int layer = 0; layer < NLAYER; ++layer) {
        const int pb = 1 + 5 * layer;
        if (IN(pb)) {
            FRESH_IDS
            pg8::Gemm g{(const pg8::bf16_t*)(ws + WS_XB), (const pg8::bf16_t*)(ws + WS_WIN) + (size_t)layer * NPAD * DM, MP, NPAD, DM};
            pg8::StaticOrder S; S.init(MP, NPAD, G, bx);
            EpiIn E; E.ws = ws; E.out = P.out; E.qg = PRM(PRM_QG) + layer * 64; E.kg = PRM(PRM_KG) + layer * 64; E.layer = layer;
#ifndef SKIP_G1
            for (int rep = 0; rep < ((DBG_DOUBLE & 1) ? 2 : 1); ++rep) pg8::gemm_phase<EpiIn, pg8::StaticOrder, false, SkinnyPre<true>>((PG8_LAS unsigned char*)lds, g, S, E, nullptr, SkinnyPre<true>{P, layer, bx, G, wid, lane});
#endif
        }
        SYNC_AFTER(pb);
        if (IN(pb + 1)) {
            FRESH_IDS
#ifndef SKIP_PL
            for (int rep = ((DBG_DOUBLE & 256) ? 0 : 1); rep < 2; ++rep) for (int u = bx; u < 256; u += G) pool_unit(P, layer, u, lds, wid, lane, rep == 0);
#endif
            __syncthreads();
#ifndef SKIP_PR
            for (int rep = 0; rep < ((DBG_DOUBLE & 16) ? 2 : 1); ++rep) for (int r0 = (bx * 8 + wid) * 16; r0 < MP; r0 += G * 8 * 16) prep_run(P, layer, r0, lane, lds + wid * 16384);
#endif
        }
        SYNC_AFTER(pb + 1);
        if (IN(pb + 2)) {
            FRESH_IDS
            const int NSC = G >= 128 ? 64 : 0;
            if (bx < NSC || NSC == 0) {
#ifndef SKIP_SC
                for (int rep = 0; rep < ((DBG_DOUBLE & 2) ? 2 : 1); ++rep) for (int u = bx; u < 64; u += (NSC ? NSC : G)) { const int hb = ((u & 7) * 8 + (u >> 3)); mscan_unit(P, layer, hb, lds, wid, lane); __syncthreads(); }
#endif
            }
            if (bx >= NSC) {
                const int j = bx - NSC, NW = G - NSC;
#ifndef SKIP_DM
                for (int rep = 0; rep < ((DBG_DOUBLE & 4) ? 2 : 1); ++rep)
                    for (int i = 0; i * NW < 2 * MS; ++i) {
                        const int c = (2 * MS - i * NW) < NW ? (2 * MS - i * NW) : NW, jj = j - (NW - c);
                        if (jj >= 0) { const int u = i * NW + (i == 0 ? jj : (jj ^ 1)); decode_mix(P, layer, u >> 1, u & 1, lds, tid, wid, lane); }
                    }
#endif
                __syncthreads();
#ifndef SKIP_AT
                constexpr int ATT_LDS = 71680;
                for (int rep = ((DBG_DOUBLE & 128) ? 0 : 1); rep < 2; ++rep)
                    for (int u = j; u < 512; u += 2 * NW) {
                        attn_unit<true, false>(P, layer, u, lds, lds + 2 * ATT_LDS, tid, wid, lane);
                        if (u + NW < 512) attn_unit<true, false>(P, layer, u + NW, lds + ATT_LDS, lds + 2 * ATT_LDS, tid, wid, lane);
                        __syncthreads();
                        attn_unit<false, true>(P, layer, u, lds, lds + 2 * ATT_LDS, tid, wid, lane, rep == 0);
                        if (u + NW < 512) attn_unit<false, true>(P, layer, u + NW, lds + ATT_LDS, lds + 2 * ATT_LDS, tid, wid, lane, rep == 0);
                        __syncthreads();
                    }
#endif
            }
        }
        SYNC_AFTER(pb + 2);
        if (IN(pb + 3)) {
            FRESH_IDS
#ifndef SKIP_PO
            { const f32x4 lg = *(const f32x4*)(PRM(PRM_LNG) + layer * 256 + 4 * lane), lb = *(const f32x4*)(PRM(PRM_LNB) + layer * 256 + 4 * lane);
              for (int rep = ((DBG_DOUBLE & 512) ? 0 : 1); rep < 2; ++rep) for (int r = bx * 8 + wid; r < MP; r += 4 * G * 8) post_token4(P, layer, r, G * 8, lane, lg, lb, rep == 0); }
#endif
        }
        SYNC_AFTER(pb + 3);
        if (IN(pb + 4)) {
            FRESH_IDS
            pg8::Gemm g{(const pg8::bf16_t*)(ws + WS_GM), (const pg8::bf16_t*)(ws + WS_WOUT) + (size_t)layer * DM * DM, MP, DM, DM};
            pg8::StaticOrder S; S.init(MP, DM, G, bx);
            EpiOut E; E.resid = INP(0); E.out = P.out + O_YP; E.XB = (bf16_t*)(ws + WS_XB); E.RS = (float*)(ws + WS_RS) + MP; E.layer = layer;
#ifndef SKIP_G2
            for (int rep = 0; rep < (((DBG_DOUBLE & 64) && layer == 0) ? 2 : 1); ++rep) pg8::gemm_phase<EpiOut, pg8::StaticOrder, false, SkinnyPre<false>>((PG8_LAS unsigned char*)lds, g, S, E, nullptr, SkinnyPre<false>{P, layer, bx, G, wid, lane});
#endif
        }
        if (layer + 1 < NLAYER) SYNC_AFTER(pb + 4);
    }
#ifdef DBG_TS
    TSTAMP(NPHASE);
    if (bx == 0 && threadIdx.x == 0) { const unsigned long long* ts = (const unsigned long long*)(ws + WS_CTL + 4096);
        P.out[O_YS] = (float)(ts[DBG_TS + 1] - ts[DBG_TS]) * (DBG_TS_SCALE); }
#endif
#undef IN
#undef SYNC_AFTER
}

#ifdef DBG_MASK
__global__ void dbg_scale(float* out) {
    const size_t G = gridDim.x, bx = blockIdx.x;
#define DBG_SCALE(o, lo_, hi_) if (((DBG_MASK | DBG_MASK2) >> (o)) & 1) { const float f_ = ((DBG_MASK >> (o)) & 1) ? DBG_FACTOR : DBG_FACTOR2; for (size_t i = (lo_) + bx * 256 + threadIdx.x; i < (hi_); i += G * 256) out[i] *= f_; }
    DBG_SCALE(0, O_YP, O_YS) DBG_SCALE(1, O_YS, O_POOLP) DBG_SCALE(2, O_POOLP, O_POOLS) DBG_SCALE(3, O_POOLS, O_KP) DBG_SCALE(4, O_KP, O_KS) DBG_SCALE(5, O_KS, O_VP)
    DBG_SCALE(6, O_VP, O_VS) DBG_SCALE(7, O_VS, O_SHP) DBG_SCALE(8, O_SHP, O_SHS) DBG_SCALE(9, O_SHS, O_WKP) DBG_SCALE(10, O_WKP, O_WKS) DBG_SCALE(11, O_WKS, O_END)
}
#endif
#if SCAN_IMPL == 2
__global__ void dbg_compare(float* out, const unsigned char* ws) {
    __shared__ float red[4][256];
    const int layer = DBG_CMP_SEL >> 1, tid = threadIdx.x;
    float md = 0.f, mr = 0.f;
    if ((DBG_CMP_SEL & 1) == 0) { const float* A_ = (const float*)(ws + WS_ORAW); const float* B_ = (const float*)(ws + WS_ORAW2);
        for (size_t i = tid; i < (size_t)MP * 256; i += 256 * 997) { const float a = A_[i], b = B_[i]; md = fmaxf(md, fabsf(a - b)); mr = fmaxf(mr, fabsf(a)); }
        for (size_t i = (size_t)tid * 4099; i < (size_t)MP * 256; i += (size_t)256 * 4099) { const float a = A_[i], b = B_[i]; md = fmaxf(md, fabsf(a - b)); mr = fmaxf(mr, fabsf(a)); } }
    else { const float* SA_ = out + O_WKP + (size_t)layer * 64 * 4096; const float* SB_ = (const float*)(ws + WS_ORAW2 + 32 * MiB) + (size_t)layer * 64 * 4096;
        for (size_t i = tid; i < (size_t)64 * 4096; i += 256) { const float a = SA_[i], b = SB_[i]; md = fmaxf(md, fabsf(a - b)); mr = fmaxf(mr, fabsf(a)); } }
    red[0][tid] = md; red[1][tid] = mr; __syncthreads();
    if (tid == 0) { for (int i = 1; i < 256; ++i) { md = fmaxf(md, red[0][i]); mr = fmaxf(mr, red[1][i]); }
        out[O_YS] = 1.0e4f * md / fmaxf(mr, 1e-20f); }
}
#endif
#ifndef MK_N_LAUNCHES
#define MK_N_LAUNCHES 1
#endif
extern "C" void kernel_launch(void* const* d_in, const int* in_sizes, int n_in, void* d_out, int out_size, void* d_ws, size_t ws_size, hipStream_t stream) {
    static int grid = 0;
    if (grid == 0) {
        if (n_in != 25 || out_size != (int)O_END || ws_size < WS_END) { fprintf(stderr, "kernel_launch: unexpected shapes: n_in %d out %d ws %zu\n", n_in, out_size, ws_size); grid = -1; return; }
        int dev = 0, cus = 0, per_cu = 0;
        if (hipGetDevice(&dev) != hipSuccess || hipDeviceGetAttribute(&cus, hipDeviceAttributeMultiprocessorCount, dev) != hipSuccess) { grid = -1; return; }
        if (hipFuncSetAttribute((const void*)hymba_fwd, hipFuncAttributeMaxDynamicSharedMemorySize, LDS_BYTES) != hipSuccess) { fprintf(stderr, "kernel_launch: hipFuncSetAttribute failed\n"); grid = -1; return; }
        if (hipOccupancyMaxActiveBlocksPerMultiprocessor(&per_cu, (const void*)hymba_fwd, 512, LDS_BYTES) != hipSuccess || per_cu < 1) { fprintf(stderr, "kernel_launch: occupancy query failed (%d)\n", per_cu); grid = -1; return; }
        grid = cus * 1;
    }
    if (grid < 0) return;
#if !INKERNEL_BAR_ZERO
    if (hipMemsetAsync((char*)d_ws + WS_CTL, 0, 65536, stream) != hipSuccess) { fprintf(stderr, "kernel_launch: memset of control words failed\n"); return; }
#endif
    Params p{};
    for (int i = 0; i < 25; ++i) p.in[i] = (const float*)d_in[i];
    p.out = (float*)d_out; p.ws = (unsigned char*)d_ws;
#if MK_N_LAUNCHES == 1
    p.ph_lo = 0; p.ph_hi = NPHASE;
    void* args[] = {&p};
    hipError_t e = hipLaunchCooperativeKernel((const void*)hymba_fwd, dim3(grid), dim3(512), args, LDS_BYTES, stream);
    if (e != hipSuccess) fprintf(stderr, "kernel_launch: cooperative launch failed: %s (grid %d)\n", hipGetErrorString(e), grid);
#if SCAN_IMPL == 2
    dbg_compare<<<1, 256, 0, stream>>>((float*)d_out, (const unsigned char*)d_ws);
#endif
#ifdef DBG_MASK
    dbg_scale<<<1024, 256, 0, stream>>>((float*)d_out);
#endif
#else
    for (int ph = 0; ph < NPHASE; ++ph) {
        p.ph_lo = ph; p.ph_hi = ph + 1;
        void* args[] = {&p};
        hipError_t e = hipLaunchCooperativeKernel((const void*)hymba_fwd, dim3(grid), dim3(512), args, LDS_BYTES, stream);
        if (e != hipSuccess) { fprintf(stderr, "kernel_launch: launch %d failed: %s\n", ph, hipGetErrorString(e)); break; }
    }
#endif
}
```

```cpp
#include <hip/hip_runtime.h>
#ifndef DBG_DOUBLE
#define DBG_DOUBLE 0
#endif
#ifndef SCAN_IMPL
#define SCAN_IMPL 1
#endif
#ifndef DBG_CMP_SEL
#define DBG_CMP_SEL 0
#endif
#ifndef USE_CG_SYNC
#define INKERNEL_BAR_ZERO 1
#define USE_CG_SYNC 1
#endif
#include <hip/hip_cooperative_groups.h>
#include <cstdio>
#include <cstdint>
namespace cg = cooperative_groups;
namespace pg8 {
#define PG8_LAS __attribute__((address_space(3)))
typedef unsigned short bf16_t;
typedef short bf16x8 __attribute__((ext_vector_type(8)));
typedef float f32x4 __attribute__((ext_vector_type(4)));
typedef unsigned u32x4 __attribute__((ext_vector_type(4)));
constexpr int BM = 256, BK = 64, HALF = 128, HTB = HALF * BK * 2  , STAGE_BYTES = 8 * HTB, NXCD = 8, WGM = 8;

__host__ __device__ __forceinline__ int lds_byte(int r, int c) { const int st = (r >> 4) * 2 + (c >> 5), rr = r & 15, cc = c & 31, ob = rr * 64 + cc * 2; return st * 1024 + (ob ^ (((ob >> 9) & 1) << 5)); }
__host__ __device__ __forceinline__ void stage_rc(int b, int& R, int& C) { const int st = b / 1024, sb = b % 1024, swz = sb ^ (((sb >> 9) & 1) << 5); R = (st >> 1) * 16 + swz / 64; C = (st & 1) * 32 + (swz % 64) / 2; }
__host__ __device__ __forceinline__ int perm32(int rho) { const int n = rho >> 4, i = rho & 15; return 8 * (i >> 2) + 4 * n + (i & 3); }

struct Unit { int pm, pn; };
struct Gemm { const bf16_t* A; const bf16_t* Bt; int M, N, K; };

struct StaticOrder {
    int nM, nN, nwg, G, c;
    __host__ __device__ void init(int M, int N, int G_, int c_) { nM = M / BM; nN = N / BM; nwg = nM * nN; G = G_; c = c_; }
    __host__ __device__ bool next(int i, Unit& u) const {
        const long L = (long)i * G + c; if (L >= nwg) return false;
        int wgid = (int)L; { const int q = nwg / NXCD, r = nwg % NXCD, xcd = wgid % NXCD, off = wgid / NXCD; wgid = (xcd < r ? xcd * (q + 1) : r * (q + 1) + (xcd - r) * q) + off; }
        const int nig = WGM * nN, gid = wgid / nig, fm = gid * WGM, gsz = (nM - fm) < WGM ? (nM - fm) : WGM;
        u.pm = fm + ((wgid % nig) % gsz); u.pn = (wgid % nig) / gsz; return true;
    }
    __device__ __forceinline__ void a_ready(const Unit&) const {}
    __device__ __forceinline__ void done(const Unit&) const {}
};

struct NoPre { __device__ __forceinline__ void operator()() const {} };
template <class Epi, class Sched, bool STAMP = false, class Pre = NoPre>
__device__ __forceinline__ void gemm_phase(PG8_LAS unsigned char* lds, const Gemm g, const Sched& S, const Epi& E, unsigned long long* stamps, const Pre& pre_hook = Pre()) {
    int tid = threadIdx.x; asm volatile("" : "+v"(tid));
    const int wid = __builtin_amdgcn_readfirstlane(tid >> 6), lane = tid & 63, wr = wid >> 2, wc = wid & 3, fr = lane & 15, fq = lane >> 4;
    const int K = g.K, nt = K / BK;
    int ts_lo = 0, ts_hi = 0, nts = 0; const unsigned long long rt_entry = STAMP ? (unsigned long long)wall_clock64() : 0ull;
#define PG8_STAMP() do { if (STAMP && wid == 0 && nts < 64) { const unsigned long long _c = (unsigned long long)clock64(); \
        ts_lo = (lane == nts) ? (int)(unsigned)_c : ts_lo; ts_hi = (lane == nts) ? (int)(unsigned)(_c >> 32) : ts_hi; ++nts; } } while (0)
    PG8_STAMP();
    unsigned voffA[2], voffB[2];
#pragma unroll
    for (int i = 0; i < 2; ++i) { int R, C; stage_rc(tid * 16 + i * 8192, R, C); const int Rb = Epi::PERM ? ((R & ~31) + perm32(R & 31)) : R;
        voffA[i] = (unsigned)(R * K + C) * 2u; voffB[i] = (unsigned)(Rb * K + C) * 2u; }
    const size_t kstep = (size_t)(BK * 2);
    const size_t hstep = (size_t)HALF * K * 2;
    const size_t tstep = 2 * hstep;
    const unsigned ldsw = (unsigned)wid * 1024u;
    const int aoff = lds_byte(wr * 64 + fr, fq * 8), boff = lds_byte(wc * 32 + fr, fq * 8);
#define PG8_SA(b, h) (((b) * 2 + (h)) * HTB)
#define PG8_SB(b, h) ((4 + (b) * 2 + (h)) * HTB)
#define PG8_STAGE(bufoff, gbase, voff) do { _Pragma("unroll") for (int _i = 0; _i < 2; ++_i) \
        __builtin_amdgcn_global_load_lds((const unsigned*)((const char*)(gbase) + (voff)[_i]), (PG8_LAS unsigned*)(lds + (bufoff) + ldsw + _i * 8192), 16, 0, 0); } while (0)
#define PG8_LDA(dst, b, h) do { _Pragma("unroll") for (int m = 0; m < 4; ++m) _Pragma("unroll") for (int k = 0; k < 2; ++k) dst[m][k] = *(const PG8_LAS bf16x8*)(lds + PG8_SA(b, h) + aoff + m * 2048 + k * 1024); } while (0)
#define PG8_LDB(dst, b, h) do { _Pragma("unroll") for (int n = 0; n < 2; ++n) _Pragma("unroll") for (int k = 0; k < 2; ++k) dst[n][k] = *(const PG8_LAS bf16x8*)(lds + PG8_SB(b, h) + boff + n * 2048 + k * 1024); } while (0)
#define PG8_MMA(ai, bj, At, Bt) do { __builtin_amdgcn_s_setprio(1); _Pragma("unroll") for (int m = 0; m < 4; ++m) _Pragma("unroll") for (int n = 0; n < 2; ++n) _Pragma("unroll") for (int k = 0; k < 2; ++k) \
        acc[ai][bj][m][n] = __builtin_amdgcn_mfma_f32_16x16x32_bf16(Bt[n][k], At[m][k], acc[ai][bj][m][n], 0, 0, 0); __builtin_amdgcn_s_setprio(0); } while (0)
#define PG8_WAIT_V(n) asm volatile("s_waitcnt vmcnt(" #n ")" ::: "memory")
#define PG8_WAIT_L(n) asm volatile("s_waitcnt lgkmcnt(" #n ")" ::: "memory")
#define PG8_BAR __builtin_amdgcn_s_barrier()
#define PG8_SCHED __builtin_amdgcn_sched_barrier(0)
    Unit cur, nxt; int ui = 0;
    if (!S.next(0, cur)) return;
    float pre[8] = {0.f, 0.f, 0.f, 0.f, 0.f, 0.f, 0.f, 0.f};
    f32x4 acc[2][2][4][2];
#pragma unroll
    for (int a = 0; a < 2; ++a)
#pragma unroll
        for (int b = 0; b < 2; ++b)
#pragma unroll
            for (int m = 0; m < 4; ++m)
#pragma unroll
                for (int n = 0; n < 2; ++n) acc[a][b][m][n] = (f32x4){0.f, 0.f, 0.f, 0.f};
    bf16x8 At[4][2], B0[2][2], B1[2][2];
    const char* cA = (const char*)g.A + (size_t)cur.pm * tstep; const char* cB = (const char*)g.Bt + (size_t)cur.pn * tstep;
    S.a_ready(cur);
    PG8_STAGE(PG8_SB(0, 0), cB, voffB); PG8_STAGE(PG8_SA(0, 0), cA, voffA); PG8_STAGE(PG8_SB(0, 1), cB + hstep, voffB); PG8_STAGE(PG8_SA(0, 1), cA + hstep, voffA);
    pre_hook();
    if (wr == 1) PG8_BAR;
    PG8_WAIT_V(4); PG8_BAR;
    PG8_STAGE(PG8_SB(1, 0), cB + kstep, voffB); PG8_STAGE(PG8_SA(1, 0), cA + kstep, voffA); PG8_STAGE(PG8_SB(1, 1), cB + hstep + kstep, voffB);
    PG8_WAIT_V(6); PG8_BAR;
    PG8_STAMP();
    for (;;) {
        const bool has_next = S.next(ui + 1, nxt);
        const char* nA = has_next ? (const char*)g.A + (size_t)nxt.pm * tstep : cA; const char* nB = has_next ? (const char*)g.Bt + (size_t)nxt.pn * tstep : cB;
        for (int t = 0; t < nt; t += 2) {
            const bool last = (t == nt - 2);
            const char* a1 = cA + (size_t)(t + 1) * kstep;
            const char* a2 = last ? nA : cA + (size_t)(t + 2) * kstep; const char* b2 = last ? nB : cB + (size_t)(t + 2) * kstep;
            const char* a3 = a2 + kstep; const char* b3 = b2 + kstep;
            if (last && has_next) S.a_ready(nxt);
            if (t == nt - 4) E.preload(cur, wr, fr, pre);
            PG8_LDB(B0, 0, 0); PG8_SCHED; PG8_LDA(At, 0, 0); PG8_STAGE(PG8_SA(1, 1), a1 + hstep, voffA);
            PG8_WAIT_L(8); PG8_BAR; PG8_WAIT_L(0); PG8_MMA(0, 0, At, B0); PG8_BAR; PG8_SCHED;
            PG8_LDB(B1, 0, 1); PG8_STAGE(PG8_SB(0, 0), b2, voffB);
            PG8_BAR; PG8_WAIT_L(0); PG8_MMA(0, 1, At, B1); PG8_BAR;
            PG8_LDA(At, 0, 1); PG8_STAGE(PG8_SA(0, 0), a2, voffA);
            PG8_BAR; PG8_WAIT_L(0); PG8_MMA(1, 0, At, B0); PG8_BAR; PG8_SCHED;
            PG8_STAGE(PG8_SB(0, 1), b2 + hstep, voffB);
            PG8_WAIT_V(6); PG8_BAR; PG8_MMA(1, 1, At, B1); PG8_BAR;
            PG8_LDB(B0, 1, 0); PG8_SCHED; PG8_LDA(At, 1, 0); PG8_STAGE(PG8_SA(0, 1), a2 + hstep, voffA);
            PG8_WAIT_L(8); PG8_BAR; PG8_WAIT_L(0); PG8_MMA(0, 0, At, B0); PG8_BAR; PG8_SCHED;
            PG8_LDB(B1, 1, 1); PG8_STAGE(PG8_SB(1, 0), b3, voffB);
            PG8_BAR; PG8_WAIT_L(0); PG8_MMA(0, 1, At, B1); PG8_BAR;
            PG8_LDA(At, 1, 1); PG8_STAGE(PG8_SA(1, 0), a3, voffA);
            PG8_BAR; PG8_WAIT_L(0); PG8_MMA(1, 0, At, B0); PG8_BAR; PG8_SCHED;
            PG8_STAGE(PG8_SB(1, 1), b3 + hstep, voffB);
            PG8_WAIT_V(6); PG8_BAR; PG8_MMA(1, 1, At, B1); PG8_BAR;
        }
        PG8_STAMP();
        if constexpr (!Epi::AFTER_DRAIN) { if ((DBG_DOUBLE & 2048) && Epi::IDEMPOTENT) E(acc, cur, wr, wc, fr, fq, pre); E(acc, cur, wr, wc, fr, fq, pre); S.done(cur); }
        PG8_STAMP();
        if (!has_next) break;
#pragma unroll
        for (int a = 0; a < 2; ++a)
#pragma unroll
            for (int b = 0; b < 2; ++b)
#pragma unroll
                for (int m = 0; m < 4; ++m)
#pragma unroll
                    for (int n = 0; n < 2; ++n) acc[a][b][m][n] = (f32x4){0.f, 0.f, 0.f, 0.f};
        cur = nxt; cA = nA; cB = nB; ++ui;
    }
    PG8_WAIT_V(0);
    if (wr == 0) PG8_BAR;
    PG8_BAR;
    if constexpr (Epi::AFTER_DRAIN) { E.fused(acc, cur, wr, wc, fr, fq, lds, wid, lane); S.done(cur); }
    PG8_STAMP();
    if (STAMP && wid == 0) { stamps[lane] = lane < nts ? (((unsigned long long)(unsigned)ts_hi << 32) | (unsigned)ts_lo) : 0ull;
        if (lane == 62) stamps[62] = rt_entry; if (lane == 63) stamps[63] = (unsigned long long)wall_clock64(); }
#undef PG8_STAMP
#undef PG8_SA
#undef PG8_SB
#undef PG8_STAGE
#undef PG8_LDA
#undef PG8_LDB
#undef PG8_MMA
#undef PG8_WAIT_V
#undef PG8_WAIT_L
#undef PG8_BAR
#undef PG8_SCHED
}
}

#define LAS __attribute__((address_space(3)))
typedef unsigned short bf16_t;
typedef short bf16x8 __attribute__((ext_vector_type(8)));
typedef float f32x2 __attribute__((ext_vector_type(2)));
typedef float f32x4 __attribute__((ext_vector_type(4)));
typedef float f32x16 __attribute__((ext_vector_type(16)));
typedef unsigned u32x2 __attribute__((ext_vector_type(2)));
typedef unsigned u32x4 __attribute__((ext_vector_type(4)));
typedef __bf16 bf2_t __attribute__((ext_vector_type(2)));
typedef _Float16 h2_t __attribute__((ext_vector_type(2)));

constexpr int DM = 1024, NB = 16, SEQ = 2048, MP = NB * SEQ, MS = 128, DIN = 2880, NPAD = 3072;
constexpr int DSH = 832, NLAYER = 2;
constexpr float LOG2E = 1.4426950408889634f;
constexpr float QSCALE = 0.125f * LOG2E;
constexpr size_t O_YP = 0, O_YS = 33554432, O_POOLP = 33685504, O_POOLS = 33808384, O_KP = 34791424, O_KS = 35315712,
                 O_VP = 39510016, O_VS = 40034304, O_SHP = 44228608, O_SHS = 44255232, O_WKP = 44468224, O_WKS = 44992512, O_END = 49186816;
constexpr size_t MiB = 1u << 20;
constexpr size_t WS_CTL = 0;
constexpr size_t WS_WIN = 1 * MiB;
constexpr size_t WS_WOUT = 13 * MiB;
constexpr size_t WS_ROPE = 17 * MiB;
constexpr size_t WS_XBS = 18 * MiB;
constexpr size_t WS_RSS = 18 * MiB + 512 * 1024;
constexpr size_t WS_MIXS = 19 * MiB;
constexpr size_t WS_ZS = 20 * MiB;
constexpr size_t WS_RS = 22 * MiB;
constexpr size_t WS_RKR = 24 * MiB;
constexpr size_t WS_KRA = 24 * MiB + 512 * 1024;
constexpr size_t WS_PRM = 25 * MiB;
constexpr int PRM_POOLW = 0, PRM_POOLSC = 32768, PRM_QG = 33280, PRM_KG = 33408, PRM_SINK = 33536, PRM_MU = 33552, PRM_W0 = 35216, PRM_WUP = 35728,
              PRM_A0 = 52112, PRM_AUP = 52624, PRM_KK = 69008, PRM_KA = 69520, PRM_RK = 70032, PRM_LNG = 70544, PRM_LNB = 71056, PRM_END = 71568;
constexpr size_t WS_WUPF = WS_PRM + 512 * 1024;
#define PRM(off) ((const float*)(ws + WS_PRM) + (off))
__device__ __forceinline__ const float* inp_ptr(const unsigned char* ws, int k) {
    const unsigned long long v = ((const unsigned long long*)(ws + (size_t)32768))[k];
    const unsigned lo = __builtin_amdgcn_readfirstlane((unsigned)v), hi = __builtin_amdgcn_readfirstlane((unsigned)(v >> 32));
    return (const float*)(((unsigned long long)hi << 32) | lo);
}
#define INP(k) inp_ptr(ws, (k))
constexpr size_t WS_XB = 32 * MiB;
constexpr size_t WS_U = 96 * MiB;
constexpr size_t WS_Q = 112 * MiB;
constexpr size_t WS_K = 144 * MiB;
constexpr size_t WS_VT = 152 * MiB;
constexpr size_t WS_RIN = 160 * MiB;
constexpr size_t WS_GM = 216 * MiB;
constexpr size_t WS_PA = 280 * MiB;
constexpr size_t WS_PW = 344 * MiB;
constexpr size_t WS_PV = 376 * MiB;
constexpr size_t WS_ORAW = 408 * MiB;
constexpr size_t WS_PO = 28 * MiB;
#if SCAN_IMPL == 2
constexpr size_t WS_PB = 32 * MiB;
#else
constexpr size_t WS_PB = 280 * MiB;
#endif
constexpr size_t WS_ORAW2 = 440 * MiB;
constexpr size_t WS_END = 476 * MiB;

struct Params {
    const float* in[25];
    float* out;
    unsigned char* ws;
    int ph_lo, ph_hi;
};

__device__ __forceinline__ unsigned pk_bf16(float lo, float hi) { f32x2 v = {lo, hi}; bf2_t b = __builtin_convertvector(v, bf2_t); return __builtin_bit_cast(unsigned, b); }
__device__ __forceinline__ h2_t as_h2(unsigned u) { return __builtin_bit_cast(h2_t, u); }
__device__ __forceinline__ unsigned pk_f16(float lo, float hi) { h2_t h = {(_Float16)lo, (_Float16)hi}; return __builtin_bit_cast(unsigned, h); }
__device__ __forceinline__ float bf_lo(unsigned u) { return __uint_as_float(u << 16); }
__device__ __forceinline__ float bf_hi(unsigned u) { return __uint_as_float(u & 0xffff0000u); }
__device__ __forceinline__ float bf1(bf16_t b) { return __uint_as_float(((unsigned)b) << 16); }
__device__ __forceinline__ bf16_t f2bf(float f) { return (bf16_t)(pk_bf16(f, 0.f) & 0xffffu); }
__device__ __forceinline__ float fast_exp(float x) { return __builtin_amdgcn_exp2f(x * LOG2E); }
__device__ __forceinline__ float sigmoidf_(float x) { return __builtin_amdgcn_rcpf(1.0f + fast_exp(-x)); }
__device__ __forceinline__ float siluf_(float x) { return x * sigmoidf_(x); }
#define DPPF(z, CTRL) __builtin_bit_cast(float, __builtin_amdgcn_update_dpp(0, __builtin_bit_cast(int, (z)), (CTRL), 0xf, 0xf, true))
__device__ __forceinline__ float wave_sum(float v) {
    v += DPPF(v, 0xB1); v += DPPF(v, 0x4E); v += DPPF(v, 0x124); v += DPPF(v, 0x128);
    { const auto sw = __builtin_amdgcn_permlane16_swap(__float_as_uint(v), __float_as_uint(v), false, false); v = __uint_as_float(sw[0]) + __uint_as_float(sw[1]); }
    { const auto sw = __builtin_amdgcn_permlane32_swap(__float_as_uint(v), __float_as_uint(v), false, false); v = __uint_as_float(sw[0]) + __uint_as_float(sw[1]); }
    return v;
}
__device__ __forceinline__ float wave_max(float v) {
    v = fmaxf(v, DPPF(v, 0xB1)); v = fmaxf(v, DPPF(v, 0x4E)); v = fmaxf(v, DPPF(v, 0x124)); v = fmaxf(v, DPPF(v, 0x128));
    { const auto sw = __builtin_amdgcn_permlane16_swap(__float_as_uint(v), __float_as_uint(v), false, false); v = fmaxf(__uint_as_float(sw[0]), __uint_as_float(sw[1])); }
    { const auto sw = __builtin_amdgcn_permlane32_swap(__float_as_uint(v), __float_as_uint(v), false, false); v = fmaxf(__uint_as_float(sw[0]), __uint_as_float(sw[1])); }
    return v;
}
__device__ __forceinline__ float sum_x16_x32(float v) {
    { const auto sw = __builtin_amdgcn_permlane16_swap(__float_as_uint(v), __float_as_uint(v), false, false); v = __uint_as_float(sw[0]) + __uint_as_float(sw[1]); }
    { const auto sw = __builtin_amdgcn_permlane32_swap(__float_as_uint(v), __float_as_uint(v), false, false); v = __uint_as_float(sw[0]) + __uint_as_float(sw[1]); }
    return v;
}
__device__ __forceinline__ float sum16(float v) {
    v += __shfl_xor(v, 1); v += __shfl_xor(v, 2); v += __shfl_xor(v, 4); v += __shfl_xor(v, 8); return v;
}
#define DPPX(z, CTRL) __builtin_bit_cast(float, __builtin_amdgcn_update_dpp(0, __builtin_bit_cast(int, (z)), (CTRL), 0xf, 0xf, true))
__device__ __forceinline__ float sum16d(float v) {
    v += DPPX(v, 0xB1); v += DPPX(v, 0x4E); v += DPPX(v, 0x124); v += DPPX(v, 0x128); return v;
}
__device__ __forceinline__ void store8_bf16(bf16_t* p, f32x4 a, f32x4 b) {
    u32x4 w; w.x = pk_bf16(a[0], a[1]); w.y = pk_bf16(a[2], a[3]); w.z = pk_bf16(b[0], b[1]); w.w = pk_bf16(b[2], b[3]);
    *(u32x4*)p = w;
}

__host__ __device__ __forceinline__ int src_col_in(int n) {
    const int pn = n >> 8, p = n & 255, bj = p >> 7, wc = (p >> 5) & 3, j = p & 31, nn = j >> 4, fq = (j >> 2) & 3, e = j & 3;
    const int i8 = 8 * fq + 4 * nn + e;
    const int gen = 128 * bj + 32 * wc + i8;
    const int hd = 64 * wc + 32 * bj + i8;
    switch (pn) {
        case 0: return gen;
        case 1: return 256 + gen;
        case 2: return 512 + hd;
        case 3: return 768 + hd;
        case 4: return 1024 + hd;
        case 5: return 1280 + gen;
        case 6: return 1536 + gen;
        case 7: return 1792 + gen;
        case 8: return 2048 + gen;
        case 9: return 2304 + gen;
        case 10: return 2624 + gen;
        default: return gen < 64 ? 2560 + gen : -1;
    }
}
__host__ __device__ __forceinline__ int src_col_out(int n) {
    const int pn = n >> 8, p = n & 255, bj = p >> 7, wc = (p >> 5) & 3, j = p & 31, nn = j >> 4, fq = (j >> 2) & 3, e = j & 3;
    return pn * 256 + 128 * bj + 32 * wc + 8 * fq + 4 * nn + e;
}

struct EpiIn {
    static constexpr bool PERM = false, AFTER_DRAIN = false, IDEMPOTENT = true;
    unsigned char* ws; float* out; const float* qg; const float* kg; int layer;
    __device__ __forceinline__ void preload(const pg8::Unit& u, int wr, int fr, float (&pre)[8]) const {
        const float* RS = (const float*)(ws + WS_RS) + (size_t)layer * MP + u.pm * 256 + wr * 64 + fr;
#pragma unroll
        for (int g = 0; g < 8; ++g) pre[g] = RS[(g >> 2) * 128 + (g & 3) * 16];
    }
    template <int KIND>
    __device__ __forceinline__ void body(const f32x4 (&acc)[2][2][4][2], const pg8::Unit& u, int wr, int wc, int fr, int fq, const float (&pre)[8]) const {
        const int pn = u.pn;
        const int row0 = u.pm * 256 + wr * 64 + fr;
        const int i8 = 8 * fq;
        float rsv[2][4];
#pragma unroll
        for (int ai = 0; ai < 2; ++ai)
#pragma unroll
            for (int m = 0; m < 4; ++m) rsv[ai][m] = pre[ai * 4 + m];
        if constexpr (KIND == 5) {
            const float* g = (pn == 4) ? kg : qg;
            const f32x4 gl0 = *(const f32x4*)(g + i8), gl1 = *(const f32x4*)(g + i8 + 4), gh0 = *(const f32x4*)(g + 32 + i8), gh1 = *(const f32x4*)(g + 36 + i8);
            const float osc = (pn == 4) ? 1.0f : QSCALE;
            const int t0 = row0 & (SEQ - 1), b = row0 >> 11;
            const f32x4* cs0 = (const f32x4*)((const f32x2*)(ws + WS_ROPE) + (size_t)t0 * 32 + i8);
            f32x4 nc[4];
#pragma unroll
            for (int i = 0; i < 4; ++i) nc[i] = cs0[i];
#pragma unroll
            for (int gi = 0; gi < 8; ++gi) {
                const int ai = gi >> 2, m = gi & 3;
                const int r = row0 + ai * 128 + m * 16, t = t0 + ai * 128 + m * 16;
                const float ri = __builtin_amdgcn_rsqf(rsv[ai][m] * (1.0f / 1024.0f) + 1e-6f);
                f32x4 cc[4];
#pragma unroll
                for (int i = 0; i < 4; ++i) cc[i] = nc[i];
                if (gi < 7) { const f32x4* cn = cs0 + (size_t)((((gi + 1) >> 2) * 128 + ((gi + 1) & 3) * 16) * 16);
#pragma unroll
                    for (int i = 0; i < 4; ++i) nc[i] = cn[i]; }
                float ss = 0.f;
#pragma unroll
                for (int bj = 0; bj < 2; ++bj)
#pragma unroll
                    for (int nn = 0; nn < 2; ++nn) { const f32x4 v = acc[ai][bj][m][nn]; ss += (v[0] * v[0] + v[1] * v[1]) + (v[2] * v[2] + v[3] * v[3]); }
                ss = sum_x16_x32(ss);
                ss *= ri * ri;
                const float sc = ri * __builtin_amdgcn_rsqf(ss * (1.0f / 64.0f) + 1e-6f);
                bf16_t* pq = (pn == 4) ? (bf16_t*)(ws + WS_K) + (size_t)r * 128 + wc * 64 + i8 : (bf16_t*)(ws + WS_Q) + (size_t)r * 512 + ((pn - 2) * 4 + wc) * 64 + i8;
                float* o = out + (long)O_KP + ((((long)layer * NB + b) * 128 + (t - (SEQ - 128))) * 2 + wc) * 64 + i8;
                f32x4 lo[2], hi[2];
#pragma unroll
                for (int nn = 0; nn < 2; ++nn) {
                    const f32x4 a = acc[ai][0][m][nn] * sc * (nn ? gl1 : gl0), bq = acc[ai][1][m][nn] * sc * (nn ? gh1 : gh0); const f32x4 c0 = cc[2 * nn], c1 = cc[2 * nn + 1];
                    lo[nn][0] = a[0] * c0[0] - bq[0] * c0[1]; hi[nn][0] = a[0] * c0[1] + bq[0] * c0[0];
                    lo[nn][1] = a[1] * c0[2] - bq[1] * c0[3]; hi[nn][1] = a[1] * c0[3] + bq[1] * c0[2];
                    lo[nn][2] = a[2] * c1[0] - bq[2] * c1[1]; hi[nn][2] = a[2] * c1[1] + bq[2] * c1[0];
                    lo[nn][3] = a[3] * c1[2] - bq[3] * c1[3]; hi[nn][3] = a[3] * c1[3] + bq[3] * c1[2];
                }
                if (pn == 4 && t >= SEQ - 128) { *(f32x4*)o = lo[0]; *(f32x4*)(o + 4) = lo[1]; *(f32x4*)(o + 32) = hi[0]; *(f32x4*)(o + 36) = hi[1]; }
                store8_bf16(pq, lo[0] * osc, lo[1] * osc); store8_bf16(pq + 32, hi[0] * osc, hi[1] * osc);
                asm volatile("" ::: "memory");
            }
            return;
        }
#pragma unroll
        for (int ai = 0; ai < 2; ++ai)
#pragma unroll
            for (int m = 0; m < 4; ++m) {
                const int r = row0 + ai * 128 + m * 16;
                const int t = r & (SEQ - 1), b = r >> 11;
                const float ri = __builtin_amdgcn_rsqf(rsv[ai][m] * (1.0f / 1024.0f) + 1e-6f);
                if (KIND == 0) {
                    bf16_t* p = (bf16_t*)(ws + WS_U) + (size_t)r * 256 + 32 * wc + i8;
                    float* o = out + (long)O_POOLP + (((long)layer * NB + b) * 15 + (t - (SEQ - 15))) * 256 + 32 * wc + i8;
#pragma unroll
                    for (int bj = 0; bj < 2; ++bj) { const f32x4 v0 = acc[ai][bj][m][0] * ri, v1 = acc[ai][bj][m][1] * ri;
                        store8_bf16(p + 128 * bj, v0, v1);
                        if (t >= SEQ - 15) { *(f32x4*)(o + 128 * bj) = v0; *(f32x4*)(o + 128 * bj + 4) = v1; } }
                } else if (KIND == 1) {
                    const int cbase = (pn == 1) ? 0 : (pn == 5) ? 256 : (pn == 6) ? 512 : 768;
                    bf16_t* p = (bf16_t*)(ws + WS_GM) + (size_t)r * 1024 + cbase + 32 * wc + i8;
#pragma unroll
                    for (int bj = 0; bj < 2; ++bj) { f32x4 v0 = acc[ai][bj][m][0] * ri, v1 = acc[ai][bj][m][1] * ri;
#pragma unroll
                        for (int e = 0; e < 4; ++e) { v0[e] = siluf_(v0[e]); v1[e] = siluf_(v1[e]); }
                        store8_bf16(p + 128 * bj, v0, v1); }
                } else if (KIND == 2) {
                    const int cbase = (pn - 7) * 256 + 32 * wc + i8;
                    bf16_t* p = (bf16_t*)(ws + WS_RIN) + (size_t)r * DSH + cbase;
                    float* o = out + O_SHP + ((size_t)layer * NB + b) * DSH + cbase;
#pragma unroll
                    for (int bj = 0; bj < 2; ++bj) { const f32x4 v0 = acc[ai][bj][m][0] * ri, v1 = acc[ai][bj][m][1] * ri;
                        store8_bf16(p + 128 * bj, v0, v1);
                        if (t == SEQ - 1) { *(f32x4*)(o + 128 * bj) = v0; *(f32x4*)(o + 128 * bj + 4) = v1; } }
                } else if (KIND == 3) {
                    const int cbase = 768 + 32 * wc + i8;
                    const f32x4 v0 = acc[ai][0][m][0] * ri, v1 = acc[ai][0][m][1] * ri;
                    store8_bf16((bf16_t*)(ws + WS_RIN) + (size_t)r * DSH + cbase, v0, v1);
                    if (t == SEQ - 1) { float* o = out + O_SHP + ((size_t)layer * NB + b) * DSH + cbase; *(f32x4*)o = v0; *(f32x4*)(o + 4) = v1; }
                } else if (KIND == 4) {
                    const int h = wc - 2;
                    bf16_t* vt = (bf16_t*)(ws + WS_VT) + ((size_t)(b * 2 + h) * 64) * SEQ + t;
                    float* o = out + (long)O_VP + ((((long)layer * NB + b) * 128 + (t - (SEQ - 128))) * 2 + h) * 64 + i8;
#pragma unroll
                    for (int bj = 0; bj < 2; ++bj) { const f32x4 v0 = acc[ai][bj][m][0] * ri, v1 = acc[ai][bj][m][1] * ri;
#pragma unroll
                        for (int e = 0; e < 4; ++e) { vt[(size_t)(32 * bj + i8 + e) * SEQ] = f2bf(v0[e]); vt[(size_t)(32 * bj + i8 + 4 + e) * SEQ] = f2bf(v1[e]); }
                        if (t >= SEQ - 128) { *(f32x4*)(o + 32 * bj) = v0; *(f32x4*)(o + 32 * bj + 4) = v1; } }
                }
                asm volatile("" ::: "memory");
            }
    }
    __device__ __forceinline__ void operator()(const f32x4 (&acc)[2][2][4][2], const pg8::Unit& u, int wr, int wc, int fr, int fq, const float (&pre)[8]) const {
        asm volatile("" : "+v"(fr), "+v"(fq));
        const int pn = u.pn;
        if (pn == 0) body<0>(acc, u, wr, wc, fr, fq, pre);
        else if (pn == 1 || pn == 5 || pn == 6 || pn == 10) body<1>(acc, u, wr, wc, fr, fq, pre);
        else if (pn >= 7 && pn <= 9) body<2>(acc, u, wr, wc, fr, fq, pre);
        else if (pn == 11) { if (wc < 2) body<3>(acc, u, wr, wc, fr, fq, pre); }
        else if (pn == 4 && wc >= 2) body<4>(acc, u, wr, wc, fr, fq, pre);
        else body<5>(acc, u, wr, wc, fr, fq, pre);
    }
};

struct EpiOut {
    static constexpr bool PERM = false, AFTER_DRAIN = false, IDEMPOTENT = false;
    const float* resid; float* out; bf16_t* XB; float* RS; int layer;
    __device__ __forceinline__ void preload(const pg8::Unit&, int, int, float (&)[8]) const {}
    __device__ __forceinline__ void operator()(const f32x4 (&acc)[2][2][4][2], const pg8::Unit& u, int wr, int wc, int fr, int fq, const float (&)[8]) const {
        asm volatile("" : "+v"(fr), "+v"(fq));
        const int row0 = u.pm * 256 + wr * 64 + fr;
        const int cb = u.pn * 256 + 32 * wc + 8 * fq;
        const size_t off0 = (size_t)row0 * DM + cb;
#define EPO_OFF(g) ((size_t)(row0 + ((g) >> 2) * 128 + ((g) & 3) * 16) * DM + cb)
        u32x4 nb[8][2];
#pragma unroll
        for (int g = 0; g < 8; ++g)
#pragma unroll
            for (int bj = 0; bj < 2; ++bj) nb[g][bj] = *(const u32x4*)(XB + EPO_OFF(g) + bj * 128);
#pragma unroll
        for (int g = 0; g < 8; ++g) {
            const int ai = g >> 2, m = g & 3;
            const int r = row0 + ai * 128 + m * 16;
            const size_t off = EPO_OFF(g);
            float ss = 0.f;
#pragma unroll
            for (int bj = 0; bj < 2; ++bj) {
                const unsigned b0 = nb[g][bj][0], b1 = nb[g][bj][1], b2 = nb[g][bj][2], b3 = nb[g][bj][3];
                const f32x4 r0 = {bf_lo(b0), bf_hi(b0), bf_lo(b1), bf_hi(b1)}, r1 = {bf_lo(b2), bf_hi(b2), bf_lo(b3), bf_hi(b3)};
                const f32x4 y0 = acc[ai][bj][m][0] + r0, y1 = acc[ai][bj][m][1] + r1;
                if (layer == 0) { store8_bf16(XB + off + bj * 128, y0, y1);
#pragma unroll
                    for (int e = 0; e < 4; ++e) ss += y0[e] * y0[e] + y1[e] * y1[e]; }
                else { *(f32x4*)(out + off + bj * 128) = y0; *(f32x4*)(out + off + bj * 128 + 4) = y1; } }
            if (layer == 0) { ss = sum_x16_x32(ss);
                if (fq == 0) __hip_atomic_fetch_add(RS + r, ss, __ATOMIC_RELAXED, __HIP_MEMORY_SCOPE_AGENT); }
            asm volatile("" ::: "memory");
        }
#undef EPO_OFF
    }
};

__device__ __forceinline__ void p0_transpose_item(const float* W, int ldw, const float* g, bf16_t* WT, LAS float* scr, int item, int nblk, bool is_in, int lane) {
    const int kb = item / nblk, nb = item % nblk, k0 = 64 * kb, n0 = 32 * nb;
    const int sc = is_in ? src_col_in(n0 + (lane & 31)) : src_col_out(n0 + (lane & 31));
    float wv_[32], gv_[32];
#pragma unroll
    for (int i = 0; i < 32; ++i) { const int kk = 2 * i + (lane >> 5); wv_[i] = 0.f; gv_[i] = 1.f;
        if (sc >= 0) { wv_[i] = W[(size_t)(k0 + kk) * ldw + sc]; if (g) gv_[i] = g[k0 + kk]; } }
#pragma unroll
    for (int i = 0; i < 32; ++i) { const int kk = 2 * i + (lane >> 5); scr[kk * 33 + (lane & 31)] = wv_[i] * gv_[i]; }
    asm volatile("s_waitcnt lgkmcnt(0)" ::: "memory");
    const int c = lane & 7;
#pragma unroll
    for (int j = 0; j < 4; ++j) { const int n = (lane >> 3) + 8 * j; const LAS float* s = scr + (8 * c) * 33 + n;
        u32x4 o; o.x = pk_bf16(s[0 * 33], s[1 * 33]); o.y = pk_bf16(s[2 * 33], s[3 * 33]); o.z = pk_bf16(s[4 * 33], s[5 * 33]); o.w = pk_bf16(s[6 * 33], s[7 * 33]);
        *(u32x4*)(WT + (size_t)(n0 + n) * DM + k0 + 8 * c) = o; }
    asm volatile("s_waitcnt lgkmcnt(0)" ::: "memory");
}
__device__ __forceinline__ float row_to_bf16(const float* xrow, bf16_t* orow, int lane) {
    const f32x4* xr = (const f32x4*)xrow + lane;
    f32x4 v[4]; float s = 0.f;
#pragma unroll
    for (int j = 0; j < 4; ++j) { v[j] = xr[64 * j]; s += (v[j][0] * v[j][0] + v[j][1] * v[j][1]) + (v[j][2] * v[j][2] + v[j][3] * v[j][3]); }
    u32x2* o8 = (u32x2*)orow + lane;
#pragma unroll
    for (int j = 0; j < 4; ++j) { u32x2 w; w.x = pk_bf16(v[j][0], v[j][1]); w.y = pk_bf16(v[j][2], v[j][3]); o8[64 * j] = w; }
    return wave_sum(s);
}
__device__ __forceinline__ void p0_prologue(const Params& P, LAS unsigned char* lds, int G, int tid, int wid, int lane) {
    unsigned char* ws = P.ws;
    LAS float* scr = (LAS float*)(lds + wid * 16384);
    const int gw = blockIdx.x * 8 + wid, NGW = G * 8;
    constexpr int I_IN = 16 * 96, I_OUT = 16 * 32, NITEMS = 2 * I_IN + 2 * I_OUT;
    for (int it = gw; it < NITEMS; it += NGW) {
        int r = it;
        if (r < 2 * I_IN) { const int l = r / I_IN; r -= l * I_IN;
            p0_transpose_item(P.in[8] + (size_t)l * DM * DIN, DIN, P.in[7] + l * DM, (bf16_t*)(ws + WS_WIN) + (size_t)l * NPAD * DM, scr, r, 96, true, lane); continue; }
        r -= 2 * I_IN; { const int l = r / I_OUT; r -= l * I_OUT;
            p0_transpose_item(P.in[9] + (size_t)l * DM * DM, DM, nullptr, (bf16_t*)(ws + WS_WOUT) + (size_t)l * DM * DM, scr, r, 32, false, lane); }
    }
    if (blockIdx.x == 0 && tid < 7) ((unsigned long long*)(ws + WS_CTL + 32768))[tid] = (unsigned long long)P.in[tid];
#if INKERNEL_BAR_ZERO
    if (blockIdx.x == 0) for (int i = tid; i < 3584; i += 512) ((unsigned*)(ws + WS_CTL) + 4096)[i] = 0u;
#endif
    for (int e = blockIdx.x * 512 + tid; e < 32768; e += G * 512) {
        float v[15];
#define P0_LD(k, idx, n) v[k] = e < (n) ? P.in[idx][e] : 0.f;
        P0_LD(0, 10, 32768) P0_LD(1, 11, 512) P0_LD(2, 12, 128) P0_LD(3, 13, 128) P0_LD(4, 14, 16) P0_LD(5, 15, 1664) P0_LD(6, 16, 512) P0_LD(7, 17, 16384)
        P0_LD(8, 18, 512) P0_LD(9, 19, 16384) P0_LD(10, 20, 512) P0_LD(11, 21, 512) P0_LD(12, 22, 512) P0_LD(13, 23, 512) P0_LD(14, 24, 512)
#define P0_ST(k, off, n) if (e < (n)) ((float*)(ws + WS_PRM))[(off) + e] = v[k];
        P0_ST(0, PRM_POOLW, 32768) P0_ST(1, PRM_POOLSC, 512) P0_ST(2, PRM_QG, 128) P0_ST(3, PRM_KG, 128) P0_ST(4, PRM_SINK, 16) P0_ST(5, PRM_MU, 1664) P0_ST(6, PRM_W0, 512) P0_ST(7, PRM_WUP, 16384)
        P0_ST(8, PRM_A0, 512) P0_ST(9, PRM_AUP, 16384) P0_ST(10, PRM_KK, 512) P0_ST(11, PRM_KA, 512) P0_ST(12, PRM_RK, 512) P0_ST(13, PRM_LNG, 512) P0_ST(14, PRM_LNB, 512)
    }
    for (int e = blockIdx.x * 512 + tid; e < 2 * 2 * 16 * 64 * 8; e += G * 512) {
        const int j = e & 7, ln = (e >> 3) & 63, nb = (e >> 9) & 15, mat = (e >> 13) & 1, l = e >> 14;
        const float* up = P.in[mat ? 19 : 17] + (size_t)l * 32 * 256;
        ((bf16_t*)(ws + WS_WUPF))[e] = f2bf(up[(8 * (ln >> 4) + j) * 256 + 16 * nb + (ln & 15)]);
    }
    for (int e = blockIdx.x * 512 + tid; e < 2049 * 32; e += G * 512) {
        const int pi = e >> 5, i = e & 31; const int pos = pi < 2048 ? pi : 16384;
        const float fr = (float)pow(10000.0, -(double)i / 32.0);
        const float ang = (float)pos * fr;
        f32x2 cs; cs.x = cosf(ang); cs.y = sinf(ang);
        ((f32x2*)(ws + WS_ROPE))[e] = cs;
    }
    for (int m0 = gw; m0 < MP; m0 += 4 * NGW) {
        f32x4 v[4][4];
#pragma unroll
        for (int j = 0; j < 4; ++j) { const int m = m0 + j * NGW; if (m < MP) { const f32x4* xr = (const f32x4*)(P.in[0] + (size_t)m * DM) + lane;
#pragma unroll
            for (int c = 0; c < 4; ++c) v[j][c] = xr[64 * c]; } }
#pragma unroll
        for (int j = 0; j < 4; ++j) { const int m = m0 + j * NGW; if (m < MP) { float s_ = 0.f;
#pragma unroll
            for (int c = 0; c < 4; ++c) s_ += (v[j][c][0] * v[j][c][0] + v[j][c][1] * v[j][c][1]) + (v[j][c][2] * v[j][c][2] + v[j][c][3] * v[j][c][3]);
            u32x2* o8 = (u32x2*)((bf16_t*)(ws + WS_XB) + (size_t)m * DM) + lane;
#pragma unroll
            for (int c = 0; c < 4; ++c) { u32x2 w; w.x = pk_bf16(v[j][c][0], v[j][c][1]); w.y = pk_bf16(v[j][c][2], v[j][c][3]); o8[64 * c] = w; }
            s_ = wave_sum(s_);
            if (lane < 2) ((float*)(ws + WS_RS))[(size_t)lane * MP + m] = lane == 0 ? s_ : 0.f; } }
    }
    for (int ms = gw; ms < MS; ms += NGW) { const float s_ = row_to_bf16(P.in[1] + (size_t)ms * DM, (bf16_t*)(ws + WS_XBS) + (size_t)ms * DM, lane);
        ((float*)(ws + WS_RSS))[ms * 64 + lane] = lane == 0 ? s_ : 0.f; }
}

template <bool IS_IN>
__device__ __forceinline__ void skinny_unit(const Params& P, int layer, int unit, int wid, int lane) {
    unsigned char* ws = P.ws;
    const bf16_t* A = IS_IN ? (const bf16_t*)(ws + WS_XBS) : (const bf16_t*)(ws + WS_MIXS);
    const bf16_t* Bt = IS_IN ? (const bf16_t*)(ws + WS_WIN) + (size_t)layer * NPAD * DM : (const bf16_t*)(ws + WS_WOUT) + (size_t)layer * DM * DM;
    const int n0 = unit * 16, r16 = lane & 15, kq = lane >> 4;
    const bf16x8* ap = (const bf16x8*)(A + (size_t)(16 * wid + r16) * DM + 8 * kq);
    const bf16x8* bp = (const bf16x8*)(Bt + (size_t)(n0 + r16) * DM + 8 * kq);
    f32x4 acc = {0.f, 0.f, 0.f, 0.f};
    float rsv[16];
    if (IS_IN) { const float* RSS = (const float*)(ws + WS_RSS);
#pragma unroll
        for (int rr = 0; rr < 16; ++rr) rsv[rr] = RSS[(16 * wid + rr) * 64 + lane]; }
    const int kst = (unit * 5 + wid * 3) & 31;
#pragma unroll
    for (int hf = 0; hf < 2; ++hf) {
        bf16x8 av[16], bv[16];
#pragma unroll
        for (int i = 0; i < 16; ++i) { const int k = (kst + hf * 16 + i) & 31; av[i] = ap[k * 4]; bv[i] = bp[k * 4]; }
#pragma unroll
        for (int i = 0; i < 16; ++i) acc = __builtin_amdgcn_mfma_f32_16x16x32_bf16(av[i], bv[i], acc, 0, 0, 0);
    }
    const int n = n0 + r16;
    if (IS_IN) {
        float rv = 0.f;
#pragma unroll
        for (int rr = 0; rr < 16; ++rr) { const float s = wave_sum(rsv[rr]); rv = (lane == rr) ? s : rv; }
        rv = __builtin_amdgcn_rsqf(rv * (1.0f / 1024.0f) + 1e-6f);
        const int lc = src_col_in(n);
        float* ZS = (float*)(ws + WS_ZS);
#pragma unroll
        for (int reg = 0; reg < 4; ++reg) { const float ri = __shfl(rv, 4 * kq + reg); if (lc >= 0) ZS[(size_t)(16 * wid + 4 * kq + reg) * DIN + lc] = acc[reg] * ri; }
    } else {
        const int lc = src_col_out(n);
        const float* resid = layer == 0 ? INP(1) : P.out + O_YS;
        float* out = P.out + O_YS;
        bf16_t* XBS = (bf16_t*)(ws + WS_XBS); float* RSS = (float*)(ws + WS_RSS);
#pragma unroll
        for (int reg = 0; reg < 4; ++reg) { const int row = 16 * wid + 4 * kq + reg;
            const float y = resid[(size_t)row * DM + lc] + acc[reg];
            out[(size_t)row * DM + lc] = y;
            if (layer == 0) { XBS[(size_t)row * DM + lc] = f2bf(y); const float s = sum16d(y * y); if (r16 == 0) RSS[row * 64 + unit] = s; } }
    }
}

constexpr int PL_ROW = 144, PL_WAVE = 16 * PL_ROW;
template <int W_>
__device__ __forceinline__ void pool_wave(const Params& P, int layer, int b, int t0, int g, LAS unsigned char* lw, int lane, bool dry) {
    unsigned char* ws = P.ws;
    const bf16_t* ub = (const bf16_t*)(ws + WS_U) + ((size_t)b * SEQ) * 256 + 64 * g + lane;
    const int r16 = lane & 15, kq = lane >> 4;
    const float* pw = PRM(PRM_POOLW) + ((size_t)(layer * 4 + g) * 64) * 64 + r16;
    bf16x8 bfr[4][2];
#pragma unroll
    for (int nb = 0; nb < 4; ++nb)
#pragma unroll
        for (int kk = 0; kk < 2; ++kk) { u32x4 w;
            const float* q = pw + (size_t)(8 * kq + 32 * kk) * 64 + 16 * nb;
            w.x = pk_bf16(q[0], q[64]); w.y = pk_bf16(q[128], q[192]); w.z = pk_bf16(q[256], q[320]); w.w = pk_bf16(q[384], q[448]);
            bfr[nb][kk] = __builtin_bit_cast(bf16x8, w); }
    f32x4 scl[4];
#pragma unroll
    for (int nb = 0; nb < 4; ++nb) scl[nb] = *(const f32x4*)(PRM(PRM_POOLSC) + layer * 256 + 64 * g + 16 * nb + 4 * kq);
    float up[16], un[16];
#pragma unroll
    for (int j = 0; j < 16; ++j) { const int tt = t0 - 16 + j; up[j] = tt >= 0 ? bf1(ub[(long)tt * 256]) : 0.f; }
    float win = 0.f;
#pragma unroll
    for (int j = 1; j < W_; ++j) win += up[16 - j];
    bf16_t* gmb = (bf16_t*)(ws + WS_GM) + ((size_t)b * SEQ + t0 + r16) * 1024 + 64 * g + 4 * kq;
    bf16_t nr[16]; u32x2 ngt[4];
#pragma unroll
    for (int j = 0; j < 16; ++j) nr[j] = ub[(size_t)(t0 + j) * 256];
#pragma unroll
    for (int nb = 0; nb < 4; ++nb) ngt[nb] = *(const u32x2*)(gmb + 16 * nb);
    for (int tq = 0; tq < 64; tq += 16) {
#pragma unroll
        for (int j = 0; j < 16; ++j) un[j] = bf1(nr[j]);
        u32x2 gt[4];
#pragma unroll
        for (int nb = 0; nb < 4; ++nb) gt[nb] = ngt[nb];
        if (tq + 16 < 64) {
#pragma unroll
            for (int j = 0; j < 16; ++j) nr[j] = ub[(size_t)(t0 + tq + 16 + j) * 256];
#pragma unroll
            for (int nb = 0; nb < 4; ++nb) ngt[nb] = *(const u32x2*)(gmb + (size_t)(tq + 16) * 1024 + 16 * nb); }
#pragma unroll
        for (int j = 0; j < 16; ++j) { const int t = t0 + tq + j;
            win += un[j];
            const float pooled = (t + 1 >= W_) ? win * (1.0f / (float)W_) - un[j] : win / (float)(t + 1) - un[j];
            win -= (j - W_ + 1 >= 0) ? un[(j - W_ + 1) & 15] : up[(16 + j - W_ + 1) & 15];
            *(LAS bf16_t*)(lw + j * PL_ROW + lane * 2) = f2bf(pooled); }
        const bf16x8 a0 = *(const LAS bf16x8*)(lw + r16 * PL_ROW + (8 * kq) * 2), a1 = *(const LAS bf16x8*)(lw + r16 * PL_ROW + (8 * kq + 32) * 2);
#pragma unroll
        for (int nb = 0; nb < 4; ++nb) { f32x4 acc = {0.f, 0.f, 0.f, 0.f};
            acc = __builtin_amdgcn_mfma_f32_16x16x32_bf16(bfr[nb][0], a0, acc, 0, 0, 0);
            acc = __builtin_amdgcn_mfma_f32_16x16x32_bf16(bfr[nb][1], a1, acc, 0, 0, 0);
            const unsigned g0 = gt[nb].x, g1 = gt[nb].y;
            u32x2 w; w.x = pk_bf16(acc[0] * scl[nb][0] * bf_lo(g0), acc[1] * scl[nb][1] * bf_hi(g0)); w.y = pk_bf16(acc[2] * scl[nb][2] * bf_lo(g1), acc[3] * scl[nb][3] * bf_hi(g1));
            *(u32x2*)(gmb + (size_t)tq * 1024 + 16 * nb) = dry ? gt[nb] : w; }
#pragma unroll
        for (int j = 0; j < 16; ++j) up[j] = un[j];
    }
}
__device__ __forceinline__ void pool_unit(const Params& P, int layer, int unit, LAS unsigned char* lds, int wid, int lane, bool dry = false) {
    const int b = unit >> 4, chunk = unit & 15, g = wid & 3, half = wid >> 2;
    const int t0 = chunk * 128 + half * 64;
    LAS unsigned char* lw = lds + wid * 2560;
    if (g == 0) pool_wave<2>(P, layer, b, t0, g, lw, lane, dry);
    else if (g == 1) pool_wave<4>(P, layer, b, t0, g, lw, lane, dry);
    else if (g == 2) pool_wave<8>(P, layer, b, t0, g, lw, lane, dry);
    else pool_wave<16>(P, layer, b, t0, g, lw, lane, dry);
}

constexpr int KS_STRIDE = 144, VS_STRIDE = 520, ATT_VOFF = 256 * KS_STRIDE;
template <bool STAGE, bool COMPUTE>
__device__ __forceinline__ void attn_unit(const Params& P, int layer, int unit, LAS unsigned char* lds, LAS unsigned char* inv_strip, int tid, int wid, int lane, bool dry = false) {
    unsigned char* ws = P.ws;
    const bf16_t* Q = (const bf16_t*)(ws + WS_Q); const bf16_t* K = (const bf16_t*)(ws + WS_K); const bf16_t* VT = (const bf16_t*)(ws + WS_VT);
    bf16_t* GM = (bf16_t*)(ws + WS_GM);
    const int kvh = unit & 1, n = (unit >> 1) & 15, b = unit >> 5;
    const int tk0 = n * 128 - 128;
    if (STAGE) {
#pragma unroll
    for (int i = 0; i < 4; ++i) { const int idx = tid + 512 * i; const int row = idx >> 3, c = idx & 7; const int t = tk0 + row;
        u32x4 v = {0u, 0u, 0u, 0u}; if (t >= 0) v = *(const u32x4*)(K + ((size_t)b * SEQ + t) * 128 + kvh * 64 + c * 8);
        *(LAS u32x4*)(lds + row * KS_STRIDE + c * 16) = v; }
#pragma unroll
    for (int i = 0; i < 4; ++i) { const int idx = tid + 512 * i; const int d = idx >> 5, c = idx & 31; const int t = tk0 + 8 * c;
        u32x4 v = {0u, 0u, 0u, 0u}; if (t >= 0) v = *(const u32x4*)(VT + ((size_t)(b * 2 + kvh) * 64 + d) * SEQ + t);
        LAS u32x2* dst = (LAS u32x2*)(lds + ATT_VOFF + d * VS_STRIDE + c * 16); dst[0] = (u32x2){v.x, v.y}; dst[1] = (u32x2){v.z, v.w}; }
    }
    if (!COMPUTE) return;
    const int hq = wid >> 1, qh = wid & 1, head = kvh * 4 + hq;
    const int r31 = lane & 31, h = lane >> 5;
    const float sink2 = PRM(PRM_SINK)[layer * 8 + head] * LOG2E;
    const bf16_t* qp0 = Q + ((size_t)b * SEQ + n * 128 + 64 * qh + r31) * 512 + head * 64 + 8 * h;
    bf16x8 nq[4];
#pragma unroll
    for (int ks = 0; ks < 4; ++ks) nq[ks] = *(const bf16x8*)(qp0 + 16 * ks);
#pragma unroll 1
    for (int qb2 = 0; qb2 < 2; ++qb2) {
        const int qb = 2 * qh + qb2, i0 = 32 * qb;
        bf16x8 qf[4];
#pragma unroll
        for (int ks = 0; ks < 4; ++ks) qf[ks] = nq[ks];
        if (qb2 == 0) {
#pragma unroll
            for (int ks = 0; ks < 4; ++ks) nq[ks] = *(const bf16x8*)(qp0 + (size_t)32 * 512 + 16 * ks); }
        f32x16 s[5];
#pragma unroll
        for (int kt = 0; kt < 5; ++kt) {
#pragma unroll
            for (int e = 0; e < 16; ++e) s[kt][e] = 0.f;
            const LAS unsigned char* kb = lds + (32 * (qb + kt) + r31) * KS_STRIDE + 16 * h;
#pragma unroll
            for (int ks = 0; ks < 4; ++ks) { const bf16x8 a = *(const LAS bf16x8*)(kb + 32 * ks); s[kt] = __builtin_amdgcn_mfma_f32_32x32x16_bf16(a, qf[ks], s[kt], 0, 0, 0); }
        }
        const float dqf = (float)(r31 - 4 * h);
        float mx = sink2;
#pragma unroll
        for (int kt = 0; kt < 5; ++kt) { if ((n > 0) || (qb + kt >= 4)) {
#pragma unroll
            for (int e = 0; e < 16; ++e) mx = fmaxf(mx, s[kt][e]); } }
        mx = fmaxf(mx, __shfl_xor(mx, 32));
        float sum = 0.f;
#pragma unroll
        for (int kt = 0; kt < 5; ++kt) { if ((n > 0) || (qb + kt >= 4)) {
#pragma unroll
            for (int e = 0; e < 16; ++e) { const float ko = (float)((e & 3) + 8 * (e >> 2));
                float p = __builtin_amdgcn_exp2f(s[kt][e] - mx);
                if (kt == 0) p *= __builtin_amdgcn_fmed3f(ko - dqf, 0.f, 1.f);
                if (kt == 4) p *= __builtin_amdgcn_fmed3f(dqf - ko + 1.0f, 0.f, 1.f);
                s[kt][e] = p; sum += p; } }
          else {
#pragma unroll
            for (int e = 0; e < 16; ++e) s[kt][e] = 0.f; } }
        sum += __shfl_xor(sum, 32);
        const float inv = 1.0f / (sum + __builtin_amdgcn_exp2f(sink2 - mx));
        bf16_t* gbase = GM + ((size_t)b * SEQ + n * 128 + i0 + r31) * 1024 + 256 + head * 64 + 8 * h;
        u32x4 gts[2][2];
#pragma unroll
        for (int db = 0; db < 2; ++db)
#pragma unroll
            for (int k = 0; k < 2; ++k) gts[db][k] = *(const u32x4*)(gbase + 32 * db + 16 * k);
        f32x16 o[2];
#pragma unroll
        for (int e = 0; e < 16; ++e) { o[0][e] = 0.f; o[1][e] = 0.f; }
#pragma unroll
        for (int kt = 0; kt < 5; ++kt)
#pragma unroll
            for (int s2 = 0; s2 < 2; ++s2) {
                u32x4 pw; pw.x = pk_bf16(s[kt][8 * s2 + 0], s[kt][8 * s2 + 1]); pw.y = pk_bf16(s[kt][8 * s2 + 2], s[kt][8 * s2 + 3]);
                pw.z = pk_bf16(s[kt][8 * s2 + 4], s[kt][8 * s2 + 5]); pw.w = pk_bf16(s[kt][8 * s2 + 6], s[kt][8 * s2 + 7]);
                const bf16x8 pf = __builtin_bit_cast(bf16x8, pw);
#pragma unroll
                for (int db = 0; db < 2; ++db) {
                    const LAS unsigned char* vb = lds + ATT_VOFF + (32 * db + r31) * VS_STRIDE + (32 * (qb + kt) + 16 * s2 + 4 * h) * 2;
                    const u32x2 v0 = *(const LAS u32x2*)vb, v1 = *(const LAS u32x2*)(vb + 16);
                    const u32x4 vw = {v0.x, v0.y, v1.x, v1.y};
                    o[db] = __builtin_amdgcn_mfma_f32_32x32x16_bf16(__builtin_bit_cast(bf16x8, vw), pf, o[db], 0, 0, 0);
                }
            }
#pragma unroll
        for (int db = 0; db < 2; ++db)
#pragma unroll
            for (int k = 0; k < 2; ++k) {
                float v[8];
#pragma unroll
                for (int i = 0; i < 4; ++i) { const auto sw = __builtin_amdgcn_permlane32_swap(__float_as_uint(o[db][8 * k + i]), __float_as_uint(o[db][8 * k + 4 + i]), false, false);
                    v[i] = __uint_as_float(sw[0]) * inv; v[4 + i] = __uint_as_float(sw[1]) * inv; }
                const u32x4 gg = gts[db][k]; const unsigned g0 = gg[0], g1 = gg[1], g2 = gg[2], g3 = gg[3];
                u32x4 w; w.x = pk_bf16(v[0] * bf_lo(g0), v[1] * bf_hi(g0)); w.y = pk_bf16(v[2] * bf_lo(g1), v[3] * bf_hi(g1));
                w.z = pk_bf16(v[4] * bf_lo(g2), v[5] * bf_hi(g2)); w.w = pk_bf16(v[6] * bf_lo(g3), v[7] * bf_hi(g3));
                *(u32x4*)(gbase + 32 * db + 16 * k) = dry ? gg : w;
            }
    }
}

__device__ __forceinline__ float tanhf_(float x) { const float e = fast_exp(2.0f * x); return 1.0f - 2.0f * __builtin_amdgcn_rcpf(e + 1.0f); }
struct PrepRaw { u32x2 r, k, v; };
__device__ __forceinline__ PrepRaw prep_load(const bf16_t* row, int c0, int lane) {
    PrepRaw x; x.r = *(const u32x2*)(row + c0); x.k = *(const u32x2*)(row + 256 + c0); x.v = *(const u32x2*)(row + 512 + c0); return x;
}
struct PrepConst { f32x4 mr, mk, mv, w0, a0, kkp, kap, rkp; };
__device__ __forceinline__ void prep_token(const Params& P, int layer, int r, int lane, const LAS unsigned char* lup, int ti, const PrepRaw& cu, const PrepRaw& pv_, float (&om)[4], const PrepConst& C, float& keep_rkr, float& keep_kr) {
    unsigned char* ws = P.ws;
    const int b = r >> 11, t = r & (SEQ - 1), c0 = 4 * lane, hh = lane >> 4;
    float rs[4], ks[4], vs[4];
    { const u32x2 cr = cu.r, ck = cu.k, cv = cu.v, pr = pv_.r, pk = pv_.k, pv = pv_.v;
      const f32x4 mr = C.mr, mk = C.mk, mv = C.mv;
      const float xr[4] = {bf_lo(cr.x), bf_hi(cr.x), bf_lo(cr.y), bf_hi(cr.y)}, yr[4] = {bf_lo(pr.x), bf_hi(pr.x), bf_lo(pr.y), bf_hi(pr.y)};
      const float xk[4] = {bf_lo(ck.x), bf_hi(ck.x), bf_lo(ck.y), bf_hi(ck.y)}, yk[4] = {bf_lo(pk.x), bf_hi(pk.x), bf_lo(pk.y), bf_hi(pk.y)};
      const float xv[4] = {bf_lo(cv.x), bf_hi(cv.x), bf_lo(cv.y), bf_hi(cv.y)}, yv[4] = {bf_lo(pv.x), bf_hi(pv.x), bf_lo(pv.y), bf_hi(pv.y)};
#pragma unroll
      for (int i = 0; i < 4; ++i) { rs[i] = xr[i] + (yr[i] - xr[i]) * mr[i]; ks[i] = xk[i] + (yk[i] - xk[i]) * mk[i]; vs[i] = xv[i] + (yv[i] - xv[i]) * mv[i]; } }
    float lw[4], la[4];
    { const u32x2 hw = *(const LAS u32x2*)(lup + (size_t)ti * 512 + c0 * 2), ha = *(const LAS u32x2*)(lup + 8192 + (size_t)ti * 512 + c0 * 2);
      const unsigned w0_ = hw[0], w1_ = hw[1], a0_ = ha[0], a1_ = ha[1];
      lw[0] = (float)as_h2(w0_).x; lw[1] = (float)as_h2(w0_).y; lw[2] = (float)as_h2(w1_).x; lw[3] = (float)as_h2(w1_).y;
      la[0] = (float)as_h2(a0_).x; la[1] = (float)as_h2(a0_).y; la[2] = (float)as_h2(a1_).x; la[3] = (float)as_h2(a1_).y; }
    const f32x4 w0 = C.w0, a0 = C.a0, kkp = C.kkp, kap = C.kap, rkp = C.rkp;
    float wv[4], av[4], kk[4], kt[4], bb[4];
    float ssq = 0.f, br = 0.f, kr = 0.f, rkr = 0.f;
#pragma unroll
    for (int i = 0; i < 4; ++i) {
        wv[i] = fast_exp(-0.6065306597126334f * sigmoidf_(w0[i] + lw[i]));
        av[i] = sigmoidf_(a0[i] + la[i]);
        kk[i] = ks[i] * kkp[i]; ssq += kk[i] * kk[i];
        kt[i] = ks[i] * (1.0f + (av[i] - 1.0f) * kap[i]);
        kr += kt[i] * rs[i]; rkr += rs[i] * kt[i] * rkp[i];
    }
    ssq = sum16d(ssq);
    const float kn = fminf(__builtin_amdgcn_rsqf(ssq), 1e12f);
#pragma unroll
    for (int i = 0; i < 4; ++i) { kk[i] *= kn; bb[i] = kk[i] * av[i]; br += bb[i] * rs[i]; }
    br = sum16d(br); kr = sum16d(kr); rkr = sum16d(rkr);
    float wr[4];
#pragma unroll
    for (int i = 0; i < 4; ++i) wr[i] = wv[i] * rs[i] - br * kk[i];
    const size_t rec = ((size_t)(b * 4 + hh) * SEQ + t);
    const int l16 = lane & 15;
#if SCAN_IMPL != 1
    u32x4* pa = (u32x4*)(ws + WS_PA) + rec * 32 + 2 * l16;
    pa[0] = (u32x4){pk_f16(kk[0], kk[1]), pk_f16(bb[0], bb[1]), pk_f16(kt[0], kt[1]), pk_f16(wr[0], wr[1])};
    pa[1] = (u32x4){pk_f16(kk[2], kk[3]), pk_f16(bb[2], bb[3]), pk_f16(kt[2], kt[3]), pk_f16(wr[2], wr[3])};
    *((f32x4*)(ws + WS_PW) + rec * 16 + l16) = (f32x4){wv[0], wv[1], wv[2], wv[3]};
#endif
#if SCAN_IMPL != 0
    if (SCAN_IMPL == 1 || layer == 0) {
        float uk[4], uw[4], bh[4], kh[4];
#pragma unroll
        for (int i = 0; i < 4; ++i) { uk[i] = om[i] * kk[i]; uw[i] = om[i] * wr[i]; om[i] *= wv[i]; const float inv = __builtin_amdgcn_rcpf(om[i]); bh[i] = bb[i] * inv; kh[i] = kt[i] * (inv * 0.0625f); }
        { const bool odd = lane & 1;
          u32x2* pb = (u32x2*)(ws + WS_PB) + rec * 64 + (odd ? 16 + l16 - 1 : l16);
          const unsigned uk0 = pk_f16(uk[0], uk[1]), uk1 = pk_f16(uk[2], uk[3]), uw0 = pk_f16(uw[0], uw[1]), uw1 = pk_f16(uw[2], uw[3]);
          const unsigned bh0 = pk_f16(bh[0], bh[1]), bh1 = pk_f16(bh[2], bh[3]), kh0 = pk_f16(kh[0], kh[1]), kh1 = pk_f16(kh[2], kh[3]);
          const unsigned s0 = odd ? uk0 : uw0, s1 = odd ? uk1 : uw1, s2 = odd ? bh0 : kh0, s3 = odd ? bh1 : kh1;
          const unsigned q0 = (unsigned)__builtin_amdgcn_update_dpp(0, (int)s0, 0xB1, 0xf, 0xf, true), q1 = (unsigned)__builtin_amdgcn_update_dpp(0, (int)s1, 0xB1, 0xf, 0xf, true);
          const unsigned q2 = (unsigned)__builtin_amdgcn_update_dpp(0, (int)s2, 0xB1, 0xf, 0xf, true), q3 = (unsigned)__builtin_amdgcn_update_dpp(0, (int)s3, 0xB1, 0xf, 0xf, true);
          *(u32x4*)pb = odd ? (u32x4){q0, q1, uw0, uw1} : (u32x4){uk0, uk1, q0, q1};
          *(u32x4*)(pb + 32) = odd ? (u32x4){q2, q3, kh0, kh1} : (u32x4){bh0, bh1, q2, q3}; }
#if DBG_DOUBLE & 4096
        { u32x2* pd = (u32x2*)(ws + WS_PW) + (rec & 65535) * 64 + l16;
          pd[0] = (u32x2){pk_f16(uk[0], uk[1]), pk_f16(uk[2], uk[3])}; pd[16] = (u32x2){pk_f16(uw[0], uw[1]), pk_f16(uw[2], uw[3])};
          pd[32] = (u32x2){pk_f16(bh[0], bh[1]), pk_f16(bh[2], bh[3])}; pd[48] = (u32x2){pk_f16(kh[0], kh[1]), pk_f16(kh[2], kh[3])}; }
#endif
        if ((t & 15) == 15) *((f32x4*)(ws + WS_PO) + ((size_t)(b * 4 + hh) * (SEQ / 16) + (t >> 4)) * 16 + l16) = (f32x4){om[0], om[1], om[2], om[3]};
    }
#endif
    *((u32x4*)(ws + WS_PV) + rec * 16 + l16) = (u32x4){pk_f16(vs[0], vs[0] * kr), pk_f16(vs[1], vs[1] * kr), pk_f16(vs[2], vs[2] * kr), pk_f16(vs[3], vs[3] * kr)};
    if (l16 == ti) { keep_rkr = rkr; keep_kr = kr; }
}
__device__ __forceinline__ void prep_run(const Params& P, int layer, int r0, int lane, LAS unsigned char* lup) {
    unsigned char* ws = P.ws;
    const bf16_t* RIN = (const bf16_t*)(ws + WS_RIN);
    const int c0 = 4 * lane;
    {
        const int tok = lane & 15, kq = lane >> 4, r = r0 + tok; const bool hp = (r & (SEQ - 1)) != 0;
        const float* mu = PRM(PRM_MU) + layer * DSH + 768 + 8 * kq;
        const bf16_t* cw = RIN + (size_t)r * DSH + 768 + 8 * kq;
        const u32x4 cww = *(const u32x4*)cw, caw = *(const u32x4*)(cw + 32);
        u32x4 pww = {0u, 0u, 0u, 0u}, paw = {0u, 0u, 0u, 0u};
        if (hp) { pww = *(const u32x4*)(cw - DSH); paw = *(const u32x4*)(cw - DSH + 32); }
        const f32x4 mw0 = *(const f32x4*)mu, mw1 = *(const f32x4*)(mu + 4), ma0 = *(const f32x4*)(mu + 32), ma1 = *(const f32x4*)(mu + 36);
        u32x4 fw, fa;
#pragma unroll
        for (int q = 0; q < 4; ++q) { const unsigned cwq = cww[q], pwq = pww[q], caq = caw[q], paq = paw[q];
            const float mlo = q < 2 ? mw0[2 * q] : mw1[2 * q - 4], mhi = q < 2 ? mw0[2 * q + 1] : mw1[2 * q - 3];
            const float nlo = q < 2 ? ma0[2 * q] : ma1[2 * q - 4], nhi = q < 2 ? ma0[2 * q + 1] : ma1[2 * q - 3];
            const float xl = bf_lo(cwq), xh = bf_hi(cwq), yl = bf_lo(caq), yh = bf_hi(caq);
            fw[q] = pk_bf16(tanhf_(xl + (bf_lo(pwq) - xl) * mlo), tanhf_(xh + (bf_hi(pwq) - xh) * mhi));
            fa[q] = pk_bf16(yl + (bf_lo(paq) - yl) * nlo, yh + (bf_hi(paq) - yh) * nhi); }
        const bf16x8 Aw = __builtin_bit_cast(bf16x8, fw), Aa = __builtin_bit_cast(bf16x8, fa);
        const u32x4* bfw = (const u32x4*)(ws + WS_WUPF) + (size_t)layer * 2 * 16 * 64 + lane;
#pragma unroll 4
        for (int nb = 0; nb < 16; ++nb) {
            const u32x4 bw = bfw[nb * 64], ba = bfw[(16 + nb) * 64];
            f32x4 z = {0.f, 0.f, 0.f, 0.f};
            const f32x4 dw = __builtin_amdgcn_mfma_f32_16x16x32_bf16(Aw, __builtin_bit_cast(bf16x8, bw), z, 0, 0, 0);
            const f32x4 da = __builtin_amdgcn_mfma_f32_16x16x32_bf16(Aa, __builtin_bit_cast(bf16x8, ba), z, 0, 0, 0);
            LAS _Float16* dst = (LAS _Float16*)lup + (size_t)(4 * kq) * 256 + 16 * nb + tok;
#pragma unroll
            for (int reg = 0; reg < 4; ++reg) { dst[reg * 256] = (_Float16)dw[reg]; dst[4096 + reg * 256] = (_Float16)da[reg]; }
        }
        asm volatile("s_waitcnt lgkmcnt(0)" ::: "memory");
    }
    PrepRaw pv_; pv_.r = (u32x2){0u, 0u}; pv_.k = (u32x2){0u, 0u}; pv_.v = (u32x2){0u, 0u};
    if ((r0 & (SEQ - 1)) != 0) pv_ = prep_load(RIN + (size_t)(r0 - 1) * DSH, c0, lane);
    PrepRaw cu = prep_load(RIN + (size_t)r0 * DSH, c0, lane);
    float om[4] = {1.f, 1.f, 1.f, 1.f};
    PrepConst C;
    { const float* mu = PRM(PRM_MU) + layer * DSH;
      C.mr = *(const f32x4*)(mu + c0); C.mk = *(const f32x4*)(mu + 256 + c0); C.mv = *(const f32x4*)(mu + 512 + c0);
      C.w0 = *(const f32x4*)(PRM(PRM_W0) + layer * 256 + c0); C.a0 = *(const f32x4*)(PRM(PRM_A0) + layer * 256 + c0);
      C.kkp = *(const f32x4*)(PRM(PRM_KK) + layer * 256 + c0); C.kap = *(const f32x4*)(PRM(PRM_KA) + layer * 256 + c0); C.rkp = *(const f32x4*)(PRM(PRM_RK) + layer * 256 + c0); }
    float keep_rkr = 0.f, keep_kr = 0.f;
#pragma unroll 2
    for (int i = 0; i < 16; ++i) {
        PrepRaw nx = cu;
        if (i < 15) nx = prep_load(RIN + (size_t)(r0 + i + 1) * DSH, c0, lane);
        prep_token(P, layer, r0 + i, lane, lup, i, cu, pv_, om, C, keep_rkr, keep_kr);
        pv_ = cu; cu = nx;
    }
    { const size_t o = (size_t)(r0 + (lane & 15)) * 4 + (lane >> 4); ((float*)(ws + WS_RKR))[o] = keep_rkr; ((float*)(ws + WS_KRA))[o] = keep_kr; }
    asm volatile("s_waitcnt lgkmcnt(0)" ::: "memory");
}

__device__ __forceinline__ void decode_mix(const Params& P, int layer, int tok, int part, LAS unsigned char* lds, int tid, int wid, int lane) {
    unsigned char* ws = P.ws;
    const float* z = (const float*)(ws + WS_ZS) + (size_t)tok * DIN;
    bf16_t* MIXS = (bf16_t*)(ws + WS_MIXS) + (size_t)tok * DM;
    constexpr int DK_ROW = 528, DK_V = 67072, DK_SCR = 134144;
    LAS float* L = (LAS float*)(lds + DK_SCR);
    LAS float* pooled = L;
    LAS float* qs = L + 256;
    LAS float* knew = L + 768;
    LAS float* vnew = L + 896;
    LAS float* scs = L + 1024;
    LAS float* xs = (LAS float*)lds;
    LAS float* kkn = xs + 832;
    LAS float* bvec = kkn + 256;
    LAS float* wvv = bvec + 256;
    LAS float* ktv = wvv + 256;
    LAS float* rrv = ktv + 256;
    LAS float* vvv = rrv + 256;
    LAS float* ov = vvv + 256;
    LAS float* rkrs = ov + 256;
    const size_t lt = (size_t)layer * MS + tok;
    if (part == 0) {
    const float* kc = INP(3) + lt * 128 * 128; const float* vc = INP(4) + lt * 128 * 128;
    {
        const f32x4* ks_ = (const f32x4*)(kc + 128); const f32x4* vs_ = (const f32x4*)(vc + 128);
        f32x4* kd = (f32x4*)(P.out + O_KS + lt * 128 * 128); f32x4* vd = (f32x4*)(P.out + O_VS + lt * 128 * 128);
        f32x4 kt_[8], vt_[8];
#pragma unroll
        for (int q = 0; q < 8; ++q) { const int i = tid + 512 * q; if (i < 127 * 32) { kt_[q] = ks_[i]; vt_[q] = vs_[i]; } }
#pragma unroll
        for (int q = 0; q < 8; ++q) { const int i = tid + 512 * q; if (i < 127 * 32) { kd[i] = kt_[q]; vd[i] = vt_[q];
            *(LAS f32x4*)(lds + (i >> 5) * DK_ROW + (i & 31) * 16) = kt_[q]; *(LAS f32x4*)(lds + DK_V + (i >> 5) * DK_ROW + (i & 31) * 16) = vt_[q]; } }
    }
    const f32x2 cs = ((const f32x2*)(ws + WS_ROPE))[2048 * 32 + (lane & 31)];
    {
        const float x = z[512 + wid * 64 + lane];
        const float ss = wave_sum(x * x);
        const float xn = x * (1.0f / sqrtf(ss * (1.0f / 64.0f) + 1e-6f)) * PRM(PRM_QG)[layer * 64 + lane];
        const float pr = __shfl_xor(xn, 32);
        qs[wid * 64 + lane] = (lane < 32 ? xn * cs.x - pr * cs.y : pr * cs.y + xn * cs.x) * 0.125f;
    }
    if (wid < 2) {
        const float x = z[1024 + wid * 64 + lane];
        const float ss = wave_sum(x * x);
        const float xn = x * (1.0f / sqrtf(ss * (1.0f / 64.0f) + 1e-6f)) * PRM(PRM_KG)[layer * 64 + lane];
        const float pr = __shfl_xor(xn, 32);
        const float kv = lane < 32 ? xn * cs.x - pr * cs.y : pr * cs.y + xn * cs.x;
        knew[wid * 64 + lane] = kv;
        P.out[O_KS + (lt * 128 + 127) * 128 + wid * 64 + lane] = kv;
    } else if (wid < 4) {
        const float x = z[1152 + (wid - 2) * 64 + lane];
        vnew[(wid - 2) * 64 + lane] = x;
        P.out[O_VS + (lt * 128 + 127) * 128 + (wid - 2) * 64 + lane] = x;
    }
    __syncthreads();
    {
        const int kvh = wid >> 2;
#pragma unroll
        for (int jj = 0; jj < 2; ++jj) { const int j = lane + 64 * jj; float a = 0.f;
            if (j < 127) { const LAS f32x4* kr_ = (const LAS f32x4*)(lds + j * DK_ROW + kvh * 256);
#pragma unroll
                for (int d4 = 0; d4 < 16; ++d4) { const f32x4 kq = kr_[d4]; const LAS float* qq = qs + wid * 64 + 4 * d4; a += kq[0] * qq[0] + kq[1] * qq[1] + kq[2] * qq[2] + kq[3] * qq[3]; } }
            else {
#pragma unroll 8
                for (int d = 0; d < 64; ++d) a += knew[kvh * 64 + d] * qs[wid * 64 + d]; }
            scs[wid * 128 + j] = a; }
    }
    __syncthreads();
    {
        const float sk = PRM(PRM_SINK)[layer * 8 + wid];
        const float s0 = scs[wid * 128 + lane], s1 = scs[wid * 128 + 64 + lane];
        const float m = fmaxf(wave_max(fmaxf(s0, s1)), sk);
        const float p0 = fast_exp(s0 - m), p1 = fast_exp(s1 - m);
        const float den = wave_sum(p0 + p1) + fast_exp(sk - m);
        scs[wid * 128 + lane] = p0 / den; scs[wid * 128 + 64 + lane] = p1 / den;
    }
    __syncthreads();
    {
        const int kvh = wid >> 2; float o = 0.f;
        const LAS float* vb = (const LAS float*)(lds + DK_V) + kvh * 64 + lane;
#pragma unroll 16
        for (int j = 0; j < 127; ++j) o += scs[wid * 128 + j] * vb[j * (DK_ROW / 4)];
        o += scs[wid * 128 + 127] * vnew[kvh * 64 + lane];
        MIXS[256 + wid * 64 + lane] = f2bf(o * siluf_(z[1280 + wid * 64 + lane]));
    }
    } else {
    const int row = tid >> 1, half = tid & 1, hd = row >> 6;
    const f32x4* sp = (const f32x4*)(INP(6) + (lt * 256 + row) * 64 + 32 * half);
    f32x4 S[8];
#pragma unroll
    for (int i = 0; i < 8; ++i) S[i] = sp[i];
    const float* mu = PRM(PRM_MU) + layer * DSH;
    const float* shp = INP(5) + lt * DSH;
    { const int i0 = tid, i1 = tid + 512;
      float x0 = 0.f, x1 = 0.f, s0 = 0.f, s1 = 0.f, m0 = 0.f, m1 = 0.f;
      if (i0 < DSH) { x0 = z[1792 + i0]; s0 = shp[i0]; m0 = mu[i0]; }
      if (i1 < DSH) { x1 = z[1792 + i1]; s1 = shp[i1]; m1 = mu[i1]; }
      if (i0 < DSH) { P.out[O_SHS + lt * DSH + i0] = x0; xs[i0] = x0 + (s0 - x0) * m0; }
      if (i1 < DSH) { P.out[O_SHS + lt * DSH + i1] = x1; xs[i1] = x1 + (s1 - x1) * m1; } }
    if (tid >= 256) {
        const int c = tid - 256, g = c >> 6, W_ = 2 << g;
        const float* buf = INP(2) + lt * 15 * 256 + c;
        float* po = P.out + O_POOLS + lt * 15 * 256 + c;
        const float u = z[c];
        float eb[15];
#pragma unroll
        for (int j = 0; j < 15; ++j) eb[j] = buf[j * 256];
        float win = u;
#pragma unroll
        for (int j = 0; j < 15; ++j) { if (j >= 16 - W_) win += eb[j]; if (j >= 1) po[(j - 1) * 256] = eb[j]; }
        po[14 * 256] = u;
        pooled[c] = win / (float)W_ - u;
    }
    __syncthreads();
    if (tid >= 256) {
        const int c = tid - 256, g = c >> 6, d = c & 63;
        const float* pw = PRM(PRM_POOLW) + ((size_t)(layer * 4 + g) * 64) * 64 + d;
        float a = 0.f;
#pragma unroll 32
        for (int cc = 0; cc < 64; ++cc) a += pooled[64 * g + cc] * pw[cc * 64];
        MIXS[c] = f2bf(a * PRM(PRM_POOLSC)[layer * 256 + c] * siluf_(z[256 + c]));
    }
    if (tid < 256) {
        const int c = tid;
        float lw = 0.f, la = 0.f;
#pragma unroll 16
        for (int j = 0; j < 32; ++j) { lw += tanhf_(xs[768 + j]) * PRM(PRM_WUP)[((size_t)layer * 32 + j) * 256 + c]; la += xs[800 + j] * PRM(PRM_AUP)[((size_t)layer * 32 + j) * 256 + c]; }
        const float wv = fast_exp(-0.6065306597126334f * sigmoidf_(PRM(PRM_W0)[layer * 256 + c] + lw));
        const float av = sigmoidf_(PRM(PRM_A0)[layer * 256 + c] + la);
        const float rr = xs[c], kx = xs[256 + c], vx = xs[512 + c];
        float kk = kx * PRM(PRM_KK)[layer * 256 + c];
        const float ssq = wave_sum(kk * kk);
        kk = kk / fmaxf(sqrtf(ssq), 1e-12f);
        const float kt = kx * (1.0f + (av - 1.0f) * PRM(PRM_KA)[layer * 256 + c]);
        const float rkr = wave_sum(rr * kt * PRM(PRM_RK)[layer * 256 + c]);
        kkn[c] = kk; bvec[c] = kk * av; wvv[c] = wv; ktv[c] = kt; rrv[c] = rr; vvv[c] = vx;
        if (lane == 0) rkrs[wid] = rkr;
    }
    __syncthreads();
    {
        f32x4* so = (f32x4*)(P.out + O_WKS + (lt * 256 + row) * 64 + 32 * half);
        float sa = 0.f;
#pragma unroll
        for (int i = 0; i < 8; ++i) {
#pragma unroll
            for (int e = 0; e < 4; ++e) sa += S[i][e] * kkn[hd * 64 + 32 * half + 4 * i + e]; }
        sa += __shfl_xor(sa, 1);
        const float vr = vvv[row]; float o = 0.f;
#pragma unroll
        for (int i = 0; i < 8; ++i) {
#pragma unroll
            for (int e = 0; e < 4; ++e) { const int k = hd * 64 + 32 * half + 4 * i + e;
                const float sn = S[i][e] * wvv[k] - sa * bvec[k] + vr * ktv[k]; S[i][e] = sn; o += sn * rrv[k]; }
            so[i] = S[i]; }
        o += __shfl_xor(o, 1);
        if (half == 0) ov[row] = o;
    }
    __syncthreads();
    if (tid < 256) {
        const int c = tid;
        const float o = ov[c];
        const float mean = wave_sum(o) * (1.0f / 64.0f);
        const float dlt = o - mean;
        const float var = wave_sum(dlt * dlt) * (1.0f / 64.0f);
        const float on = dlt * (1.0f / sqrtf(var + 64e-5f)) * PRM(PRM_LNG)[layer * 256 + c] + PRM(PRM_LNB)[layer * 256 + c];
        MIXS[768 + c] = f2bf((on + rkrs[wid] * vvv[c]) * siluf_(z[2624 + c]));
    }
    }
    __syncthreads();
}

constexpr int SC_TC = 32, SC_A1A = 0, SC_A1B = SC_TC * 256, SC_A2A = 2 * SC_TC * 256, SC_A2B = 3 * SC_TC * 256, SC_W = 4 * SC_TC * 256, SC_V = 5 * SC_TC * 256, SC_BUF = SC_V + SC_TC * 128;
#define DPP_ADD(z, CTRL) ((z) + __builtin_bit_cast(float, __builtin_amdgcn_update_dpp(0, __builtin_bit_cast(int, (z)), (CTRL), 0xf, 0xf, true)))
__device__ __forceinline__ void scan_unit(const Params& P, int layer, int unit, LAS unsigned char* lds, int tid, int wid, int lane) {
    unsigned char* ws = P.ws;
    const int hb = unit >> 2, rg = unit & 3;
    const int p = lane & 15, rowl = (wid & 3) * 4 + (lane >> 4), row = 16 * rg + rowl;
    const bool odd = (lane & 1) != 0, worker = wid < 4;
    const unsigned char* gA = ws + WS_PA + (size_t)hb * SEQ * 512;
    const unsigned char* gW = ws + WS_PW + (size_t)hb * SEQ * 256;
    const unsigned char* gV = ws + WS_PV + ((size_t)hb * SEQ * 64 + 16 * rg) * 4;
    const int stid = tid - 256;
    u32x4 ra[4], rw[2], rv = {0u, 0u, 0u, 0u};
#define SC_GLOAD(c) do { if (!worker) { const size_t t0_ = (size_t)(c) * SC_TC; \
        _Pragma("unroll") for (int i = 0; i < 4; ++i) ra[i] = *(const u32x4*)(gA + t0_ * 512 + (size_t)(stid + 256 * i) * 16); \
        _Pragma("unroll") for (int i = 0; i < 2; ++i) rw[i] = *(const u32x4*)(gW + t0_ * 256 + (size_t)(stid + 256 * i) * 16); \
        if (stid < 128) rv = *(const u32x4*)(gV + (t0_ + (stid >> 2)) * 256 + (stid & 3) * 16); } } while (0)
#define SC_LSTORE(buf) do { if (!worker) { LAS unsigned char* B_ = lds + (buf) * SC_BUF; \
        _Pragma("unroll") for (int i = 0; i < 4; ++i) { const int idx = stid + 256 * i; const int tk_ = idx >> 5, pr_ = idx & 31, sl_ = pr_ >> 1, hf_ = pr_ & 1; \
            const unsigned x0 = ra[i][0], x1 = ra[i][1], x2 = ra[i][2], x3 = ra[i][3]; const h2_t h0 = as_h2(x0), h1 = as_h2(x1), h2 = as_h2(x2), h3 = as_h2(x3); \
            *(LAS f32x4*)(B_ + (hf_ ? SC_A1B : SC_A1A) + tk_ * 256 + sl_ * 16) = (f32x4){(float)h0.x, (float)h3.x, (float)h0.y, (float)h3.y}; \
            *(LAS f32x2*)(B_ + SC_A2A + tk_ * 256 + sl_ * 16 + hf_ * 8) = (f32x2){(float)h1.x, (float)h1.y}; \
            *(LAS f32x2*)(B_ + SC_A2B + tk_ * 256 + sl_ * 16 + hf_ * 8) = (f32x2){(float)h2.x, (float)h2.y}; } \
        _Pragma("unroll") for (int i = 0; i < 2; ++i) *(LAS u32x4*)(B_ + SC_W + (stid + 256 * i) * 16) = rw[i]; \
        if (stid < 128) { const unsigned y0 = rv[0], y1 = rv[1], y2 = rv[2], y3 = rv[3]; const h2_t g0 = as_h2(y0), g1 = as_h2(y1), g2 = as_h2(y2), g3 = as_h2(y3); \
            *(LAS f32x4*)(B_ + SC_V + stid * 32) = (f32x4){(float)g0.x, (float)g0.y, (float)g1.x, (float)g1.y}; \
            *(LAS f32x4*)(B_ + SC_V + stid * 32 + 16) = (f32x4){(float)g2.x, (float)g2.y, (float)g3.x, (float)g3.y}; } } } while (0)
    f32x2 Sa = {0.f, 0.f}, Sb = {0.f, 0.f};
    SC_GLOAD(0); SC_LSTORE(0);
    __syncthreads();
    const __amdgpu_buffer_rsrc_t orsrc = __builtin_amdgcn_make_buffer_rsrc((void*)(ws + WS_ORAW), 0, 32 * 1024 * 1024, 0x00020000);
    const unsigned obase = (unsigned)((((size_t)(hb >> 2) * SEQ) * 256 + (hb & 3) * 64 + row) * 4);
    for (int c = 0; c < SEQ / SC_TC; ++c) {
        if (c + 1 < SEQ / SC_TC) SC_GLOAD(c + 1);
        if (worker) {
            const LAS unsigned char* B = lds + (c & 1) * SC_BUF + p * 16;
            const LAS unsigned char* pV = lds + (c & 1) * SC_BUF + SC_V + rowl * 8;
            unsigned ooff = (p == 1) ? obase + (unsigned)c * (SC_TC * 1024) : 0x7fffff00u;
            f32x4 n1a = *(const LAS f32x4*)(B + SC_A1A), n1b = *(const LAS f32x4*)(B + SC_A1B), n2a = *(const LAS f32x4*)(B + SC_A2A), n2b = *(const LAS f32x4*)(B + SC_A2B), nw = *(const LAS f32x4*)(B + SC_W);
            f32x2 nv = *(const LAS f32x2*)pV;
#pragma unroll 8
            for (int tt = 0; tt < SC_TC; ++tt) {
                const f32x4 a1a = n1a, a1b = n1b, bb = n2a, kt = n2b, w = nw; const f32x2 v2 = nv;
                { const int o_ = (tt + 1) * 256;
                  n1a = *(const LAS f32x4*)(B + SC_A1A + o_); n1b = *(const LAS f32x4*)(B + SC_A1B + o_); n2a = *(const LAS f32x4*)(B + SC_A2A + o_); n2b = *(const LAS f32x4*)(B + SC_A2B + o_);
                  nw = *(const LAS f32x4*)(B + SC_W + o_); nv = *(const LAS f32x2*)(pV + (tt + 1) * 128); }
                f32x2 pq = (f32x2){a1a[0], a1a[1]} * Sa[0] + (f32x2){a1a[2], a1a[3]} * Sa[1];
                pq = pq + (f32x2){a1b[0], a1b[1]} * Sb[0] + (f32x2){a1b[2], a1b[3]} * Sb[1];
                const float x = odd ? pq[1] : pq[0], y = odd ? pq[0] : pq[1];
                float zr = x + __builtin_bit_cast(float, __builtin_amdgcn_update_dpp(0, __builtin_bit_cast(int, y), 0xB1, 0xf, 0xf, true));
                zr = DPP_ADD(zr, 0x4E);
                zr = DPP_ADD(zr, 0x124);
                zr = DPP_ADD(zr, 0x128);
                const float nsa = -__builtin_bit_cast(float, __builtin_amdgcn_update_dpp(0, __builtin_bit_cast(int, zr), 0xA0, 0xf, 0xf, true));
                Sa = Sa * (f32x2){w[0], w[1]} + ((f32x2){bb[0], bb[1]} * nsa + (f32x2){kt[0], kt[1]} * v2[0]);
                Sb = Sb * (f32x2){w[2], w[3]} + ((f32x2){bb[2], bb[3]} * nsa + (f32x2){kt[2], kt[3]} * v2[0]);
                __builtin_amdgcn_raw_buffer_store_b32(__float_as_uint(zr + v2[1]), orsrc, ooff, 0, 0);
                ooff += 1024u;
            }
        }
        if (c + 1 < SEQ / SC_TC) SC_LSTORE((c + 1) & 1);
        __syncthreads();
    }
    if (worker) *(f32x4*)(P.out + O_WKP + (((size_t)layer * 64 + hb) * 64 + row) * 64 + 4 * p) = (f32x4){Sa[0], Sa[1], Sb[0], Sb[1]};
#undef SC_GLOAD
#undef SC_LSTORE
}

typedef _Float16 half8 __attribute__((ext_vector_type(8)));
typedef _Float16 half4 __attribute__((ext_vector_type(4)));
constexpr int MS_TROW = 144, MS_TILE = 16 * MS_TROW;
constexpr int MS_UK = 0, MS_UW = MS_TILE, MS_A5 = 2 * MS_TILE, MS_OM = MS_A5 + 4096, MS_A3 = MS_OM + 256, MS_A4 = MS_A3 + 1024, MS_VB = MS_A4 + 1024, MS_IMG = MS_VB + 4 * 512;
constexpr int MS_SCR = 2 * MS_TILE, MS_SCR0 = 8 * MS_IMG;
#define MFMA16H(a, b, c) __builtin_amdgcn_mfma_f32_16x16x32_f16((a), (b), (c), 0, 0, 0)
__device__ __forceinline__ half8 pack_h8(f32x4 lo, f32x4 hi) { half8 h; h[0] = (_Float16)lo[0]; h[1] = (_Float16)lo[1]; h[2] = (_Float16)lo[2]; h[3] = (_Float16)lo[3];
    h[4] = (_Float16)hi[0]; h[5] = (_Float16)hi[1]; h[6] = (_Float16)hi[2]; h[7] = (_Float16)hi[3]; return h; }
__device__ __forceinline__ half8 pack_h8v(f32x4 lo, half4 hi) { half8 h; h[0] = (_Float16)lo[0]; h[1] = (_Float16)lo[1]; h[2] = (_Float16)lo[2]; h[3] = (_Float16)lo[3];
    h[4] = hi[0]; h[5] = hi[1]; h[6] = hi[2]; h[7] = hi[3]; return h; }

struct MsRegs { half8 f[4][2]; float om; float krj; unsigned vraw[4][4]; };
__device__ __forceinline__ void mscan_load(const unsigned char* ws, int hb, int c, int lane, MsRegs& R) {
    const int r = lane & 15, q = lane >> 4;
    const size_t t0 = (size_t)c * 16;
    const unsigned char* gB = ws + WS_PB + ((size_t)hb * SEQ + t0 + r) * 512 + (size_t)q * 16;
#pragma unroll
    for (int m = 0; m < 4; ++m)
#pragma unroll
        for (int s2 = 0; s2 < 2; ++s2) R.f[m][s2] = *(const half8*)(gB + m * 128 + s2 * 64);
    R.om = ((const float*)(ws + WS_PO))[((size_t)hb * (SEQ / 16) + c) * 64 + lane];
    R.krj = ((const float*)(ws + WS_KRA))[((size_t)(hb >> 2) * SEQ + t0 + r) * 4 + (hb & 3)];
    const unsigned* gV = (const unsigned*)(ws + WS_PV) + ((size_t)hb * SEQ + t0 + 4 * q) * 64 + r;
#pragma unroll
    for (int rg = 0; rg < 4; ++rg)
#pragma unroll
        for (int e = 0; e < 4; ++e) R.vraw[rg][e] = gV[(size_t)e * 64 + 16 * rg];
}
__device__ __forceinline__ void mscan_build(const MsRegs& R, LAS unsigned char* img, LAS unsigned char* scr, int lane) {
    const int r = lane & 15, q = lane >> 4, k = lane;
    LAS unsigned char* tBH = scr; LAS unsigned char* tKH = scr + MS_TILE;
#pragma unroll
    for (int s2 = 0; s2 < 2; ++s2) { const int co = r * MS_TROW + (8 * q + 32 * s2) * 2;
        *(LAS half8*)(img + MS_UK + co) = R.f[0][s2]; *(LAS half8*)(img + MS_UW + co) = R.f[1][s2];
        *(LAS half8*)(tBH + co) = R.f[2][s2]; *(LAS half8*)(tKH + co) = R.f[3][s2]; }
    f32x4 be = {0.f, 0.f, 0.f, 0.f}, ga = be, bp = be, gp = be, gaT = be, beT = be;
#pragma unroll
    for (int s2 = 0; s2 < 2; ++s2) { const half8 fUK = R.f[0][s2], fUW = R.f[1][s2], fBH = R.f[2][s2], fKH = R.f[3][s2];
        be = MFMA16H(fBH, fUK, be); ga = MFMA16H(fKH, fUK, ga); bp = MFMA16H(fBH, fUW, bp); gp = MFMA16H(fKH, fUW, gp); gaT = MFMA16H(fUK, fKH, gaT); beT = MFMA16H(fUK, fBH, beT); }
#pragma unroll
    for (int reg = 0; reg < 4; ++reg) { const int i = 4 * q + reg; const bool up = i < r, lo = r < i;
        be[reg] = up ? be[reg] : 0.f; ga[reg] = up ? ga[reg] : 0.f; bp[reg] = up ? bp[reg] : 0.f; gp[reg] = up ? gp[reg] : 0.f;
        gaT[reg] = lo ? gaT[reg] : 0.f; beT[reg] = lo ? beT[reg] : 0.f; }
    ga = ga * 16.0f; gp = gp * 16.0f; gaT = gaT * 16.0f;
#define MS_H4(x) ({ half4 h_; h_[0] = (_Float16)(x)[0]; h_[1] = (_Float16)(x)[1]; h_[2] = (_Float16)(x)[2]; h_[3] = (_Float16)(x)[3]; h_; })
#define MS_MM(xt, y) __builtin_amdgcn_mfma_f32_16x16x16f16(MS_H4(xt), MS_H4(y), ((f32x4){0.f, 0.f, 0.f, 0.f}), 0, 0, 0)
    const f32x4 nN = -be, nNT = -beT;
    const f32x4 N2 = MS_MM(nNT, nN), N2T = MS_MM(nN, nNT);
    const f32x4 N4 = MS_MM(N2T, N2), N4T = MS_MM(N2, N2T);
    const f32x4 N8 = MS_MM(N4T, N4);
    const f32x4 N3 = MS_MM(nNT, N2), N3T = MS_MM(N2, nNT);
    f32x4 P1 = nN + N2 + N3, P1T = nNT + N2T + N3T;
#pragma unroll
    for (int reg = 0; reg < 4; ++reg) { const float d = (4 * q + reg == r) ? 1.0f : 0.f; P1[reg] += d; P1T[reg] += d; }
    const f32x4 P2 = P1 + MS_MM(P1T, N4), P2T = P1T + MS_MM(N4, P1T);
    const f32x4 Tm = P2 + MS_MM(P2T, N8);
    const f32x4 g2 = MS_MM(gaT, Tm);
    { half8 h3; h3[0] = (_Float16)Tm[0]; h3[1] = (_Float16)Tm[1]; h3[2] = (_Float16)Tm[2]; h3[3] = (_Float16)Tm[3]; h3[4] = (_Float16)g2[0]; h3[5] = (_Float16)g2[1]; h3[6] = (_Float16)g2[2]; h3[7] = (_Float16)g2[3];
      *(LAS half8*)(img + MS_A3 + lane * 16) = h3; }
    { half8 h4;
#pragma unroll
      for (int e = 0; e < 4; ++e) { h4[e] = (_Float16)(-bp[e]); h4[4 + e] = (_Float16)(gp[e] + ((4 * q + e == r) ? R.krj : 0.f)); }
      *(LAS half8*)(img + MS_A4 + lane * 16) = h4; }
#pragma unroll
    for (int rg = 0; rg < 4; ++rg) { half4 hv;
#pragma unroll
      for (int e = 0; e < 4; ++e) { const unsigned u = R.vraw[rg][e]; hv[e] = as_h2(u).x; }
      *(LAS half4*)(img + MS_VB + rg * 512 + lane * 8) = hv; }
    asm volatile("s_waitcnt lgkmcnt(0)" ::: "memory");
    const float om = R.om;
    {
        const _Float16 omb = (_Float16)(-om), omk = (_Float16)(om * 16.0f);
        _Float16 bvv[16], kvv[16];
#pragma unroll
        for (int i = 0; i < 16; ++i) { bvv[i] = *(const LAS _Float16*)(tBH + i * MS_TROW + k * 2); kvv[i] = *(const LAS _Float16*)(tKH + i * MS_TROW + k * 2); }
        asm volatile("" ::: "memory");
#pragma unroll
        for (int qq = 0; qq < 4; ++qq) { half8 h;
#pragma unroll
            for (int e = 0; e < 4; ++e) { h[e] = bvv[4 * qq + e] * omb; h[4 + e] = kvv[4 * qq + e] * omk; }
            *(LAS half8*)(img + MS_A5 + ((k >> 4) * 64 + qq * 16 + (k & 15)) * 16) = h; }
    }
    *(LAS float*)(img + MS_OM + (((k >> 2) & 3) * 16 + (k >> 4) * 4 + (k & 3)) * 4) = om;
    asm volatile("s_waitcnt lgkmcnt(0)" ::: "memory");
}

struct MsOps { half8 uk0, uk1, uw0, uw1, a3, a4, a5[4]; half4 vb; f32x4 om[4]; };
__device__ __forceinline__ void mscan_ops_load(const LAS unsigned char* I, int rg, int lane, MsOps& o) {
    const int r = lane & 15, q = lane >> 4;
#define MS_UFRAG(T_, s_) ({ const half4 lo_ = *(const LAS half4*)(I + (T_) + r * MS_TROW + (32 * (s_) + 4 * q) * 2), hi_ = *(const LAS half4*)(I + (T_) + r * MS_TROW + (32 * (s_) + 16 + 4 * q) * 2); \
        half8 h_; h_[0] = lo_[0]; h_[1] = lo_[1]; h_[2] = lo_[2]; h_[3] = lo_[3]; h_[4] = hi_[0]; h_[5] = hi_[1]; h_[6] = hi_[2]; h_[7] = hi_[3]; h_; })
    o.uk0 = MS_UFRAG(MS_UK, 0); o.uk1 = MS_UFRAG(MS_UK, 1); o.uw0 = MS_UFRAG(MS_UW, 0); o.uw1 = MS_UFRAG(MS_UW, 1);
    o.vb = *(const LAS half4*)(I + MS_VB + rg * 512 + lane * 8);
    o.a3 = *(const LAS half8*)(I + MS_A3 + lane * 16); o.a4 = *(const LAS half8*)(I + MS_A4 + lane * 16);
#pragma unroll
    for (int kb = 0; kb < 4; ++kb) { o.a5[kb] = *(const LAS half8*)(I + MS_A5 + (kb * 64 + lane) * 16); o.om[kb] = *(const LAS f32x4*)(I + MS_OM + (q * 16 + kb * 4) * 4); }
}
__device__ __forceinline__ void mscan_unit(const Params& P, int layer, int hb, LAS unsigned char* lds, int wid, int lane) {
    unsigned char* ws = P.ws;
    const int r = lane & 15, q = lane >> 4;
    const int rg = wid & 3;
    f32x4 Sacc[4];
#pragma unroll
    for (int kb = 0; kb < 4; ++kb) Sacc[kb] = (f32x4){0.f, 0.f, 0.f, 0.f};
    float* oraw = (float*)(ws + WS_ORAW) + ((size_t)(hb >> 2) * SEQ) * 256 + (hb & 3) * 64 + 16 * rg + r;
    const bool builder = wid >= 4;
    const int bw = wid - 4;
    constexpr int NR = SEQ / 64;
    MsRegs R;
    if (builder) { mscan_load(ws, hb, bw, lane, R); mscan_build(R, lds + bw * MS_IMG, lds + MS_SCR0 + bw * MS_SCR, lane); mscan_load(ws, hb, 4 + bw, lane, R); }
    __syncthreads();
    for (int rd = 0; rd < SEQ / 64; ++rd) {
        if (builder) { if (rd + 1 < NR) { mscan_build(R, lds + (((rd + 1) & 1) * 4 + bw) * MS_IMG, lds + MS_SCR0 + bw * MS_SCR, lane);
                                             if (rd + 2 < NR) mscan_load(ws, hb, 4 * (rd + 2) + bw, lane, R); } }
        else {
            __builtin_amdgcn_s_setprio(2);
            MsOps cur, nxt;
            mscan_ops_load(lds + ((rd & 1) * 4) * MS_IMG, rg, lane, cur);
#pragma unroll
            for (int cc = 0; cc < 4; ++cc) {
                if (cc < 3) mscan_ops_load(lds + ((rd & 1) * 4 + cc + 1) * MS_IMG, rg, lane, nxt);
                asm volatile("" ::: "memory");
                const half8 bS0 = pack_h8(Sacc[0], Sacc[1]), bS1 = pack_h8(Sacc[2], Sacc[3]);
                f32x4 DT = {0.f, 0.f, 0.f, 0.f}, ET = DT;
                DT = MFMA16H(cur.uk0, bS0, DT); DT = MFMA16H(cur.uk1, bS1, DT);
                ET = MFMA16H(cur.uw0, bS0, ET); ET = MFMA16H(cur.uw1, bS1, ET);
                f32x4 SA = {0.f, 0.f, 0.f, 0.f};
                SA = MFMA16H(cur.a3, pack_h8v(DT, cur.vb), SA);
                const half8 b3 = pack_h8v(SA, cur.vb);
                const f32x4 OT = MFMA16H(cur.a4, b3, ET);
                float* op = oraw + ((size_t)(rd * 4 + cc) * 16 + 4 * q) * 256;
#pragma unroll
                for (int reg = 0; reg < 4; ++reg) op[(size_t)reg * 256] = OT[reg];
#pragma unroll
                for (int kb = 0; kb < 4; ++kb) Sacc[kb] = MFMA16H(cur.a5[kb], b3, Sacc[kb] * cur.om[kb]);
                if (cc < 3) cur = nxt;
            }
            __builtin_amdgcn_s_setprio(0);
        }
        __syncthreads();
    }
    if (!builder) {
        float* so = P.out + O_WKP + (((size_t)layer * 64 + hb) * 64 + 16 * rg + r) * 64;
#pragma unroll
        for (int kb = 0; kb < 4; ++kb) *(f32x4*)(so + 16 * kb + 4 * q) = Sacc[kb];
    }
}

__device__ __forceinline__ void post_token4(const Params& P, int layer, int r0, int rstride, int lane, const f32x4 lg, const f32x4 lb, bool dry = false) {
    unsigned char* ws = P.ws;
    const int c0 = 4 * lane, hh = lane >> 4, l16 = lane & 15;
    f32x4 o[4]; float rkr[4]; u32x4 pv[4]; u32x2 gt[4];
#pragma unroll
    for (int j = 0; j < 4; ++j) { const int r = r0 + j * rstride, b = r >> 11, t = r & (SEQ - 1);
        o[j] = *((const f32x4*)(ws + WS_ORAW) + (size_t)r * 64 + lane);
        rkr[j] = ((const float*)(ws + WS_RKR))[(size_t)r * 4 + hh];
        pv[j] = *((const u32x4*)(ws + WS_PV) + ((size_t)(b * 4 + hh) * SEQ + t) * 16 + l16);
        gt[j] = *(const u32x2*)((bf16_t*)(ws + WS_GM) + (size_t)r * 1024 + 768 + c0); }
#pragma unroll
    for (int j = 0; j < 4; ++j) { const int r = r0 + j * rstride;
        const f32x4 oo = o[j];
        const float mean = sum16d((oo[0] + oo[1]) + (oo[2] + oo[3])) * (1.0f / 64.0f);
        const f32x4 d = oo - mean;
        const float var = sum16d((d[0] * d[0] + d[1] * d[1]) + (d[2] * d[2] + d[3] * d[3])) * (1.0f / 64.0f);
        const float rstd = __builtin_amdgcn_rsqf(var + 64e-5f);
        const u32x4 pw = pv[j]; const unsigned pv0 = pw[0], pv1 = pw[1], pv2 = pw[2], pv3 = pw[3];
        const float v[4] = {(float)as_h2(pv0).x, (float)as_h2(pv1).x, (float)as_h2(pv2).x, (float)as_h2(pv3).x};
        const u32x2 gq = gt[j]; const unsigned g0 = gq.x, g1 = gq.y;
        const float g[4] = {bf_lo(g0), bf_hi(g0), bf_lo(g1), bf_hi(g1)};
        float y[4];
#pragma unroll
        for (int i = 0; i < 4; ++i) y[i] = (d[i] * rstd * lg[i] + lb[i] + rkr[j] * v[i]) * g[i];
        *(u32x2*)((bf16_t*)(ws + WS_GM) + (size_t)r * 1024 + 768 + c0) = dry ? gq : (u32x2){pk_bf16(y[0], y[1]), pk_bf16(y[2], y[3])}; }
}

#define XB_TMO      128
#define XB_XCNT(j)  (256  + 64 * (j))
#define XB_XSUB(j)  (1280 + 64 * (j))
#define XB_XGEN(j)  (2304 + 64 * (j))
#define XB_TOP      3328
#define XB_TOPGEN   3392
#define XCD_BAR_WORDS 3456
#define XB_SPIN_CAP (1u << 18)

__device__ __forceinline__ unsigned xb_ld(unsigned* p)              { return __hip_atomic_load(p, __ATOMIC_RELAXED, __HIP_MEMORY_SCOPE_AGENT); }
__device__ __forceinline__ unsigned xb_add(unsigned* p, unsigned v) { return __hip_atomic_fetch_add(p, v, __ATOMIC_RELAXED, __HIP_MEMORY_SCOPE_AGENT); }
__device__ __forceinline__ unsigned xb_xcc_id() { return (unsigned)__builtin_amdgcn_s_getreg((3 << 11) | 20) & 0xFu; }
#define XB_SPIN(cond, bar) do { unsigned _sp = 0; while (cond) { __builtin_amdgcn_s_sleep(1); \
    if ((++_sp & 255u) == 0u) { if (xb_ld(&(bar)[XB_TMO])) break; if (_sp > XB_SPIN_CAP) { atomicAdd(&(bar)[XB_TMO], 1u); break; } } } } while (0)

struct XcdBarrier {
    unsigned* bar; unsigned x;
    volatile LAS unsigned* st;
};

__device__ __forceinline__ XcdBarrier xcd_barrier_post(unsigned* bar, volatile LAS unsigned* st) {
    XcdBarrier b; b.bar = bar; b.x = xb_xcc_id(); b.st = st;
    if (threadIdx.x == 0) (void)xb_add(&bar[XB_XCNT(b.x)], 1u);
    return b;
}
__device__ __forceinline__ void xcd_barrier_complete(unsigned* bar, unsigned x, unsigned& nloc, unsigned& nx) {
    const unsigned G = gridDim.x * gridDim.y * gridDim.z;
    unsigned sum, cnt, mine, sp = 0u;
    for (;;) {
        sum = 0u; cnt = 0u; mine = 0u;
#pragma unroll
        for (unsigned j = 0; j < 16; ++j) { const unsigned c = xb_ld(&bar[XB_XCNT(j)]); sum += c; cnt += (c > 0u) ? 1u : 0u; mine = (j == x) ? c : mine; }
        if (sum == G) break;
        __builtin_amdgcn_s_sleep(1);
        if ((++sp & 255u) == 0u) { if (xb_ld(&bar[XB_TMO])) break; if (sp > XB_SPIN_CAP) { atomicAdd(&bar[XB_TMO], 1u); break; } }
    }
    nloc = mine > 0u ? mine : 1u; nx = cnt > 0u ? cnt : 1u;
}

__device__ __forceinline__ void xcd_barrier(const XcdBarrier& b) {
    asm volatile("s_waitcnt vmcnt(0)" ::: "memory");
    __syncthreads();
    if (threadIdx.x == 0) {
        unsigned* bar = b.bar;
        __builtin_amdgcn_s_waitcnt(0);
        unsigned nloc = b.st[0], nx = b.st[1];
        if (nloc == 0u) { xcd_barrier_complete(bar, b.x, nloc, nx); b.st[0] = nloc; b.st[1] = nx; }
        const unsigned old = xb_add(&bar[XB_XSUB(b.x)], 1u);
        const unsigned gen = old / nloc;
        if (old + 1u == (gen + 1u) * nloc) {
            __builtin_amdgcn_fence(__ATOMIC_RELEASE, "agent");
            asm volatile("s_waitcnt vmcnt(0)" ::: "memory");
            const unsigned og = xb_add(&bar[XB_TOP], 1u);
            const unsigned tg = og / nx;
            if (og + 1u == (tg + 1u) * nx) xb_add(&bar[XB_TOPGEN], 1u);
            else XB_SPIN(xb_ld(&bar[XB_TOPGEN]) == tg, bar);
            __builtin_amdgcn_fence(__ATOMIC_ACQUIRE, "agent");
            xb_add(&bar[XB_XGEN(b.x)], 1u);
            asm volatile("s_waitcnt vmcnt(0)" ::: "memory");
        } else {
            XB_SPIN(xb_ld(&bar[XB_XGEN(b.x)]) == gen, bar);
            __builtin_amdgcn_fence(__ATOMIC_ACQUIRE, "agent");
            asm volatile("s_waitcnt vmcnt(0)" ::: "memory");
        }
    }
    __syncthreads();
}

constexpr int LDS_BYTES = 147456;
constexpr int NPHASE = 11;
template <bool IS_IN>
struct SkinnyPre { const Params& P; int layer, bx, G, wid, lane;
    __device__ __forceinline__ void operator()() const { for (int u = bx; u < (IS_IN ? NPAD / 16 : DM / 16); u += G) skinny_unit<IS_IN>(P, layer, u, wid, lane); } };
#ifndef CODE_PF
#define CODE_PF 0
#endif
__device__ __forceinline__ void code_prefetch(unsigned long long pc0, int tid) {
    const volatile __attribute__((address_space(1))) unsigned* p = (const volatile __attribute__((address_space(1))) unsigned*)(pc0 + (unsigned long long)tid * 64ull);
    unsigned s_ = 0;
#pragma unroll
    for (int k = 0; k < 5; ++k) if (k * 512 + tid < 2240) s_ += p[k * 8192];
    asm volatile("" :: "v"(s_));
}
__global__ void __launch_bounds__(512, 2) hymba_fwd(Params P) {
    extern __shared__ __attribute__((aligned(16))) unsigned char lds_raw[];
    LAS unsigned char* lds = (LAS unsigned char*)lds_raw;
    cg::grid_group grid = cg::this_grid();
    unsigned long long pc0; asm volatile("s_getpc_b64 %0" : "=s"(pc0));
    if (CODE_PF & 1) code_prefetch(pc0, threadIdx.x);
    {
        volatile LAS unsigned* st = (volatile LAS unsigned*)(lds + 147392);
        if (threadIdx.x == 0) { st[0] = 0u; st[1] = 0u; st[2] = 0u; st[3] = 0u; }
        __syncthreads();
    }
#if INKERNEL_BAR_ZERO
    const XcdBarrier xbar = {(unsigned*)(P.ws + WS_CTL) + 4096, xb_xcc_id(), (volatile LAS unsigned*)(lds + 147392)};
    static_assert(XCD_BAR_WORDS <= 3584, "the prologue zeroes 3584 barrier words");
#else
    const XcdBarrier xbar = xcd_barrier_post((unsigned*)(P.ws + WS_CTL) + 4096, (volatile LAS unsigned*)(lds + 147392));
#endif
    const int G = gridDim.x, bx = blockIdx.x;
#define FRESH_IDS int tid = threadIdx.x; asm volatile("" : "+v"(tid)); const int lane = tid & 63; const int wid = __builtin_amdgcn_readfirstlane(tid >> 6); (void)lane; (void)wid; if (CODE_PF & 2) code_prefetch(pc0, tid);
    unsigned char* ws = P.ws;
    const int lo = P.ph_lo, hi = P.ph_hi;
#define IN(k) (lo <= (k) && (k) < hi)
#ifdef DBG_TS
#define TSTAMP(k) do { if (bx == 0 && threadIdx.x == 0) ((unsigned long long*)(ws + WS_CTL + 4096))[(k)] = __builtin_amdgcn_s_memrealtime(); } while (0)
#else
#define TSTAMP(k) do {} while (0)
#endif
#define SYNC_AFTER(k) do { if (IN(k) && IN((k) + 1)) { if ((k) == 0 && USE_CG_SYNC) grid.sync(); else xcd_barrier(xbar); if (DBG_DOUBLE & 8) xcd_barrier(xbar); } TSTAMP((k) + 1); } while (0)
    TSTAMP(0);
#ifndef SKIP_P0
    if (IN(0)) { FRESH_IDS for (int rep = 0; rep < ((DBG_DOUBLE & 32) ? 2 : 1); ++rep) p0_prologue(P, lds, G, tid, wid, lane); }
#endif
    SYNC_AFTER(0);
#if INKERNEL_BAR_ZERO
    if (threadIdx.x == 0) (void)xb_add(&xbar.bar[XB_XCNT(xbar.x)], 1u);
#endif
    for (int layer = 0; layer < NLAYER; ++layer) {
        const int pb = 1 + 5 * layer;
        if (IN(pb)) {
            FRESH_IDS
            pg8::Gemm g{(const pg8::bf16_t*)(ws + WS_XB), (const pg8::bf16_t*)(ws + WS_WIN) + (size_t)layer * NPAD * DM, MP, NPAD, DM};
            pg8::StaticOrder S; S.init(MP, NPAD, G, bx);
            EpiIn E; E.ws = ws; E.out = P.out; E.qg = PRM(PRM_QG) + layer * 64; E.kg = PRM(PRM_KG) + layer * 64; E.layer = layer;
#ifndef SKIP_G1
            for (int rep = 0; rep < ((DBG_DOUBLE & 1) ? 2 : 1); ++rep) pg8::gemm_phase<EpiIn, pg8::StaticOrder, false, SkinnyPre<true>>((PG8_LAS unsigned char*)lds, g, S, E, nullptr, SkinnyPre<true>{P, layer, bx, G, wid, lane});
#endif
        }
        SYNC_AFTER(pb);
        if (IN(pb + 1)) {
            FRESH_IDS
#ifndef SKIP_PL
            for (int rep = ((DBG_DOUBLE & 256) ? 0 : 1); rep < 2; ++rep) for (int u = bx; u < 256; u += G) pool_unit(P, layer, u, lds, wid, lane, rep == 0);
#endif
            __syncthreads();
#ifndef SKIP_PR
            for (int rep = 0; rep < ((DBG_DOUBLE & 16) ? 2 : 1); ++rep) for (int r0 = (bx * 8 + wid) * 16; r0 < MP; r0 += G * 8 * 16) prep_run(P, layer, r0, lane, lds + wid * 16384);
#endif
        }
        SYNC_AFTER(pb + 1);
        if (IN(pb + 2)) {
            FRESH_IDS
            const int NSC = G >= 128 ? 64 : 0;
            if (bx < NSC || NSC == 0) {
#ifndef SKIP_SC
                for (int rep = 0; rep < ((DBG_DOUBLE & 2) ? 2 : 1); ++rep) for (int u = bx; u < 64; u += (NSC ? NSC : G)) { const int hb = ((u & 7) * 8 + (u >> 3)); mscan_unit(P, layer, hb, lds, wid, lane); __syncthreads(); }
#endif
            }
            if (bx >= NSC) {
                const int j = bx - NSC, NW = G - NSC;
#ifndef SKIP_DM
                for (int rep = 0; rep < ((DBG_DOUBLE & 4) ? 2 : 1); ++rep)
                    for (int i = 0; i * NW < 2 * MS; ++i) {
                        const int c = (2 * MS - i * NW) < NW ? (2 * MS - i * NW) : NW, jj = j - (NW - c);
                        if (jj >= 0) { const int u = i * NW + (i == 0 ? jj : (jj ^ 1)); decode_mix(P, layer, u >> 1, u & 1, lds, tid, wid, lane); }
                    }
#endif
                __syncthreads();
#ifndef SKIP_AT
                constexpr int ATT_LDS = 71680;
                for (int rep = ((DBG_DOUBLE & 128) ? 0 : 1); rep < 2; ++rep)
                    for (int u = j; u < 512; u += 2 * NW) {
                        attn_unit<true, false>(P, layer, u, lds, lds + 2 * ATT_LDS, tid, wid, lane);
                        if (u + NW < 512) attn_unit<true, false>(P, layer, u + NW, lds + ATT_LDS, lds + 2 * ATT_LDS, tid, wid, lane);
                        __syncthreads();
                        attn_unit<false, true>(P, layer, u, lds, lds + 2 * ATT_LDS, tid, wid, lane, rep == 0);
                        if (u + NW < 512) attn_unit<false, true>(P, layer, u + NW, lds + ATT_LDS, lds + 2 * ATT_LDS, tid, wid, lane, rep == 0);
                        __syncthreads();
                    }
#endif
            }
        }
        SYNC_AFTER(pb + 2);
        if (IN(pb + 3)) {
            FRESH_IDS
#ifndef SKIP_PO
            { const f32x4 lg = *(const f32x4*)(PRM(PRM_LNG) + layer * 256 + 4 * lane), lb = *(const f32x4*)(PRM(PRM_LNB) + layer * 256 + 4 * lane);
              for (int rep = ((DBG_DOUBLE & 512) ? 0 : 1); rep < 2; ++rep) for (int r = bx * 8 + wid; r < MP; r += 4 * G * 8) post_token4(P, layer, r, G * 8, lane, lg, lb, rep == 0); }
#endif
        }
        SYNC_AFTER(pb + 3);
        if (IN(pb + 4)) {
            FRESH_IDS
            pg8::Gemm g{(const pg8::bf16_t*)(ws + WS_GM), (const pg8::bf16_t*)(ws + WS_WOUT) + (size_t)layer * DM * DM, MP, DM, DM};
            pg8::StaticOrder S; S.init(MP, DM, G, bx);
            EpiOut E; E.resid = INP(0); E.out = P.out + O_YP; E.XB = (bf16_t*)(ws + WS_XB); E.RS = (float*)(ws + WS_RS) + MP; E.layer = layer;
#ifndef SKIP_G2
            for (int rep = 0; rep < (((DBG_DOUBLE & 64) && layer == 0) ? 2 : 1); ++rep) pg8::gemm_phase<EpiOut, pg8::StaticOrder, false, SkinnyPre<false>>((PG8_LAS unsigned char*)lds, g, S, E, nullptr, SkinnyPre<false>{P, layer, bx, G, wid, lane});
#endif
        }
        if (layer + 1 < NLAYER) SYNC_AFTER(pb + 4);
    }
#ifdef DBG_TS
    TSTAMP(NPHASE);
    if (bx == 0 && threadIdx.x == 0) { const unsigned long long* ts = (const unsigned long long*)(ws + WS_CTL + 4096);
        P.out[O_YS] = (float)(ts[DBG_TS + 1] - ts[DBG_TS]) * (DBG_TS_SCALE); }
#endif
#undef IN
#undef SYNC_AFTER
}

#ifdef DBG_MASK
__global__ void dbg_scale(float* out) {
    const size_t G = gridDim.x, bx = blockIdx.x;
#define DBG_SCALE(o, lo_, hi_) if (((DBG_MASK | DBG_MASK2) >> (o)) & 1) { const float f_ = ((DBG_MASK >> (o)) & 1) ? DBG_FACTOR : DBG_FACTOR2; for (size_t i = (lo_) + bx * 256 + threadIdx.x; i < (hi_); i += G * 256) out[i] *= f_; }
    DBG_SCALE(0, O_YP, O_YS) DBG_SCALE(1, O_YS, O_POOLP) DBG_SCALE(2, O_POOLP, O_POOLS) DBG_SCALE(3, O_POOLS, O_KP) DBG_SCALE(4, O_KP, O_KS) DBG_SCALE(5, O_KS, O_VP)
    DBG_SCALE(6, O_VP, O_VS) DBG_SCALE(7, O_VS, O_SHP) DBG_SCALE(8, O_SHP, O_SHS) DBG_SCALE(9, O_SHS, O_WKP) DBG_SCALE(10, O_WKP, O_WKS) DBG_SCALE(11, O_WKS, O_END)
}
#endif
#if SCAN_IMPL == 2
__global__ void dbg_compare(float* out, const unsigned char* ws) {
    __shared__ float red[4][256];
    const int layer = DBG_CMP_SEL >> 1, tid = threadIdx.x;
    float md = 0.f, mr = 0.f;
    if ((DBG_CMP_SEL & 1) == 0) { const float* A_ = (const float*)(ws + WS_ORAW); const float* B_ = (const float*)(ws + WS_ORAW2);
        for (size_t i = tid; i < (size_t)MP * 256; i += 256 * 997) { const float a = A_[i], b = B_[i]; md = fmaxf(md, fabsf(a - b)); mr = fmaxf(mr, fabsf(a)); }
        for (size_t i = (size_t)tid * 4099; i < (size_t)MP * 256; i += (size_t)256 * 4099) { const float a = A_[i], b = B_[i]; md = fmaxf(md, fabsf(a - b)); mr = fmaxf(mr, fabsf(a)); } }
    else { const float* SA_ = out + O_WKP + (size_t)layer * 64 * 4096; const float* SB_ = (const float*)(ws + WS_ORAW2 + 32 * MiB) + (size_t)layer * 64 * 4096;
        for (size_t i = tid; i < (size_t)64 * 4096; i += 256) { const float a = SA_[i], b = SB_[i]; md = fmaxf(md, fabsf(a - b)); mr = fmaxf(mr, fabsf(a)); } }
    red[0][tid] = md; red[1][tid] = mr; __syncthreads();
    if (tid == 0) { for (int i = 1; i < 256; ++i) { md = fmaxf(md, red[0][i]); mr = fmaxf(mr, red[1][i]); }
        out[O_YS] = 1.0e4f * md / fmaxf(mr, 1e-20f); }
}
#endif
#ifndef MK_N_LAUNCHES
#define MK_N_LAUNCHES 1
#endif
extern "C" void kernel_launch(void* const* d_in, const int* in_sizes, int n_in, void* d_out, int out_size, void* d_ws, size_t ws_size, hipStream_t stream) {
    static int grid = 0;
    if (grid == 0) {
        if (n_in != 25 || out_size != (int)O_END || ws_size < WS_END) { fprintf(stderr, "kernel_launch: unexpected shapes: n_in %d out %d ws %zu\n", n_in, out_size, ws_size); grid = -1; return; }
        int dev = 0, cus = 0, per_cu = 0;
        if (hipGetDevice(&dev) != hipSuccess || hipDeviceGetAttribute(&cus, hipDeviceAttributeMultiprocessorCount, dev) != hipSuccess) { grid = -1; return; }
        if (hipFuncSetAttribute((const void*)hymba_fwd, hipFuncAttributeMaxDynamicSharedMemorySize, LDS_BYTES) != hipSuccess) { fprintf(stderr, "kernel_launch: hipFuncSetAttribute failed\n"); grid = -1; return; }
        if (hipOccupancyMaxActiveBlocksPerMultiprocessor(&per_cu, (const void*)hymba_fwd, 512, LDS_BYTES) != hipSuccess || per_cu < 1) { fprintf(stderr, "kernel_launch: occupancy query failed (%d)\n", per_cu); grid = -1; return; }
        grid = cus * 1;
    }
    if (grid < 0) return;
#if !INKERNEL_BAR_ZERO
    if (hipMemsetAsync((char*)d_ws + WS_CTL, 0, 65536, stream) != hipSuccess) { fprintf(stderr, "kernel_launch: memset of control words failed\n"); return; }
#endif
    Params p{};
    for (int i = 0; i < 25; ++i) p.in[i] = (const float*)d_in[i];
    p.out = (float*)d_out; p.ws = (unsigned char*)d_ws;
#if MK_N_LAUNCHES == 1
    p.ph_lo = 0; p.ph_hi = NPHASE;
    void* args[] = {&p};
    hipError_t e = hipLaunchCooperativeKernel((const void*)hymba_fwd, dim3(grid), dim3(512), args, LDS_BYTES, stream);
    if (e != hipSuccess) fprintf(stderr, "kernel_launch: cooperative launch failed: %s (grid %d)\n", hipGetErrorString(e), grid);
#if SCAN_IMPL == 2
    dbg_compare<<<1, 256, 0, stream>>>((float*)d_out, (const unsigned char*)d_ws);
#endif
#ifdef DBG_MASK
    dbg_scale<<<1024, 256, 0, stream>>>((float*)d_out);
#endif
#else
    for (int ph = 0; ph < NPHASE; ++ph) {
        p.ph_lo = ph; p.ph_hi = ph + 1;
        void* args[] = {&p};
        hipError_t e = hipLaunchCooperativeKernel((const void*)hymba_fwd, dim3(grid), dim3(512), args, LDS_BYTES, stream);
        if (e != hipSuccess) { fprintf(stderr, "kernel_launch: launch %d failed: %s\n", ph, hipGetErrorString(e)); break; }
    }
#endif
}
```

```cpp
#include <hip/hip_runtime.h>
#ifndef DBG_DOUBLE
#define DBG_DOUBLE 0
#endif
#ifndef SCAN_IMPL
#define SCAN_IMPL 1
#endif
#ifndef DBG_CMP_SEL
#define DBG_CMP_SEL 0
#endif
#ifndef USE_CG_SYNC
#define INKERNEL_BAR_ZERO 1
#define USE_CG_SYNC 1
#endif
#include <hip/hip_cooperative_groups.h>
#include <cstdio>
#include <cstdint>
namespace cg = cooperative_groups;
namespace pg8 {
#define PG8_LAS __attribute__((address_space(3)))
typedef unsigned short bf16_t;
typedef short bf16x8 __attribute__((ext_vector_type(8)));
typedef float f32x4 __attribute__((ext_vector_type(4)));
typedef unsigned u32x4 __attribute__((ext_vector_type(4)));
constexpr int BM = 256, BK = 64, HALF = 128, HTB = HALF * BK * 2  , STAGE_BYTES = 8 * HTB, NXCD = 8, WGM = 8;

__host__ __device__ __forceinline__ int lds_byte(int r, int c) { const int st = (r >> 4) * 2 + (c >> 5), rr = r & 15, cc = c & 31, ob = rr * 64 + cc * 2; return st * 1024 + (ob ^ (((ob >> 9) & 1) << 5)); }
__host__ __device__ __forceinline__ void stage_rc(int b, int& R, int& C) { const int st = b / 1024, sb = b % 1024, swz = sb ^ (((sb >> 9) & 1) << 5); R = (st >> 1) * 16 + swz / 64; C = (st & 1) * 32 + (swz % 64) / 2; }
__host__ __device__ __forceinline__ int perm32(int rho) { const int n = rho >> 4, i = rho & 15; return 8 * (i >> 2) + 4 * n + (i & 3); }

struct Unit { int pm, pn; };
struct Gemm { const bf16_t* A; const bf16_t* Bt; int M, N, K; };

struct StaticOrder {
    int nM, nN, nwg, G, c;
    __host__ __device__ void init(int M, int N, int G_, int c_) { nM = M / BM; nN = N / BM; nwg = nM * nN; G = G_; c = c_; }
    __host__ __device__ bool next(int i, Unit& u) const {
        const long L = (long)i * G + c; if (L >= nwg) return false;
        int wgid = (int)L; { const int q = nwg / NXCD, r = nwg % NXCD, xcd = wgid % NXCD, off = wgid / NXCD; wgid = (xcd < r ? xcd * (q + 1) : r * (q + 1) + (xcd - r) * q) + off; }
        const int nig = WGM * nN, gid = wgid / nig, fm = gid * WGM, gsz = (nM - fm) < WGM ? (nM - fm) : WGM;
        u.pm = fm + ((wgid % nig) % gsz); u.pn = (wgid % nig) / gsz; return true;
    }
    __device__ __forceinline__ void a_ready(const Unit&) const {}
    __device__ __forceinline__ void done(const Unit&) const {}
};

struct NoPre { __device__ __forceinline__ void operator()() const {} };
template <class Epi, class Sched, bool STAMP = false, class Pre = NoPre>
__device__ __forceinline__ void gemm_phase(PG8_LAS unsigned char* lds, const Gemm g, const Sched& S, const Epi& E, unsigned long long* stamps, const Pre& pre_hook = Pre()) {
    int tid = threadIdx.x; asm volatile("" : "+v"(tid));
    const int wid = __builtin_amdgcn_readfirstlane(tid >> 6), lane = tid & 63, wr = wid >> 2, wc = wid & 3, fr = lane & 15, fq = lane >> 4;
    const int K = g.K, nt = K / BK;
    int ts_lo = 0, ts_hi = 0, nts = 0; const unsigned long long rt_entry = STAMP ? (unsigned long long)wall_clock64() : 0ull;
#define PG8_STAMP() do { if (STAMP && wid == 0 && nts < 64) { const unsigned long long _c = (unsigned long long)clock64(); \
        ts_lo = (lane == nts) ? (int)(unsigned)_c : ts_lo; ts_hi = (lane == nts) ? (int)(unsigned)(_c >> 32) : ts_hi; ++nts; } } while (0)
    PG8_STAMP();
    unsigned voffA[2], voffB[2];
#pragma unroll
    for (int i = 0; i < 2; ++i) { int R, C; stage_rc(tid * 16 + i * 8192, R, C); const int Rb = Epi::PERM ? ((R & ~31) + perm32(R & 31)) : R;
        voffA[i] = (unsigned)(R * K + C) * 2u; voffB[i] = (unsigned)(Rb * K + C) * 2u; }
    const size_t kstep = (size_t)(BK * 2);
    const size_t hstep = (size_t)HALF * K * 2;
    const size_t tstep = 2 * hstep;
    const unsigned ldsw = (unsigned)wid * 1024u;
    const int aoff = lds_byte(wr * 64 + fr, fq * 8), boff = lds_byte(wc * 32 + fr, fq * 8);
#define PG8_SA(b, h) (((b) * 2 + (h)) * HTB)
#define PG8_SB(b, h) ((4 + (b) * 2 + (h)) * HTB)
#define PG8_STAGE(bufoff, gbase, voff) do { _Pragma("unroll") for (int _i = 0; _i < 2; ++_i) \
        __builtin_amdgcn_global_load_lds((const unsigned*)((const char*)(gbase) + (voff)[_i]), (PG8_LAS unsigned*)(lds + (bufoff) + ldsw + _i * 8192), 16, 0, 0); } while (0)
#define PG8_LDA(dst, b, h) do { _Pragma("unroll") for (int m = 0; m < 4; ++m) _Pragma("unroll") for (int k = 0; k < 2; ++k) dst[m][k] = *(const PG8_LAS bf16x8*)(lds + PG8_SA(b, h) + aoff + m * 2048 + k * 1024); } while (0)
#define PG8_LDB(dst, b, h) do { _Pragma("unroll") for (int n = 0; n < 2; ++n) _Pragma("unroll") for (int k = 0; k < 2; ++k) dst[n][k] = *(const PG8_LAS bf16x8*)(lds + PG8_SB(b, h) + boff + n * 2048 + k * 1024); } while (0)
#define PG8_MMA(ai, bj, At, Bt) do { __builtin_amdgcn_s_setprio(1); _Pragma("unroll") for (int m = 0; m < 4; ++m) _Pragma("unroll") for (int n = 0; n < 2; ++n) _Pragma("unroll") for (int k = 0; k < 2; ++k) \
        acc[ai][bj][m][n] = __builtin_amdgcn_mfma_f32_16x16x32_bf16(Bt[n][k], At[m][k], acc[ai][bj][m][n], 0, 0, 0); __builtin_amdgcn_s_setprio(0); } while (0)
#define PG8_WAIT_V(n) asm volatile("s_waitcnt vmcnt(" #n ")" ::: "memory")
#define PG8_WAIT_L(n) asm volatile("s_waitcnt lgkmcnt(" #n ")" ::: "memory")
#define PG8_BAR __builtin_amdgcn_s_barrier()
#define PG8_SCHED __builtin_amdgcn_sched_barrier(0)
    Unit cur, nxt; int ui = 0;
    if (!S.next(0, cur)) return;
    float pre[8] = {0.f, 0.f, 0.f, 0.f, 0.f, 0.f, 0.f, 0.f};
    f32x4 acc[2][2][4][2];
#pragma unroll
    for (int a = 0; a < 2; ++a)
#pragma unroll
        for (int b = 0; b < 2; ++b)
#pragma unroll
            for (int m = 0; m < 4; ++m)
#pragma unroll
                for (int n = 0; n < 2; ++n) acc[a][b][m][n] = (f32x4){0.f, 0.f, 0.f, 0.f};
    bf16x8 At[4][2], B0[2][2], B1[2][2];
    const char* cA = (const char*)g.A + (size_t)cur.pm * tstep; const char* cB = (const char*)g.Bt + (size_t)cur.pn * tstep;
    S.a_ready(cur);
    PG8_STAGE(PG8_SB(0, 0), cB, voffB); PG8_STAGE(PG8_SA(0, 0), cA, voffA); PG8_STAGE(PG8_SB(0, 1), cB + hstep, voffB); PG8_STAGE(PG8_SA(0, 1), cA + hstep, voffA);
    pre_hook();
    if (wr == 1) PG8_BAR;
    PG8_WAIT_V(4); PG8_BAR;
    PG8_STAGE(PG8_SB(1, 0), cB + kstep, voffB); PG8_STAGE(PG8_SA(1, 0), cA + kstep, voffA); PG8_STAGE(PG8_SB(1, 1), cB + hstep + kstep, voffB);
    PG8_WAIT_V(6); PG8_BAR;
    PG8_STAMP();
    for (;;) {
        const bool has_next = S.next(ui + 1, nxt);
        const char* nA = has_next ? (const char*)g.A + (size_t)nxt.pm * tstep : cA; const char* nB = has_next ? (const char*)g.Bt + (size_t)nxt.pn * tstep : cB;
        for (int t = 0; t < nt; t += 2) {
            const bool last = (t == nt - 2);
            const char* a1 = cA + (size_t)(t + 1) * kstep;
            const char* a2 = last ? nA : cA + (size_t)(t + 2) * kstep; const char* b2 = last ? nB : cB + (size_t)(t + 2) * kstep;
            const char* a3 = a2 + kstep; const char* b3 = b2 + kstep;
            if (last && has_next) S.a_ready(nxt);
            if (t == nt - 4) E.preload(cur, wr, fr, pre);
            PG8_LDB(B0, 0, 0); PG8_SCHED; PG8_LDA(At, 0, 0); PG8_STAGE(PG8_SA(1, 1), a1 + hstep, voffA);
            PG8_WAIT_L(8); PG8_BAR; PG8_WAIT_L(0); PG8_MMA(0, 0, At, B0); PG8_BAR; PG8_SCHED;
            PG8_LDB(B1, 0, 1); PG8_STAGE(PG8_SB(0, 0), b2, voffB);
            PG8_BAR; PG8_WAIT_L(0); PG8_MMA(0, 1, At, B1); PG8_BAR;
            PG8_LDA(At, 0, 1); PG8_STAGE(PG8_SA(0, 0), a2, voffA);
            PG8_BAR; PG8_WAIT_L(0); PG8_MMA(1, 0, At, B0); PG8_BAR; PG8_SCHED;
            PG8_STAGE(PG8_SB(0, 1), b2 + hstep, voffB);
            PG8_WAIT_V(6); PG8_BAR; PG8_MMA(1, 1, At, B1); PG8_BAR;
            PG8_LDB(B0, 1, 0); PG8_SCHED; PG8_LDA(At, 1, 0); PG8_STAGE(PG8_SA(0, 1), a2 + hstep, voffA);
            PG8_WAIT_L(8); PG8_BAR; PG8_WAIT_L(0); PG8_MMA(0, 0, At, B0); PG8_BAR; PG8_SCHED;
            PG8_LDB(B1, 1, 1); PG8_STAGE(PG8_SB(1, 0), b3, voffB);
            PG8_BAR; PG8_WAIT_L(0); PG8_MMA(0, 1, At, B1); PG8_BAR;
            PG8_LDA(At, 1, 1); PG8_STAGE(PG8_SA(1, 0), a3, voffA);
            PG8_BAR; PG8_WAIT_L(0); PG8_MMA(1, 0, At, B0); PG8_BAR; PG8_SCHED;
            PG8_STAGE(PG8_SB(1, 1), b3 + hstep, voffB);
            PG8_WAIT_V(6); PG8_BAR; PG8_MMA(1, 1, At, B1); PG8_BAR;
        }
        PG8_STAMP();
        if constexpr (!Epi::AFTER_DRAIN) { if ((DBG_DOUBLE & 2048) && Epi::IDEMPOTENT) E(acc, cur, wr, wc, fr, fq, pre); E(acc, cur, wr, wc, fr, fq, pre); S.done(cur); }
        PG8_STAMP();
        if (!has_next) break;
#pragma unroll
        for (int a = 0; a < 2; ++a)
#pragma unroll
            for (int b = 0; b < 2; ++b)
#pragma unroll
                for (int m = 0; m < 4; ++m)
#pragma unroll
                    for (int n = 0; n < 2; ++n) acc[a][b][m][n] = (f32x4){0.f, 0.f, 0.f, 0.f};
        cur = nxt; cA = nA; cB = nB; ++ui;
    }
    PG8_WAIT_V(0);
    if (wr == 0) PG8_BAR;
    PG8_BAR;
    if constexpr (Epi::AFTER_DRAIN) { E.fused(acc, cur, wr, wc, fr, fq, lds, wid, lane); S.done(cur); }
    PG8_STAMP();
    if (STAMP && wid == 0) { stamps[lane] = lane < nts ? (((unsigned long long)(unsigned)ts_hi << 32) | (unsigned)ts_lo) : 0ull;
        if (lane == 62) stamps[62] = rt_entry; if (lane == 63) stamps[63] = (unsigned long long)wall_clock64(); }
#undef PG8_STAMP
#undef PG8_SA
#undef PG8_SB
#undef PG8_STAGE
#undef PG8_LDA
#undef PG8_LDB
#undef PG8_MMA
#undef PG8_WAIT_V
#undef PG8_WAIT_L
#undef PG8_BAR
#undef PG8_SCHED
}
}

#define LAS __attribute__((address_space(3)))
typedef unsigned short bf16_t;
typedef short bf16x8 __attribute__((ext_vector_type(8)));
typedef float f32x2 __attribute__((ext_vector_type(2)));
typedef float f32x4 __attribute__((ext_vector_type(4)));
typedef float f32x16 __attribute__((ext_vector_type(16)));
typedef unsigned u32x2 __attribute__((ext_vector_type(2)));
typedef unsigned u32x4 __attribute__((ext_vector_type(4)));
typedef __bf16 bf2_t __attribute__((ext_vector_type(2)));
typedef _Float16 h2_t __attribute__((ext_vector_type(2)));

constexpr int DM = 1024, NB = 16, SEQ = 2048, MP = NB * SEQ, MS = 128, DIN = 2880, NPAD = 3072;
constexpr int DSH = 832, NLAYER = 2;
constexpr float LOG2E = 1.4426950408889634f;
constexpr float QSCALE = 0.125f * LOG2E;
constexpr size_t O_YP = 0, O_YS = 33554432, O_POOLP = 33685504, O_POOLS = 33808384, O_KP = 34791424, O_KS = 35315712,
                 O_VP = 39510016, O_VS = 40034304, O_SHP = 44228608, O_SHS = 44255232, O_WKP = 44468224, O_WKS = 44992512, O_END = 49186816;
constexpr size_t MiB = 1u << 20;
constexpr size_t WS_CTL = 0;
constexpr size_t WS_WIN = 1 * MiB;
constexpr size_t WS_WOUT = 13 * MiB;
constexpr size_t WS_ROPE = 17 * MiB;
constexpr size_t WS_XBS = 18 * MiB;
constexpr size_t WS_RSS = 18 * MiB + 512 * 1024;
constexpr size_t WS_MIXS = 19 * MiB;
constexpr size_t WS_ZS = 20 * MiB;
constexpr size_t WS_RS = 22 * MiB;
constexpr size_t WS_RKR = 24 * MiB;
constexpr size_t WS_KRA = 24 * MiB + 512 * 1024;
constexpr size_t WS_PRM = 25 * MiB;
constexpr int PRM_POOLW = 0, PRM_POOLSC = 32768, PRM_QG = 33280, PRM_KG = 33408, PRM_SINK = 33536, PRM_MU = 33552, PRM_W0 = 35216, PRM_WUP = 35728,
              PRM_A0 = 52112, PRM_AUP = 52624, PRM_KK = 69008, PRM_KA = 69520, PRM_RK = 70032, PRM_LNG = 70544, PRM_LNB = 71056, PRM_END = 71568;
constexpr size_t WS_POOLF = WS_PRM + 640 * 1024;
constexpr size_t WS_WUPF = WS_PRM + 512 * 1024;
#define PRM(off) ((const float*)(ws + WS_PRM) + (off))
__device__ __forceinline__ const float* inp_ptr(const unsigned char* ws, int k) {
    const unsigned long long v = ((const unsigned long long*)(ws + (size_t)32768))[k];
    const unsigned lo = __builtin_amdgcn_readfirstlane((unsigned)v), hi = __builtin_amdgcn_readfirstlane((unsigned)(v >> 32));
    return (const float*)(((unsigned long long)hi << 32) | lo);
}
#define INP(k) inp_ptr(ws, (k))
constexpr size_t WS_XB = 32 * MiB;
constexpr size_t WS_U = 96 * MiB;
constexpr size_t WS_Q = 112 * MiB;
constexpr size_t WS_K = 144 * MiB;
constexpr size_t WS_VT = 152 * MiB;
constexpr size_t WS_RIN = 160 * MiB;
constexpr size_t WS_GM = 216 * MiB;
constexpr size_t WS_PA = 280 * MiB;
constexpr size_t WS_PW = 344 * MiB;
constexpr size_t WS_PV = 376 * MiB;
constexpr size_t WS_ORAW = 408 * MiB;
constexpr size_t WS_PO = 28 * MiB;
#if SCAN_IMPL == 2
constexpr size_t WS_PB = 32 * MiB;
#else
constexpr size_t WS_PB = 280 * MiB;
#endif
constexpr size_t WS_ORAW2 = 440 * MiB;
constexpr size_t WS_END = 476 * MiB;

struct Params {
    const float* in[25];
    float* out;
    unsigned char* ws;
    int ph_lo, ph_hi;
};

__device__ __forceinline__ unsigned pk_bf16(float lo, float hi) { f32x2 v = {lo, hi}; bf2_t b = __builtin_convertvector(v, bf2_t); return __builtin_bit_cast(unsigned, b); }
__device__ __forceinline__ h2_t as_h2(unsigned u) { return __builtin_bit_cast(h2_t, u); }
__device__ __forceinline__ unsigned pk_f16(float lo, float hi) { h2_t h = {(_Float16)lo, (_Float16)hi}; return __builtin_bit_cast(unsigned, h); }
__device__ __forceinline__ float bf_lo(unsigned u) { return __uint_as_float(u << 16); }
__device__ __forceinline__ float bf_hi(unsigned u) { return __uint_as_float(u & 0xffff0000u); }
__device__ __forceinline__ float bf1(bf16_t b) { return __uint_as_float(((unsigned)b) << 16); }
__device__ __forceinline__ bf16_t f2bf(float f) { return (bf16_t)(pk_bf16(f, 0.f) & 0xffffu); }
__device__ __forceinline__ float fast_exp(float x) { return __builtin_amdgcn_exp2f(x * LOG2E); }
__device__ __forceinline__ float sigmoidf_(float x) { return __builtin_amdgcn_rcpf(1.0f + fast_exp(-x)); }
__device__ __forceinline__ float siluf_(float x) { return x * sigmoidf_(x); }
#define DPPF(z, CTRL) __builtin_bit_cast(float, __builtin_amdgcn_update_dpp(0, __builtin_bit_cast(int, (z)), (CTRL), 0xf, 0xf, true))
__device__ __forceinline__ float wave_sum(float v) {
    v += DPPF(v, 0xB1); v += DPPF(v, 0x4E); v += DPPF(v, 0x124); v += DPPF(v, 0x128);
    { const auto sw = __builtin_amdgcn_permlane16_swap(__float_as_uint(v), __float_as_uint(v), false, false); v = __uint_as_float(sw[0]) + __uint_as_float(sw[1]); }
    { const auto sw = __builtin_amdgcn_permlane32_swap(__float_as_uint(v), __float_as_uint(v), false, false); v = __uint_as_float(sw[0]) + __uint_as_float(sw[1]); }
    return v;
}
__device__ __forceinline__ float wave_max(float v) {
    v = fmaxf(v, DPPF(v, 0xB1)); v = fmaxf(v, DPPF(v, 0x4E)); v = fmaxf(v, DPPF(v, 0x124)); v = fmaxf(v, DPPF(v, 0x128));
    { const auto sw = __builtin_amdgcn_permlane16_swap(__float_as_uint(v), __float_as_uint(v), false, false); v = fmaxf(__uint_as_float(sw[0]), __uint_as_float(sw[1])); }
    { const auto sw = __builtin_amdgcn_permlane32_swap(__float_as_uint(v), __float_as_uint(v), false, false); v = fmaxf(__uint_as_float(sw[0]), __uint_as_float(sw[1])); }
    return v;
}
__device__ __forceinline__ float sum_x16_x32(float v) {
    { const auto sw = __builtin_amdgcn_permlane16_swap(__float_as_uint(v), __float_as_uint(v), false, false); v = __uint_as_float(sw[0]) + __uint_as_float(sw[1]); }
    { const auto sw = __builtin_amdgcn_permlane32_swap(__float_as_uint(v), __float_as_uint(v), false, false); v = __uint_as_float(sw[0]) + __uint_as_float(sw[1]); }
    return v;
}
__device__ __forceinline__ float sum16(float v) {
    v += __shfl_xor(v, 1); v += __shfl_xor(v, 2); v += __shfl_xor(v, 4); v += __shfl_xor(v, 8); return v;
}
#define DPPX(z, CTRL) __builtin_bit_cast(float, __builtin_amdgcn_update_dpp(0, __builtin_bit_cast(int, (z)), (CTRL), 0xf, 0xf, true))
__device__ __forceinline__ float sum16d(float v) {
    v += DPPX(v, 0xB1); v += DPPX(v, 0x4E); v += DPPX(v, 0x124); v += DPPX(v, 0x128); return v;
}
__device__ __forceinline__ void store8_bf16(bf16_t* p, f32x4 a, f32x4 b) {
    u32x4 w; w.x = pk_bf16(a[0], a[1]); w.y = pk_bf16(a[2], a[3]); w.z = pk_bf16(b[0], b[1]); w.w = pk_bf16(b[2], b[3]);
    *(u32x4*)p = w;
}

__host__ __device__ __forceinline__ int src_col_in(int n) {
    const int pn = n >> 8, p = n & 255, bj = p >> 7, wc = (p >> 5) & 3, j = p & 31, nn = j >> 4, fq = (j >> 2) & 3, e = j & 3;
    const int i8 = 8 * fq + 4 * nn + e;
    const int gen = 128 * bj + 32 * wc + i8;
    const int hd = 64 * wc + 32 * bj + i8;
    switch (pn) {
        case 0: return gen;
        case 1: return 256 + gen;
        case 2: return 512 + hd;
        case 3: return 768 + hd;
        case 4: return 1024 + hd;
        case 5: return 1280 + gen;
        case 6: return 1536 + gen;
        case 7: return 1792 + gen;
        case 8: return 2048 + gen;
        case 9: return 2304 + gen;
        case 10: return 2624 + gen;
        default: return gen < 64 ? 2560 + gen : -1;
    }
}
__host__ __device__ __forceinline__ int src_col_out(int n) {
    const int pn = n >> 8, p = n & 255, bj = p >> 7, wc = (p >> 5) & 3, j = p & 31, nn = j >> 4, fq = (j >> 2) & 3, e = j & 3;
    return pn * 256 + 128 * bj + 32 * wc + 8 * fq + 4 * nn + e;
}

struct EpiIn {
    static constexpr bool PERM = false, AFTER_DRAIN = false, IDEMPOTENT = true;
    unsigned char* ws; float* out; const float* qg; const float* kg; int layer;
    __device__ __forceinline__ void preload(const pg8::Unit& u, int wr, int fr, float (&pre)[8]) const {
        const float* RS = (const float*)(ws + WS_RS) + (size_t)layer * MP + u.pm * 256 + wr * 64 + fr;
#pragma unroll
        for (int g = 0; g < 8; ++g) pre[g] = RS[(g >> 2) * 128 + (g & 3) * 16];
    }
    template <int KIND>
    __device__ __forceinline__ void body(const f32x4 (&acc)[2][2][4][2], const pg8::Unit& u, int wr, int wc, int fr, int fq, const float (&pre)[8]) const {
        const int pn = u.pn;
        const int row0 = u.pm * 256 + wr * 64 + fr;
        const int i8 = 8 * fq;
        float rsv[2][4];
#pragma unroll
        for (int ai = 0; ai < 2; ++ai)
#pragma unroll
            for (int m = 0; m < 4; ++m) rsv[ai][m] = pre[ai * 4 + m];
        if constexpr (KIND == 5) {
            const float* g = (pn == 4) ? kg : qg;
            const f32x4 gl0 = *(const f32x4*)(g + i8), gl1 = *(const f32x4*)(g + i8 + 4), gh0 = *(const f32x4*)(g + 32 + i8), gh1 = *(const f32x4*)(g + 36 + i8);
            const float osc = (pn == 4) ? 1.0f : QSCALE;
            const int t0 = row0 & (SEQ - 1), b = row0 >> 11;
            const f32x4* cs0 = (const f32x4*)((const f32x2*)(ws + WS_ROPE) + (size_t)t0 * 32 + i8);
            f32x4 nc[4];
#pragma unroll
            for (int i = 0; i < 4; ++i) nc[i] = cs0[i];
#pragma unroll
            for (int gi = 0; gi < 8; ++gi) {
                const int ai = gi >> 2, m = gi & 3;
                const int r = row0 + ai * 128 + m * 16, t = t0 + ai * 128 + m * 16;
                const float ri = __builtin_amdgcn_rsqf(rsv[ai][m] * (1.0f / 1024.0f) + 1e-6f);
                f32x4 cc[4];
#pragma unroll
                for (int i = 0; i < 4; ++i) cc[i] = nc[i];
                if (gi < 7) { const f32x4* cn = cs0 + (size_t)((((gi + 1) >> 2) * 128 + ((gi + 1) & 3) * 16) * 16);
#pragma unroll
                    for (int i = 0; i < 4; ++i) nc[i] = cn[i]; }
                float ss = 0.f;
#pragma unroll
                for (int bj = 0; bj < 2; ++bj)
#pragma unroll
                    for (int nn = 0; nn < 2; ++nn) { const f32x4 v = acc[ai][bj][m][nn]; ss += (v[0] * v[0] + v[1] * v[1]) + (v[2] * v[2] + v[3] * v[3]); }
                ss = sum_x16_x32(ss);
                ss *= ri * ri;
                const float sc = ri * __builtin_amdgcn_rsqf(ss * (1.0f / 64.0f) + 1e-6f);
                bf16_t* pq = (pn == 4) ? (bf16_t*)(ws + WS_K) + (size_t)r * 128 + wc * 64 + i8 : (bf16_t*)(ws + WS_Q) + (size_t)r * 512 + ((pn - 2) * 4 + wc) * 64 + i8;
                float* o = out + (long)O_KP + ((((long)layer * NB + b) * 128 + (t - (SEQ - 128))) * 2 + wc) * 64 + i8;
                f32x4 lo[2], hi[2];
#pragma unroll
                for (int nn = 0; nn < 2; ++nn) {
                    const f32x4 a = acc[ai][0][m][nn] * sc * (nn ? gl1 : gl0), bq = acc[ai][1][m][nn] * sc * (nn ? gh1 : gh0); const f32x4 c0 = cc[2 * nn], c1 = cc[2 * nn + 1];
                    lo[nn][0] = a[0] * c0[0] - bq[0] * c0[1]; hi[nn][0] = a[0] * c0[1] + bq[0] * c0[0];
                    lo[nn][1] = a[1] * c0[2] - bq[1] * c0[3]; hi[nn][1] = a[1] * c0[3] + bq[1] * c0[2];
                    lo[nn][2] = a[2] * c1[0] - bq[2] * c1[1]; hi[nn][2] = a[2] * c1[1] + bq[2] * c1[0];
                    lo[nn][3] = a[3] * c1[2] - bq[3] * c1[3]; hi[nn][3] = a[3] * c1[3] + bq[3] * c1[2];
                }
                if (pn == 4 && t >= SEQ - 128) { *(f32x4*)o = lo[0]; *(f32x4*)(o + 4) = lo[1]; *(f32x4*)(o + 32) = hi[0]; *(f32x4*)(o + 36) = hi[1]; }
                store8_bf16(pq, lo[0] * osc, lo[1] * osc); store8_bf16(pq + 32, hi[0] * osc, hi[1] * osc);
                asm volatile("" ::: "memory");
            }
            return;
        }
#pragma unroll
        for (int ai = 0; ai < 2; ++ai)
#pragma unroll
            for (int m = 0; m < 4; ++m) {
                const int r = row0 + ai * 128 + m * 16;
                const int t = r & (SEQ - 1), b = r >> 11;
                const float ri = __builtin_amdgcn_rsqf(rsv[ai][m] * (1.0f / 1024.0f) + 1e-6f);
                if (KIND == 0) {
                    bf16_t* p = (bf16_t*)(ws + WS_U) + (size_t)r * 256 + 32 * wc + i8;
                    float* o = out + (long)O_POOLP + (((long)layer * NB + b) * 15 + (t - (SEQ - 15))) * 256 + 32 * wc + i8;
#pragma unroll
                    for (int bj = 0; bj < 2; ++bj) { const f32x4 v0 = acc[ai][bj][m][0] * ri, v1 = acc[ai][bj][m][1] * ri;
                        store8_bf16(p + 128 * bj, v0, v1);
                        if (t >= SEQ - 15) { *(f32x4*)(o + 128 * bj) = v0; *(f32x4*)(o + 128 * bj + 4) = v1; } }
                } else if (KIND == 1) {
                    const int cbase = (pn == 1) ? 0 : (pn == 5) ? 256 : (pn == 6) ? 512 : 768;
                    bf16_t* p = (bf16_t*)(ws + WS_GM) + (size_t)r * 1024 + cbase + 32 * wc + i8;
#pragma unroll
                    for (int bj = 0; bj < 2; ++bj) { f32x4 v0 = acc[ai][bj][m][0] * ri, v1 = acc[ai][bj][m][1] * ri;
#pragma unroll
                        for (int e = 0; e < 4; ++e) { v0[e] = siluf_(v0[e]); v1[e] = siluf_(v1[e]); }
                        store8_bf16(p + 128 * bj, v0, v1); }
                } else if (KIND == 2) {
                    const int cbase = (pn - 7) * 256 + 32 * wc + i8;
                    bf16_t* p = (bf16_t*)(ws + WS_RIN) + (size_t)r * DSH + cbase;
                    float* o = out + O_SHP + ((size_t)layer * NB + b) * DSH + cbase;
#pragma unroll
                    for (int bj = 0; bj < 2; ++bj) { const f32x4 v0 = acc[ai][bj][m][0] * ri, v1 = acc[ai][bj][m][1] * ri;
                        store8_bf16(p + 128 * bj, v0, v1);
                        if (t == SEQ - 1) { *(f32x4*)(o + 128 * bj) = v0; *(f32x4*)(o + 128 * bj + 4) = v1; } }
                } else if (KIND == 3) {
                    const int cbase = 768 + 32 * wc + i8;
                    const f32x4 v0 = acc[ai][0][m][0] * ri, v1 = acc[ai][0][m][1] * ri;
                    store8_bf16((bf16_t*)(ws + WS_RIN) + (size_t)r * DSH + cbase, v0, v1);
                    if (t == SEQ - 1) { float* o = out + O_SHP + ((size_t)layer * NB + b) * DSH + cbase; *(f32x4*)o = v0; *(f32x4*)(o + 4) = v1; }
                } else if (KIND == 4) {
                    const int h = wc - 2;
                    bf16_t* vt = (bf16_t*)(ws + WS_VT) + ((size_t)(b * 2 + h) * 64) * SEQ + t;
                    float* o = out + (long)O_VP + ((((long)layer * NB + b) * 128 + (t - (SEQ - 128))) * 2 + h) * 64 + i8;
#pragma unroll
                    for (int bj = 0; bj < 2; ++bj) { const f32x4 v0 = acc[ai][bj][m][0] * ri, v1 = acc[ai][bj][m][1] * ri;
#pragma unroll
                        for (int e = 0; e < 4; ++e) { vt[(size_t)(32 * bj + i8 + e) * SEQ] = f2bf(v0[e]); vt[(size_t)(32 * bj + i8 + 4 + e) * SEQ] = f2bf(v1[e]); }
                        if (t >= SEQ - 128) { *(f32x4*)(o + 32 * bj) = v0; *(f32x4*)(o + 32 * bj + 4) = v1; } }
                }
                asm volatile("" ::: "memory");
            }
    }
    __device__ __forceinline__ void operator()(const f32x4 (&acc)[2][2][4][2], const pg8::Unit& u, int wr, int wc, int fr, int fq, const float (&pre)[8]) const {
        asm volatile("" : "+v"(fr), "+v"(fq));
        const int pn = u.pn;
        if (pn == 0) body<0>(acc, u, wr, wc, fr, fq, pre);
        else if (pn == 1 || pn == 5 || pn == 6 || pn == 10) body<1>(acc, u, wr, wc, fr, fq, pre);
        else if (pn >= 7 && pn <= 9) body<2>(acc, u, wr, wc, fr, fq, pre);
        else if (pn == 11) { if (wc < 2) body<3>(acc, u, wr, wc, fr, fq, pre); }
        else if (pn == 4 && wc >= 2) body<4>(acc, u, wr, wc, fr, fq, pre);
        else body<5>(acc, u, wr, wc, fr, fq, pre);
    }
};

struct EpiOut {
    static constexpr bool PERM = false, AFTER_DRAIN = false, IDEMPOTENT = false;
    const float* resid; float* out; bf16_t* XB; float* RS; int layer;
    __device__ __forceinline__ void preload(const pg8::Unit&, int, int, float (&)[8]) const {}
    __device__ __forceinline__ void operator()(const f32x4 (&acc)[2][2][4][2], const pg8::Unit& u, int wr, int wc, int fr, int fq, const float (&)[8]) const {
        asm volatile("" : "+v"(fr), "+v"(fq));
        const int row0 = u.pm * 256 + wr * 64 + fr;
        const int cb = u.pn * 256 + 32 * wc + 8 * fq;
        const size_t off0 = (size_t)row0 * DM + cb;
#define EPO_OFF(g) ((size_t)(row0 + ((g) >> 2) * 128 + ((g) & 3) * 16) * DM + cb)
        u32x4 nb[8][2];
#pragma unroll
        for (int g = 0; g < 8; ++g)
#pragma unroll
            for (int bj = 0; bj < 2; ++bj) nb[g][bj] = *(const u32x4*)(XB + EPO_OFF(g) + bj * 128);
#pragma unroll
        for (int g = 0; g < 8; ++g) {
            const int ai = g >> 2, m = g & 3;
            const int r = row0 + ai * 128 + m * 16;
            const size_t off = EPO_OFF(g);
            float ss = 0.f;
#pragma unroll
            for (int bj = 0; bj < 2; ++bj) {
                const unsigned b0 = nb[g][bj][0], b1 = nb[g][bj][1], b2 = nb[g][bj][2], b3 = nb[g][bj][3];
                const f32x4 r0 = {bf_lo(b0), bf_hi(b0), bf_lo(b1), bf_hi(b1)}, r1 = {bf_lo(b2), bf_hi(b2), bf_lo(b3), bf_hi(b3)};
                const f32x4 y0 = acc[ai][bj][m][0] + r0, y1 = acc[ai][bj][m][1] + r1;
                if (layer == 0) { store8_bf16(XB + off + bj * 128, y0, y1);
#pragma unroll
                    for (int e = 0; e < 4; ++e) ss += y0[e] * y0[e] + y1[e] * y1[e]; }
                else { *(f32x4*)(out + off + bj * 128) = y0; *(f32x4*)(out + off + bj * 128 + 4) = y1; } }
            if (layer == 0) { ss = sum_x16_x32(ss);
                if (fq == 0) __hip_atomic_fetch_add(RS + r, ss, __ATOMIC_RELAXED, __HIP_MEMORY_SCOPE_AGENT); }
            asm volatile("" ::: "memory");
        }
#undef EPO_OFF
    }
};

__device__ __forceinline__ void p0_transpose_item(const float* W, int ldw, const float* g, bf16_t* WT, LAS float* scr, int item, int nblk, bool is_in, int lane) {
    const int kb = item / nblk, nb = item % nblk, k0 = 64 * kb, n0 = 32 * nb;
    const int sc = is_in ? src_col_in(n0 + (lane & 31)) : src_col_out(n0 + (lane & 31));
    float wv_[32], gv_[32];
#pragma unroll
    for (int i = 0; i < 32; ++i) { const int kk = 2 * i + (lane >> 5); wv_[i] = 0.f; gv_[i] = 1.f;
        if (sc >= 0) { wv_[i] = W[(size_t)(k0 + kk) * ldw + sc]; if (g) gv_[i] = g[k0 + kk]; } }
#pragma unroll
    for (int i = 0; i < 32; ++i) { const int kk = 2 * i + (lane >> 5); scr[kk * 33 + (lane & 31)] = wv_[i] * gv_[i]; }
    asm volatile("s_waitcnt lgkmcnt(0)" ::: "memory");
    const int c = lane & 7;
#pragma unroll
    for (int j = 0; j < 4; ++j) { const int n = (lane >> 3) + 8 * j; const LAS float* s = scr + (8 * c) * 33 + n;
        u32x4 o; o.x = pk_bf16(s[0 * 33], s[1 * 33]); o.y = pk_bf16(s[2 * 33], s[3 * 33]); o.z = pk_bf16(s[4 * 33], s[5 * 33]); o.w = pk_bf16(s[6 * 33], s[7 * 33]);
        *(u32x4*)(WT + (size_t)(n0 + n) * DM + k0 + 8 * c) = o; }
    asm volatile("s_waitcnt lgkmcnt(0)" ::: "memory");
}
__device__ __forceinline__ float row_to_bf16(const float* xrow, bf16_t* orow, int lane) {
    const f32x4* xr = (const f32x4*)xrow + lane;
    f32x4 v[4]; float s = 0.f;
#pragma unroll
    for (int j = 0; j < 4; ++j) { v[j] = xr[64 * j]; s += (v[j][0] * v[j][0] + v[j][1] * v[j][1]) + (v[j][2] * v[j][2] + v[j][3] * v[j][3]); }
    u32x2* o8 = (u32x2*)orow + lane;
#pragma unroll
    for (int j = 0; j < 4; ++j) { u32x2 w; w.x = pk_bf16(v[j][0], v[j][1]); w.y = pk_bf16(v[j][2], v[j][3]); o8[64 * j] = w; }
    return wave_sum(s);
}
__device__ __forceinline__ void p0_prologue(const Params& P, LAS unsigned char* lds, int G, int tid, int wid, int lane) {
    unsigned char* ws = P.ws;
    LAS float* scr = (LAS float*)(lds + wid * 16384);
    const int gw = blockIdx.x * 8 + wid, NGW = G * 8;
    constexpr int I_IN = 16 * 96, I_OUT = 16 * 32, NITEMS = 2 * I_IN + 2 * I_OUT;
    for (int it = gw; it < NITEMS; it += NGW) {
        int r = it;
        if (r < 2 * I_IN) { const int l = r / I_IN; r -= l * I_IN;
            p0_transpose_item(P.in[8] + (size_t)l * DM * DIN, DIN, P.in[7] + l * DM, (bf16_t*)(ws + WS_WIN) + (size_t)l * NPAD * DM, scr, r, 96, true, lane); continue; }
        r -= 2 * I_IN; { const int l = r / I_OUT; r -= l * I_OUT;
            p0_transpose_item(P.in[9] + (size_t)l * DM * DM, DM, nullptr, (bf16_t*)(ws + WS_WOUT) + (size_t)l * DM * DM, scr, r, 32, false, lane); }
    }
    if (blockIdx.x == 0 && tid < 7) ((unsigned long long*)(ws + WS_CTL + 32768))[tid] = (unsigned long long)P.in[tid];
#if INKERNEL_BAR_ZERO
    if (blockIdx.x == 0) for (int i = tid; i < 3584; i += 512) ((unsigned*)(ws + WS_CTL) + 4096)[i] = 0u;
#endif
    for (int e = blockIdx.x * 512 + tid; e < 32768; e += G * 512) {
        float v[15];
#define P0_LD(k, idx, n) v[k] = e < (n) ? P.in[idx][e] : 0.f;
        P0_LD(0, 10, 32768) P0_LD(1, 11, 512) P0_LD(2, 12, 128) P0_LD(3, 13, 128) P0_LD(4, 14, 16) P0_LD(5, 15, 1664) P0_LD(6, 16, 512) P0_LD(7, 17, 16384)
        P0_LD(8, 18, 512) P0_LD(9, 19, 16384) P0_LD(10, 20, 512) P0_LD(11, 21, 512) P0_LD(12, 22, 512) P0_LD(13, 23, 512) P0_LD(14, 24, 512)
#define P0_ST(k, off, n) if (e < (n)) ((float*)(ws + WS_PRM))[(off) + e] = v[k];
        P0_ST(0, PRM_POOLW, 32768) P0_ST(1, PRM_POOLSC, 512) P0_ST(2, PRM_QG, 128) P0_ST(3, PRM_KG, 128) P0_ST(4, PRM_SINK, 16) P0_ST(5, PRM_MU, 1664) P0_ST(6, PRM_W0, 512) P0_ST(7, PRM_WUP, 16384)
        P0_ST(8, PRM_A0, 512) P0_ST(9, PRM_AUP, 16384) P0_ST(10, PRM_KK, 512) P0_ST(11, PRM_KA, 512) P0_ST(12, PRM_RK, 512) P0_ST(13, PRM_LNG, 512) P0_ST(14, PRM_LNB, 512)
    }
    for (int e = blockIdx.x * 512 + tid; e < 2 * 2 * 16 * 64 * 8; e += G * 512) {
        const int j = e & 7, ln = (e >> 3) & 63, nb = (e >> 9) & 15, mat = (e >> 13) & 1, l = e >> 14;
        const float* up = P.in[mat ? 19 : 17] + (size_t)l * 32 * 256;
        ((bf16_t*)(ws + WS_WUPF))[e] = f2bf(up[(8 * (ln >> 4) + j) * 256 + 16 * nb + (ln & 15)]);
    }
    for (int e = blockIdx.x * 512 + tid; e < 2 * 4 * 4 * 2 * 64 * 8; e += G * 512) {
        const int j = e & 7, ln = (e >> 3) & 63, kk = (e >> 9) & 1, nb = (e >> 10) & 3, lg = e >> 12;
        ((bf16_t*)(ws + WS_POOLF))[e] = f2bf(P.in[10][((size_t)lg * 64 + 8 * (ln >> 4) + 32 * kk + j) * 64 + 16 * nb + (ln & 15)]);
    }
    for (int e = blockIdx.x * 512 + tid; e < 2049 * 32; e += G * 512) {
        const int pi = e >> 5, i = e & 31; const int pos = pi < 2048 ? pi : 16384;
        const float fr = (float)pow(10000.0, -(double)i / 32.0);
        const float ang = (float)pos * fr;
        f32x2 cs; cs.x = cosf(ang); cs.y = sinf(ang);
        ((f32x2*)(ws + WS_ROPE))[e] = cs;
    }
    for (int m0 = gw; m0 < MP; m0 += 4 * NGW) {
        f32x4 v[4][4];
#pragma unroll
        for (int j = 0; j < 4; ++j) { const int m = m0 + j * NGW; if (m < MP) { const f32x4* xr = (const f32x4*)(P.in[0] + (size_t)m * DM) + lane;
#pragma unroll
            for (int c = 0; c < 4; ++c) v[j][c] = xr[64 * c]; } }
#pragma unroll
        for (int j = 0; j < 4; ++j) { const int m = m0 + j * NGW; if (m < MP) { float s_ = 0.f;
#pragma unroll
            for (int c = 0; c < 4; ++c) s_ += (v[j][c][0] * v[j][c][0] + v[j][c][1] * v[j][c][1]) + (v[j][c][2] * v[j][c][2] + v[j][c][3] * v[j][c][3]);
            u32x2* o8 = (u32x2*)((bf16_t*)(ws + WS_XB) + (size_t)m * DM) + lane;
#pragma unroll
            for (int c = 0; c < 4; ++c) { u32x2 w; w.x = pk_bf16(v[j][c][0], v[j][c][1]); w.y = pk_bf16(v[j][c][2], v[j][c][3]); o8[64 * c] = w; }
            s_ = wave_sum(s_);
            if (lane < 2) ((float*)(ws + WS_RS))[(size_t)lane * MP + m] = lane == 0 ? s_ : 0.f; } }
    }
    for (int ms = gw; ms < MS; ms += NGW) { const float s_ = row_to_bf16(P.in[1] + (size_t)ms * DM, (bf16_t*)(ws + WS_XBS) + (size_t)ms * DM, lane);
        ((float*)(ws + WS_RSS))[ms * 64 + lane] = lane == 0 ? s_ : 0.f; }
}

template <bool IS_IN>
__device__ __forceinline__ void skinny_unit(const Params& P, int layer, int unit, int wid, int lane) {
    unsigned char* ws = P.ws;
    const bf16_t* A = IS_IN ? (const bf16_t*)(ws + WS_XBS) : (const bf16_t*)(ws + WS_MIXS);
    const bf16_t* Bt = IS_IN ? (const bf16_t*)(ws + WS_WIN) + (size_t)layer * NPAD * DM : (const bf16_t*)(ws + WS_WOUT) + (size_t)layer * DM * DM;
    const int n0 = unit * 16, r16 = lane & 15, kq = lane >> 4;
    const bf16x8* ap = (const bf16x8*)(A + (size_t)(16 * wid + r16) * DM + 8 * kq);
    const bf16x8* bp = (const bf16x8*)(Bt + (size_t)(n0 + r16) * DM + 8 * kq);
    f32x4 acc = {0.f, 0.f, 0.f, 0.f};
    float rsv[16];
    if (IS_IN) { const float* RSS = (const float*)(ws + WS_RSS);
#pragma unroll
        for (int rr = 0; rr < 16; ++rr) rsv[rr] = RSS[(16 * wid + rr) * 64 + lane]; }
    const int kst = (unit * 5 + wid * 3) & 31;
#pragma unroll
    for (int hf = 0; hf < 2; ++hf) {
        bf16x8 av[16], bv[16];
#pragma unroll
        for (int i = 0; i < 16; ++i) { const int k = (kst + hf * 16 + i) & 31; av[i] = ap[k * 4]; bv[i] = bp[k * 4]; }
#pragma unroll
        for (int i = 0; i < 16; ++i) acc = __builtin_amdgcn_mfma_f32_16x16x32_bf16(av[i], bv[i], acc, 0, 0, 0);
    }
    const int n = n0 + r16;
    if (IS_IN) {
        float rv = 0.f;
#pragma unroll
        for (int rr = 0; rr < 16; ++rr) { const float s = wave_sum(rsv[rr]); rv = (lane == rr) ? s : rv; }
        rv = __builtin_amdgcn_rsqf(rv * (1.0f / 1024.0f) + 1e-6f);
        const int lc = src_col_in(n);
        float* ZS = (float*)(ws + WS_ZS);
#pragma unroll
        for (int reg = 0; reg < 4; ++reg) { const float ri = __shfl(rv, 4 * kq + reg); if (lc >= 0) ZS[(size_t)(16 * wid + 4 * kq + reg) * DIN + lc] = acc[reg] * ri; }
    } else {
        const int lc = src_col_out(n);
        const float* resid = layer == 0 ? INP(1) : P.out + O_YS;
        float* out = P.out + O_YS;
        bf16_t* XBS = (bf16_t*)(ws + WS_XBS); float* RSS = (float*)(ws + WS_RSS);
#pragma unroll
        for (int reg = 0; reg < 4; ++reg) { const int row = 16 * wid + 4 * kq + reg;
            const float y = resid[(size_t)row * DM + lc] + acc[reg];
            out[(size_t)row * DM + lc] = y;
            if (layer == 0) { XBS[(size_t)row * DM + lc] = f2bf(y); const float s = sum16d(y * y); if (r16 == 0) RSS[row * 64 + unit] = s; } }
    }
}

constexpr int PL_ROW = 144, PL_WAVE = 16 * PL_ROW;
template <int W_>
__device__ __forceinline__ void pool_wave(const Params& P, int layer, int b, int t0, int g, LAS unsigned char* lw, int lane, bool dry) {
    unsigned char* ws = P.ws;
    const int r16 = lane & 15, kq = lane >> 4;
    bf16x8 bfr[4][2];
#pragma unroll
    for (int nb = 0; nb < 4; ++nb)
#pragma unroll
        for (int kk = 0; kk < 2; ++kk) bfr[nb][kk] = *((const bf16x8*)(ws + WS_POOLF) + ((((size_t)(layer * 4 + g) * 4 + nb) * 2 + kk) * 64 + lane));
    LAS unsigned char* us = lw + PL_WAVE;
    { const bf16_t* ug = (const bf16_t*)(ws + WS_U) + ((size_t)b * SEQ) * 256 + 64 * g + 8 * (lane & 7);
      u32x4 uv[10];
#pragma unroll
      for (int i = 0; i < 10; ++i) { const int tt = t0 - 16 + 8 * i + (lane >> 3); uv[i] = (u32x4){0u, 0u, 0u, 0u}; if (tt >= 0) uv[i] = *(const u32x4*)(ug + (long)tt * 256); }
#pragma unroll
      for (int i = 0; i < 10; ++i) *(LAS u32x4*)(us + (8 * i + (lane >> 3)) * PL_ROW + (lane & 7) * 16) = uv[i]; }
    f32x4 scl[4];
#pragma unroll
    for (int nb = 0; nb < 4; ++nb) scl[nb] = *(const f32x4*)(PRM(PRM_POOLSC) + layer * 256 + 64 * g + 16 * nb + 4 * kq);
    float up[16], un[16];
#pragma unroll
    for (int j = 0; j < 16; ++j) up[j] = bf1(*(const LAS bf16_t*)(us + j * PL_ROW + lane * 2));
    float win = 0.f;
#pragma unroll
    for (int j = 1; j < W_; ++j) win += up[16 - j];
    bf16_t* gmb = (bf16_t*)(ws + WS_GM) + ((size_t)b * SEQ + t0 + r16) * 1024 + 64 * g + 4 * kq;
    u32x2 ngt[4];
#pragma unroll
    for (int nb = 0; nb < 4; ++nb) ngt[nb] = *(const u32x2*)(gmb + 16 * nb);
    for (int tq = 0; tq < 64; tq += 16) {
#pragma unroll
        for (int j = 0; j < 16; ++j) un[j] = bf1(*(const LAS bf16_t*)(us + (16 + tq + j) * PL_ROW + lane * 2));
        u32x2 gt[4];
#pragma unroll
        for (int nb = 0; nb < 4; ++nb) gt[nb] = ngt[nb];
        if (tq + 16 < 64) {
#pragma unroll
            for (int nb = 0; nb < 4; ++nb) ngt[nb] = *(const u32x2*)(gmb + (size_t)(tq + 16) * 1024 + 16 * nb); }
#pragma unroll
        for (int j = 0; j < 16; ++j) { const int t = t0 + tq + j;
            win += un[j];
            const float pooled = (t + 1 >= W_) ? win * (1.0f / (float)W_) - un[j] : win / (float)(t + 1) - un[j];
            win -= (j - W_ + 1 >= 0) ? un[(j - W_ + 1) & 15] : up[(16 + j - W_ + 1) & 15];
            *(LAS bf16_t*)(lw + j * PL_ROW + lane * 2) = f2bf(pooled); }
        const bf16x8 a0 = *(const LAS bf16x8*)(lw + r16 * PL_ROW + (8 * kq) * 2), a1 = *(const LAS bf16x8*)(lw + r16 * PL_ROW + (8 * kq + 32) * 2);
#pragma unroll
        for (int nb = 0; nb < 4; ++nb) { f32x4 acc = {0.f, 0.f, 0.f, 0.f};
            acc = __builtin_amdgcn_mfma_f32_16x16x32_bf16(bfr[nb][0], a0, acc, 0, 0, 0);
            acc = __builtin_amdgcn_mfma_f32_16x16x32_bf16(bfr[nb][1], a1, acc, 0, 0, 0);
            const unsigned g0 = gt[nb].x, g1 = gt[nb].y;
            u32x2 w; w.x = pk_bf16(acc[0] * scl[nb][0] * bf_lo(g0), acc[1] * scl[nb][1] * bf_hi(g0)); w.y = pk_bf16(acc[2] * scl[nb][2] * bf_lo(g1), acc[3] * scl[nb][3] * bf_hi(g1));
            *(u32x2*)(gmb + (size_t)tq * 1024 + 16 * nb) = dry ? gt[nb] : w; }
#pragma unroll
        for (int j = 0; j < 16; ++j) up[j] = un[j];
    }
}
__device__ __forceinline__ void pool_unit(const Params& P, int layer, int unit, LAS unsigned char* lds, int wid, int lane, bool dry = false) {
    const int b = unit >> 4, chunk = unit & 15, g = wid & 3, half = wid >> 2;
    const int t0 = chunk * 128 + half * 64;
    LAS unsigned char* lw = lds + wid * (PL_WAVE + 80 * PL_ROW);
    if (g == 0) pool_wave<2>(P, layer, b, t0, g, lw, lane, dry);
    else if (g == 1) pool_wave<4>(P, layer, b, t0, g, lw, lane, dry);
    else if (g == 2) pool_wave<8>(P, layer, b, t0, g, lw, lane, dry);
    else pool_wave<16>(P, layer, b, t0, g, lw, lane, dry);
}

constexpr int KS_STRIDE = 144, VS_STRIDE = 520, ATT_VOFF = 256 * KS_STRIDE;
template <bool STAGE, bool COMPUTE>
__device__ __forceinline__ void attn_unit(const Params& P, int layer, int unit, LAS unsigned char* lds, LAS unsigned char* inv_strip, int tid, int wid, int lane, bool dry = false) {
    unsigned char* ws = P.ws;
    const bf16_t* Q = (const bf16_t*)(ws + WS_Q); const bf16_t* K = (const bf16_t*)(ws + WS_K); const bf16_t* VT = (const bf16_t*)(ws + WS_VT);
    bf16_t* GM = (bf16_t*)(ws + WS_GM);
    const int kvh = unit & 1, n = (unit >> 1) & 15, b = unit >> 5;
    const int tk0 = n * 128 - 128;
    if (STAGE) {
#pragma unroll
    for (int i = 0; i < 4; ++i) { const int idx = tid + 512 * i; const int row = idx >> 3, c = idx & 7; const int t = tk0 + row;
        u32x4 v = {0u, 0u, 0u, 0u}; if (t >= 0) v = *(const u32x4*)(K + ((size_t)b * SEQ + t) * 128 + kvh * 64 + c * 8);
        *(LAS u32x4*)(lds + row * KS_STRIDE + c * 16) = v; }
#pragma unroll
    for (int i = 0; i < 4; ++i) { const int idx = tid + 512 * i; const int d = idx >> 5, c = idx & 31; const int t = tk0 + 8 * c;
        u32x4 v = {0u, 0u, 0u, 0u}; if (t >= 0) v = *(const u32x4*)(VT + ((size_t)(b * 2 + kvh) * 64 + d) * SEQ + t);
        LAS u32x2* dst = (LAS u32x2*)(lds + ATT_VOFF + d * VS_STRIDE + c * 16); dst[0] = (u32x2){v.x, v.y}; dst[1] = (u32x2){v.z, v.w}; }
    }
    if (!COMPUTE) return;
    const int hq = wid >> 1, qh = wid & 1, head = kvh * 4 + hq;
    const int r31 = lane & 31, h = lane >> 5;
    const float sink2 = PRM(PRM_SINK)[layer * 8 + head] * LOG2E;
    const bf16_t* qp0 = Q + ((size_t)b * SEQ + n * 128 + 64 * qh + r31) * 512 + head * 64 + 8 * h;
    bf16x8 nq[4];
#pragma unroll
    for (int ks = 0; ks < 4; ++ks) nq[ks] = *(const bf16x8*)(qp0 + 16 * ks);
#pragma unroll 1
    for (int qb2 = 0; qb2 < 2; ++qb2) {
        const int qb = 2 * qh + qb2, i0 = 32 * qb;
        bf16x8 qf[4];
#pragma unroll
        for (int ks = 0; ks < 4; ++ks) qf[ks] = nq[ks];
        if (qb2 == 0) {
#pragma unroll
            for (int ks = 0; ks < 4; ++ks) nq[ks] = *(const bf16x8*)(qp0 + (size_t)32 * 512 + 16 * ks); }
        f32x16 s[5];
#pragma unroll
        for (int kt = 0; kt < 5; ++kt) {
#pragma unroll
            for (int e = 0; e < 16; ++e) s[kt][e] = 0.f;
            const LAS unsigned char* kb = lds + (32 * (qb + kt) + r31) * KS_STRIDE + 16 * h;
#pragma unroll
            for (int ks = 0; ks < 4; ++ks) { const bf16x8 a = *(const LAS bf16x8*)(kb + 32 * ks); s[kt] = __builtin_amdgcn_mfma_f32_32x32x16_bf16(a, qf[ks], s[kt], 0, 0, 0); }
        }
        const float dqf = (float)(r31 - 4 * h);
        float mx = sink2;
#pragma unroll
        for (int kt = 0; kt < 5; ++kt) { if ((n > 0) || (qb + kt >= 4)) {
#pragma unroll
            for (int e = 0; e < 16; ++e) mx = fmaxf(mx, s[kt][e]); } }
        mx = fmaxf(mx, __shfl_xor(mx, 32));
        float sum = 0.f;
#pragma unroll
        for (int kt = 0; kt < 5; ++kt) { if ((n > 0) || (qb + kt >= 4)) {
#pragma unroll
            for (int e = 0; e < 16; ++e) { const float ko = (float)((e & 3) + 8 * (e >> 2));
                float p = __builtin_amdgcn_exp2f(s[kt][e] - mx);
                if (kt == 0) p *= __builtin_amdgcn_fmed3f(ko - dqf, 0.f, 1.f);
                if (kt == 4) p *= __builtin_amdgcn_fmed3f(dqf - ko + 1.0f, 0.f, 1.f);
                s[kt][e] = p; sum += p; } }
          else {
#pragma unroll
            for (int e = 0; e < 16; ++e) s[kt][e] = 0.f; } }
        sum += __shfl_xor(sum, 32);
        const float inv = 1.0f / (sum + __builtin_amdgcn_exp2f(sink2 - mx));
        bf16_t* gbase = GM + ((size_t)b * SEQ + n * 128 + i0 + r31) * 1024 + 256 + head * 64 + 8 * h;
        u32x4 gts[2][2];
#pragma unroll
        for (int db = 0; db < 2; ++db)
#pragma unroll
            for (int k = 0; k < 2; ++k) gts[db][k] = *(const u32x4*)(gbase + 32 * db + 16 * k);
        f32x16 o[2];
#pragma unroll
        for (int e = 0; e < 16; ++e) { o[0][e] = 0.f; o[1][e] = 0.f; }
#pragma unroll
        for (int kt = 0; kt < 5; ++kt)
#pragma unroll
            for (int s2 = 0; s2 < 2; ++s2) {
                u32x4 pw; pw.x = pk_bf16(s[kt][8 * s2 + 0], s[kt][8 * s2 + 1]); pw.y = pk_bf16(s[kt][8 * s2 + 2], s[kt][8 * s2 + 3]);
                pw.z = pk_bf16(s[kt][8 * s2 + 4], s[kt][8 * s2 + 5]); pw.w = pk_bf16(s[kt][8 * s2 + 6], s[kt][8 * s2 + 7]);
                const bf16x8 pf = __builtin_bit_cast(bf16x8, pw);
#pragma unroll
                for (int db = 0; db < 2; ++db) {
                    const LAS unsigned char* vb = lds + ATT_VOFF + (32 * db + r31) * VS_STRIDE + (32 * (qb + kt) + 16 * s2 + 4 * h) * 2;
                    const u32x2 v0 = *(const LAS u32x2*)vb, v1 = *(const LAS u32x2*)(vb + 16);
                    const u32x4 vw = {v0.x, v0.y, v1.x, v1.y};
                    o[db] = __builtin_amdgcn_mfma_f32_32x32x16_bf16(__builtin_bit_cast(bf16x8, vw), pf, o[db], 0, 0, 0);
                }
            }
#pragma unroll
        for (int db = 0; db < 2; ++db)
#pragma unroll
            for (int k = 0; k < 2; ++k) {
                float v[8];
#pragma unroll
                for (int i = 0; i < 4; ++i) { const auto sw = __builtin_amdgcn_permlane32_swap(__float_as_uint(o[db][8 * k + i]), __float_as_uint(o[db][8 * k + 4 + i]), false, false);
                    v[i] = __uint_as_float(sw[0]) * inv; v[4 + i] = __uint_as_float(sw[1]) * inv; }
                const u32x4 gg = gts[db][k]; const unsigned g0 = gg[0], g1 = gg[1], g2 = gg[2], g3 = gg[3];
                u32x4 w; w.x = pk_bf16(v[0] * bf_lo(g0), v[1] * bf_hi(g0)); w.y = pk_bf16(v[2] * bf_lo(g1), v[3] * bf_hi(g1));
                w.z = pk_bf16(v[4] * bf_lo(g2), v[5] * bf_hi(g2)); w.w = pk_bf16(v[6] * bf_lo(g3), v[7] * bf_hi(g3));
                *(u32x4*)(gbase + 32 * db + 16 * k) = dry ? gg : w;
            }
    }
}

__device__ __forceinline__ float tanhf_(float x) { const float e = fast_exp(2.0f * x); return 1.0f - 2.0f * __builtin_amdgcn_rcpf(e + 1.0f); }
struct PrepRaw { u32x2 r, k, v; };
__device__ __forceinline__ PrepRaw prep_load(const bf16_t* row, int c0, int lane) {
    PrepRaw x; x.r = *(const u32x2*)(row + c0); x.k = *(const u32x2*)(row + 256 + c0); x.v = *(const u32x2*)(row + 512 + c0); return x;
}
struct PrepConst { f32x4 mr, mk, mv, w0, a0, kkp, kap, rkp; };
__device__ __forceinline__ void prep_token(const Params& P, int layer, int r, int lane, const LAS unsigned char* lup, int ti, const PrepRaw& cu, const PrepRaw& pv_, float (&om)[4], const PrepConst& C, float& keep_rkr, float& keep_kr) {
    unsigned char* ws = P.ws;
    const int b = r >> 11, t = r & (SEQ - 1), c0 = 4 * lane, hh = lane >> 4;
    float rs[4], ks[4], vs[4];
    { const u32x2 cr = cu.r, ck = cu.k, cv = cu.v, pr = pv_.r, pk = pv_.k, pv = pv_.v;
      const f32x4 mr = C.mr, mk = C.mk, mv = C.mv;
      const float xr[4] = {bf_lo(cr.x), bf_hi(cr.x), bf_lo(cr.y), bf_hi(cr.y)}, yr[4] = {bf_lo(pr.x), bf_hi(pr.x), bf_lo(pr.y), bf_hi(pr.y)};
      const float xk[4] = {bf_lo(ck.x), bf_hi(ck.x), bf_lo(ck.y), bf_hi(ck.y)}, yk[4] = {bf_lo(pk.x), bf_hi(pk.x), bf_lo(pk.y), bf_hi(pk.y)};
      const float xv[4] = {bf_lo(cv.x), bf_hi(cv.x), bf_lo(cv.y), bf_hi(cv.y)}, yv[4] = {bf_lo(pv.x), bf_hi(pv.x), bf_lo(pv.y), bf_hi(pv.y)};
#pragma unroll
      for (int i = 0; i < 4; ++i) { rs[i] = xr[i] + (yr[i] - xr[i]) * mr[i]; ks[i] = xk[i] + (yk[i] - xk[i]) * mk[i]; vs[i] = xv[i] + (yv[i] - xv[i]) * mv[i]; } }
    float lw[4], la[4];
    { const u32x2 hw = *(const LAS u32x2*)(lup + (size_t)ti * 512 + c0 * 2), ha = *(const LAS u32x2*)(lup + 8192 + (size_t)ti * 512 + c0 * 2);
      const unsigned w0_ = hw[0], w1_ = hw[1], a0_ = ha[0], a1_ = ha[1];
      lw[0] = (float)as_h2(w0_).x; lw[1] = (float)as_h2(w0_).y; lw[2] = (float)as_h2(w1_).x; lw[3] = (float)as_h2(w1_).y;
      la[0] = (float)as_h2(a0_).x; la[1] = (float)as_h2(a0_).y; la[2] = (float)as_h2(a1_).x; la[3] = (float)as_h2(a1_).y; }
    const f32x4 w0 = C.w0, a0 = C.a0, kkp = C.kkp, kap = C.kap, rkp = C.rkp;
    float wv[4], av[4], kk[4], kt[4], bb[4];
    float ssq = 0.f, br = 0.f, kr = 0.f, rkr = 0.f;
#pragma unroll
    for (int i = 0; i < 4; ++i) {
        wv[i] = fast_exp(-0.6065306597126334f * sigmoidf_(w0[i] + lw[i]));
        av[i] = sigmoidf_(a0[i] + la[i]);
        kk[i] = ks[i] * kkp[i]; ssq += kk[i] * kk[i];
        kt[i] = ks[i] * (1.0f + (av[i] - 1.0f) * kap[i]);
        kr += kt[i] * rs[i]; rkr += rs[i] * kt[i] * rkp[i];
    }
    ssq = sum16d(ssq);
    const float kn = fminf(__builtin_amdgcn_rsqf(ssq), 1e12f);
#pragma unroll
    for (int i = 0; i < 4; ++i) { kk[i] *= kn; bb[i] = kk[i] * av[i]; br += bb[i] * rs[i]; }
    br = sum16d(br); kr = sum16d(kr); rkr = sum16d(rkr);
    float wr[4];
#pragma unroll
    for (int i = 0; i < 4; ++i) wr[i] = wv[i] * rs[i] - br * kk[i];
    const size_t rec = ((size_t)(b * 4 + hh) * SEQ + t);
    const int l16 = lane & 15;
#if SCAN_IMPL != 1
    u32x4* pa = (u32x4*)(ws + WS_PA) + rec * 32 + 2 * l16;
    pa[0] = (u32x4){pk_f16(kk[0], kk[1]), pk_f16(bb[0], bb[1]), pk_f16(kt[0], kt[1]), pk_f16(wr[0], wr[1])};
    pa[1] = (u32x4){pk_f16(kk[2], kk[3]), pk_f16(bb[2], bb[3]), pk_f16(kt[2], kt[3]), pk_f16(wr[2], wr[3])};
    *((f32x4*)(ws + WS_PW) + rec * 16 + l16) = (f32x4){wv[0], wv[1], wv[2], wv[3]};
#endif
#if SCAN_IMPL != 0
    if (SCAN_IMPL == 1 || layer == 0) {
        float uk[4], uw[4], bh[4], kh[4];
#pragma unroll
        for (int i = 0; i < 4; ++i) { uk[i] = om[i] * kk[i]; uw[i] = om[i] * wr[i]; om[i] *= wv[i]; const float inv = __builtin_amdgcn_rcpf(om[i]); bh[i] = bb[i] * inv; kh[i] = kt[i] * (inv * 0.0625f); }
        { const bool odd = lane & 1;
          u32x2* pb = (u32x2*)(ws + WS_PB) + rec * 64 + (odd ? 16 + l16 - 1 : l16);
          const unsigned uk0 = pk_f16(uk[0], uk[1]), uk1 = pk_f16(uk[2], uk[3]), uw0 = pk_f16(uw[0], uw[1]), uw1 = pk_f16(uw[2], uw[3]);
          const unsigned bh0 = pk_f16(bh[0], bh[1]), bh1 = pk_f16(bh[2], bh[3]), kh0 = pk_f16(kh[0], kh[1]), kh1 = pk_f16(kh[2], kh[3]);
          const unsigned s0 = odd ? uk0 : uw0, s1 = odd ? uk1 : uw1, s2 = odd ? bh0 : kh0, s3 = odd ? bh1 : kh1;
          const unsigned q0 = (unsigned)__builtin_amdgcn_update_dpp(0, (int)s0, 0xB1, 0xf, 0xf, true), q1 = (unsigned)__builtin_amdgcn_update_dpp(0, (int)s1, 0xB1, 0xf, 0xf, true);
          const unsigned q2 = (unsigned)__builtin_amdgcn_update_dpp(0, (int)s2, 0xB1, 0xf, 0xf, true), q3 = (unsigned)__builtin_amdgcn_update_dpp(0, (int)s3, 0xB1, 0xf, 0xf, true);
          *(u32x4*)pb = odd ? (u32x4){q0, q1, uw0, uw1} : (u32x4){uk0, uk1, q0, q1};
          *(u32x4*)(pb + 32) = odd ? (u32x4){q2, q3, kh0, kh1} : (u32x4){bh0, bh1, q2, q3}; }
#if DBG_DOUBLE & 4096
        { u32x2* pd = (u32x2*)(ws + WS_PW) + (rec & 65535) * 64 + l16;
          pd[0] = (u32x2){pk_f16(uk[0], uk[1]), pk_f16(uk[2], uk[3])}; pd[16] = (u32x2){pk_f16(uw[0], uw[1]), pk_f16(uw[2], uw[3])};
          pd[32] = (u32x2){pk_f16(bh[0], bh[1]), pk_f16(bh[2], bh[3])}; pd[48] = (u32x2){pk_f16(kh[0], kh[1]), pk_f16(kh[2], kh[3])}; }
#endif
        if ((t & 15) == 15) *((f32x4*)(ws + WS_PO) + ((size_t)(b * 4 + hh) * (SEQ / 16) + (t >> 4)) * 16 + l16) = (f32x4){om[0], om[1], om[2], om[3]};
    }
#endif
    *((u32x4*)(ws + WS_PV) + rec * 16 + l16) = (u32x4){pk_f16(vs[0], vs[0] * kr), pk_f16(vs[1], vs[1] * kr), pk_f16(vs[2], vs[2] * kr), pk_f16(vs[3], vs[3] * kr)};
    if (l16 == ti) { keep_rkr = rkr; keep_kr = kr; }
}
__device__ __forceinline__ void prep_run(const Params& P, int layer, int r0, int lane, LAS unsigned char* lup) {
    unsigned char* ws = P.ws;
    const bf16_t* RIN = (const bf16_t*)(ws + WS_RIN);
    const int c0 = 4 * lane;
    {
        const int tok = lane & 15, kq = lane >> 4, r = r0 + tok; const bool hp = (r & (SEQ - 1)) != 0;
        const float* mu = PRM(PRM_MU) + layer * DSH + 768 + 8 * kq;
        const bf16_t* cw = RIN + (size_t)r * DSH + 768 + 8 * kq;
        const u32x4 cww = *(const u32x4*)cw, caw = *(const u32x4*)(cw + 32);
        u32x4 pww = {0u, 0u, 0u, 0u}, paw = {0u, 0u, 0u, 0u};
        if (hp) { pww = *(const u32x4*)(cw - DSH); paw = *(const u32x4*)(cw - DSH + 32); }
        const f32x4 mw0 = *(const f32x4*)mu, mw1 = *(const f32x4*)(mu + 4), ma0 = *(const f32x4*)(mu + 32), ma1 = *(const f32x4*)(mu + 36);
        u32x4 fw, fa;
#pragma unroll
        for (int q = 0; q < 4; ++q) { const unsigned cwq = cww[q], pwq = pww[q], caq = caw[q], paq = paw[q];
            const float mlo = q < 2 ? mw0[2 * q] : mw1[2 * q - 4], mhi = q < 2 ? mw0[2 * q + 1] : mw1[2 * q - 3];
            const float nlo = q < 2 ? ma0[2 * q] : ma1[2 * q - 4], nhi = q < 2 ? ma0[2 * q + 1] : ma1[2 * q - 3];
            const float xl = bf_lo(cwq), xh = bf_hi(cwq), yl = bf_lo(caq), yh = bf_hi(caq);
            fw[q] = pk_bf16(tanhf_(xl + (bf_lo(pwq) - xl) * mlo), tanhf_(xh + (bf_hi(pwq) - xh) * mhi));
            fa[q] = pk_bf16(yl + (bf_lo(paq) - yl) * nlo, yh + (bf_hi(paq) - yh) * nhi); }
        const bf16x8 Aw = __builtin_bit_cast(bf16x8, fw), Aa = __builtin_bit_cast(bf16x8, fa);
        const u32x4* bfw = (const u32x4*)(ws + WS_WUPF) + (size_t)layer * 2 * 16 * 64 + lane;
#pragma unroll 4
        for (int nb = 0; nb < 16; ++nb) {
            const u32x4 bw = bfw[nb * 64], ba = bfw[(16 + nb) * 64];
            f32x4 z = {0.f, 0.f, 0.f, 0.f};
            const f32x4 dw = __builtin_amdgcn_mfma_f32_16x16x32_bf16(Aw, __builtin_bit_cast(bf16x8, bw), z, 0, 0, 0);
            const f32x4 da = __builtin_amdgcn_mfma_f32_16x16x32_bf16(Aa, __builtin_bit_cast(bf16x8, ba), z, 0, 0, 0);
            LAS _Float16* dst = (LAS _Float16*)lup + (size_t)(4 * kq) * 256 + 16 * nb + tok;
#pragma unroll
            for (int reg = 0; reg < 4; ++reg) { dst[reg * 256] = (_Float16)dw[reg]; dst[4096 + reg * 256] = (_Float16)da[reg]; }
        }
        asm volatile("s_waitcnt lgkmcnt(0)" ::: "memory");
    }
    PrepRaw pv_; pv_.r = (u32x2){0u, 0u}; pv_.k = (u32x2){0u, 0u}; pv_.v = (u32x2){0u, 0u};
    if ((r0 & (SEQ - 1)) != 0) pv_ = prep_load(RIN + (size_t)(r0 - 1) * DSH, c0, lane);
    PrepRaw cu = prep_load(RIN + (size_t)r0 * DSH, c0, lane);
    float om[4] = {1.f, 1.f, 1.f, 1.f};
    PrepConst C;
    { const float* mu = PRM(PRM_MU) + layer * DSH;
      C.mr = *(const f32x4*)(mu + c0); C.mk = *(const f32x4*)(mu + 256 + c0); C.mv = *(const f32x4*)(mu + 512 + c0);
      C.w0 = *(const f32x4*)(PRM(PRM_W0) + layer * 256 + c0); C.a0 = *(const f32x4*)(PRM(PRM_A0) + layer * 256 + c0);
      C.kkp = *(const f32x4*)(PRM(PRM_KK) + layer * 256 + c0); C.kap = *(const f32x4*)(PRM(PRM_KA) + layer * 256 + c0); C.rkp = *(const f32x4*)(PRM(PRM_RK) + layer * 256 + c0); }
    float keep_rkr = 0.f, keep_kr = 0.f;
#pragma unroll 2
    for (int i = 0; i < 16; ++i) {
        PrepRaw nx = cu;
        if (i < 15) nx = prep_load(RIN + (size_t)(r0 + i + 1) * DSH, c0, lane);
        prep_token(P, layer, r0 + i, lane, lup, i, cu, pv_, om, C, keep_rkr, keep_kr);
        pv_ = cu; cu = nx;
    }
    { const size_t o = (size_t)(r0 + (lane & 15)) * 4 + (lane >> 4); ((float*)(ws + WS_RKR))[o] = keep_rkr; ((float*)(ws + WS_KRA))[o] = keep_kr; }
    asm volatile("s_waitcnt lgkmcnt(0)" ::: "memory");
}

__device__ __forceinline__ void decode_mix(const Params& P, int layer, int tok, int part, LAS unsigned char* lds, int tid, int wid, int lane) {
    unsigned char* ws = P.ws;
    const float* z = (const float*)(ws + WS_ZS) + (size_t)tok * DIN;
    bf16_t* MIXS = (bf16_t*)(ws + WS_MIXS) + (size_t)tok * DM;
    constexpr int DK_ROW = 528, DK_V = 67072, DK_SCR = 134144;
    LAS float* L = (LAS float*)(lds + DK_SCR);
    LAS float* pooled = L;
    LAS float* qs = L + 256;
    LAS float* knew = L + 768;
    LAS float* vnew = L + 896;
    LAS float* scs = L + 1024;
    LAS float* xs = (LAS float*)lds;
    LAS float* kkn = xs + 832;
    LAS float* bvec = kkn + 256;
    LAS float* wvv = bvec + 256;
    LAS float* ktv = wvv + 256;
    LAS float* rrv = ktv + 256;
    LAS float* vvv = rrv + 256;
    LAS float* ov = vvv + 256;
    LAS float* rkrs = ov + 256;
    const size_t lt = (size_t)layer * MS + tok;
    if (part == 0) {
    const float* kc = INP(3) + lt * 128 * 128; const float* vc = INP(4) + lt * 128 * 128;
    {
        const f32x4* ks_ = (const f32x4*)(kc + 128); const f32x4* vs_ = (const f32x4*)(vc + 128);
        f32x4* kd = (f32x4*)(P.out + O_KS + lt * 128 * 128); f32x4* vd = (f32x4*)(P.out + O_VS + lt * 128 * 128);
        f32x4 kt_[8], vt_[8];
#pragma unroll
        for (int q = 0; q < 8; ++q) { const int i = tid + 512 * q; if (i < 127 * 32) { kt_[q] = ks_[i]; vt_[q] = vs_[i]; } }
#pragma unroll
        for (int q = 0; q < 8; ++q) { const int i = tid + 512 * q; if (i < 127 * 32) { kd[i] = kt_[q]; vd[i] = vt_[q];
            *(LAS f32x4*)(lds + (i >> 5) * DK_ROW + (i & 31) * 16) = kt_[q]; *(LAS f32x4*)(lds + DK_V + (i >> 5) * DK_ROW + (i & 31) * 16) = vt_[q]; } }
    }
    const f32x2 cs = ((const f32x2*)(ws + WS_ROPE))[2048 * 32 + (lane & 31)];
    {
        const float x = z[512 + wid * 64 + lane];
        const float ss = wave_sum(x * x);
        const float xn = x * (1.0f / sqrtf(ss * (1.0f / 64.0f) + 1e-6f)) * PRM(PRM_QG)[layer * 64 + lane];
        const float pr = __shfl_xor(xn, 32);
        qs[wid * 64 + lane] = (lane < 32 ? xn * cs.x - pr * cs.y : pr * cs.y + xn * cs.x) * 0.125f;
    }
    if (wid < 2) {
        const float x = z[1024 + wid * 64 + lane];
        const float ss = wave_sum(x * x);
        const float xn = x * (1.0f / sqrtf(ss * (1.0f / 64.0f) + 1e-6f)) * PRM(PRM_KG)[layer * 64 + lane];
        const float pr = __shfl_xor(xn, 32);
        const float kv = lane < 32 ? xn * cs.x - pr * cs.y : pr * cs.y + xn * cs.x;
        knew[wid * 64 + lane] = kv;
        P.out[O_KS + (lt * 128 + 127) * 128 + wid * 64 + lane] = kv;
    } else if (wid < 4) {
        const float x = z[1152 + (wid - 2) * 64 + lane];
        vnew[(wid - 2) * 64 + lane] = x;
        P.out[O_VS + (lt * 128 + 127) * 128 + (wid - 2) * 64 + lane] = x;
    }
    __syncthreads();
    {
        const int kvh = wid >> 2;
#pragma unroll
        for (int jj = 0; jj < 2; ++jj) { const int j = lane + 64 * jj; float a = 0.f;
            if (j < 127) { const LAS f32x4* kr_ = (const LAS f32x4*)(lds + j * DK_ROW + kvh * 256);
#pragma unroll
                for (int d4 = 0; d4 < 16; ++d4) { const f32x4 kq = kr_[d4]; const LAS float* qq = qs + wid * 64 + 4 * d4; a += kq[0] * qq[0] + kq[1] * qq[1] + kq[2] * qq[2] + kq[3] * qq[3]; } }
            else {
#pragma unroll 8
                for (int d = 0; d < 64; ++d) a += knew[kvh * 64 + d] * qs[wid * 64 + d]; }
            scs[wid * 128 + j] = a; }
    }
    __syncthreads();
    {
        const float sk = PRM(PRM_SINK)[layer * 8 + wid];
        const float s0 = scs[wid * 128 + lane], s1 = scs[wid * 128 + 64 + lane];
        const float m = fmaxf(wave_max(fmaxf(s0, s1)), sk);
        const float p0 = fast_exp(s0 - m), p1 = fast_exp(s1 - m);
        const float den = wave_sum(p0 + p1) + fast_exp(sk - m);
        scs[wid * 128 + lane] = p0 / den; scs[wid * 128 + 64 + lane] = p1 / den;
    }
    __syncthreads();
    {
        const int kvh = wid >> 2; float o = 0.f;
        const LAS float* vb = (const LAS float*)(lds + DK_V) + kvh * 64 + lane;
#pragma unroll 16
        for (int j = 0; j < 127; ++j) o += scs[wid * 128 + j] * vb[j * (DK_ROW / 4)];
        o += scs[wid * 128 + 127] * vnew[kvh * 64 + lane];
        MIXS[256 + wid * 64 + lane] = f2bf(o * siluf_(z[1280 + wid * 64 + lane]));
    }
    } else {
    const int row = tid >> 1, half = tid & 1, hd = row >> 6;
    const f32x4* sp = (const f32x4*)(INP(6) + (lt * 256 + row) * 64 + 32 * half);
    f32x4 S[8];
#pragma unroll
    for (int i = 0; i < 8; ++i) S[i] = sp[i];
    const float* mu = PRM(PRM_MU) + layer * DSH;
    const float* shp = INP(5) + lt * DSH;
    { const int i0 = tid, i1 = tid + 512;
      float x0 = 0.f, x1 = 0.f, s0 = 0.f, s1 = 0.f, m0 = 0.f, m1 = 0.f;
      if (i0 < DSH) { x0 = z[1792 + i0]; s0 = shp[i0]; m0 = mu[i0]; }
      if (i1 < DSH) { x1 = z[1792 + i1]; s1 = shp[i1]; m1 = mu[i1]; }
      if (i0 < DSH) { P.out[O_SHS + lt * DSH + i0] = x0; xs[i0] = x0 + (s0 - x0) * m0; }
      if (i1 < DSH) { P.out[O_SHS + lt * DSH + i1] = x1; xs[i1] = x1 + (s1 - x1) * m1; } }
    if (tid >= 256) {
        const int c = tid - 256, g = c >> 6, W_ = 2 << g;
        const float* buf = INP(2) + lt * 15 * 256 + c;
        float* po = P.out + O_POOLS + lt * 15 * 256 + c;
        const float u = z[c];
        float eb[15];
#pragma unroll
        for (int j = 0; j < 15; ++j) eb[j] = buf[j * 256];
        float win = u;
#pragma unroll
        for (int j = 0; j < 15; ++j) { if (j >= 16 - W_) win += eb[j]; if (j >= 1) po[(j - 1) * 256] = eb[j]; }
        po[14 * 256] = u;
        pooled[c] = win / (float)W_ - u;
    }
    __syncthreads();
    if (tid >= 256) {
        const int c = tid - 256, g = c >> 6, d = c & 63;
        const float* pw = PRM(PRM_POOLW) + ((size_t)(layer * 4 + g) * 64) * 64 + d;
        float a = 0.f;
#pragma unroll 32
        for (int cc = 0; cc < 64; ++cc) a += pooled[64 * g + cc] * pw[cc * 64];
        MIXS[c] = f2bf(a * PRM(PRM_POOLSC)[layer * 256 + c] * siluf_(z[256 + c]));
    }
    if (tid < 256) {
        const int c = tid;
        float lw = 0.f, la = 0.f;
#pragma unroll 16
        for (int j = 0; j < 32; ++j) { lw += tanhf_(xs[768 + j]) * PRM(PRM_WUP)[((size_t)layer * 32 + j) * 256 + c]; la += xs[800 + j] * PRM(PRM_AUP)[((size_t)layer * 32 + j) * 256 + c]; }
        const float wv = fast_exp(-0.6065306597126334f * sigmoidf_(PRM(PRM_W0)[layer * 256 + c] + lw));
        const float av = sigmoidf_(PRM(PRM_A0)[layer * 256 + c] + la);
        const float rr = xs[c], kx = xs[256 + c], vx = xs[512 + c];
        float kk = kx * PRM(PRM_KK)[layer * 256 + c];
        const float ssq = wave_sum(kk * kk);
        kk = kk / fmaxf(sqrtf(ssq), 1e-12f);
        const float kt = kx * (1.0f + (av - 1.0f) * PRM(PRM_KA)[layer * 256 + c]);
        const float rkr = wave_sum(rr * kt * PRM(PRM_RK)[layer * 256 + c]);
        kkn[c] = kk; bvec[c] = kk * av; wvv[c] = wv; ktv[c] = kt; rrv[c] = rr; vvv[c] = vx;
        if (lane == 0) rkrs[wid] = rkr;
    }
    __syncthreads();
    {
        f32x4* so = (f32x4*)(P.out + O_WKS + (lt * 256 + row) * 64 + 32 * half);
        float sa = 0.f;
#pragma unroll
        for (int i = 0; i < 8; ++i) {
#pragma unroll
            for (int e = 0; e < 4; ++e) sa += S[i][e] * kkn[hd * 64 + 32 * half + 4 * i + e]; }
        sa += __shfl_xor(sa, 1);
        const float vr = vvv[row]; float o = 0.f;
#pragma unroll
        for (int i = 0; i < 8; ++i) {
#pragma unroll
            for (int e = 0; e < 4; ++e) { const int k = hd * 64 + 32 * half + 4 * i + e;
                const float sn = S[i][e] * wvv[k] - sa * bvec[k] + vr * ktv[k]; S[i][e] = sn; o += sn * rrv[k]; }
            so[i] = S[i]; }
        o += __shfl_xor(o, 1);
        if (half == 0) ov[row] = o;
    }
    __syncthreads();
    if (tid < 256) {
        const int c = tid;
        const float o = ov[c];
        const float mean = wave_sum(o) * (1.0f / 64.0f);
        const float dlt = o - mean;
        const float var = wave_sum(dlt * dlt) * (1.0f / 64.0f);
        const float on = dlt * (1.0f / sqrtf(var + 64e-5f)) * PRM(PRM_LNG)[layer * 256 + c] + PRM(PRM_LNB)[layer * 256 + c];
        MIXS[768 + c] = f2bf((on + rkrs[wid] * vvv[c]) * siluf_(z[2624 + c]));
    }
    }
    __syncthreads();
}

constexpr int SC_TC = 32, SC_A1A = 0, SC_A1B = SC_TC * 256, SC_A2A = 2 * SC_TC * 256, SC_A2B = 3 * SC_TC * 256, SC_W = 4 * SC_TC * 256, SC_V = 5 * SC_TC * 256, SC_BUF = SC_V + SC_TC * 128;
#define DPP_ADD(z, CTRL) ((z) + __builtin_bit_cast(float, __builtin_amdgcn_update_dpp(0, __builtin_bit_cast(int, (z)), (CTRL), 0xf, 0xf, true)))
__device__ __forceinline__ void scan_unit(const Params& P, int layer, int unit, LAS unsigned char* lds, int tid, int wid, int lane) {
    unsigned char* ws = P.ws;
    const int hb = unit >> 2, rg = unit & 3;
    const int p = lane & 15, rowl = (wid & 3) * 4 + (lane >> 4), row = 16 * rg + rowl;
    const bool odd = (lane & 1) != 0, worker = wid < 4;
    const unsigned char* gA = ws + WS_PA + (size_t)hb * SEQ * 512;
    const unsigned char* gW = ws + WS_PW + (size_t)hb * SEQ * 256;
    const unsigned char* gV = ws + WS_PV + ((size_t)hb * SEQ * 64 + 16 * rg) * 4;
    const int stid = tid - 256;
    u32x4 ra[4], rw[2], rv = {0u, 0u, 0u, 0u};
#define SC_GLOAD(c) do { if (!worker) { const size_t t0_ = (size_t)(c) * SC_TC; \
        _Pragma("unroll") for (int i = 0; i < 4; ++i) ra[i] = *(const u32x4*)(gA + t0_ * 512 + (size_t)(stid + 256 * i) * 16); \
        _Pragma("unroll") for (int i = 0; i < 2; ++i) rw[i] = *(const u32x4*)(gW + t0_ * 256 + (size_t)(stid + 256 * i) * 16); \
        if (stid < 128) rv = *(const u32x4*)(gV + (t0_ + (stid >> 2)) * 256 + (stid & 3) * 16); } } while (0)
#define SC_LSTORE(buf) do { if (!worker) { LAS unsigned char* B_ = lds + (buf) * SC_BUF; \
        _Pragma("unroll") for (int i = 0; i < 4; ++i) { const int idx = stid + 256 * i; const int tk_ = idx >> 5, pr_ = idx & 31, sl_ = pr_ >> 1, hf_ = pr_ & 1; \
            const unsigned x0 = ra[i][0], x1 = ra[i][1], x2 = ra[i][2], x3 = ra[i][3]; const h2_t h0 = as_h2(x0), h1 = as_h2(x1), h2 = as_h2(x2), h3 = as_h2(x3); \
            *(LAS f32x4*)(B_ + (hf_ ? SC_A1B : SC_A1A) + tk_ * 256 + sl_ * 16) = (f32x4){(float)h0.x, (float)h3.x, (float)h0.y, (float)h3.y}; \
            *(LAS f32x2*)(B_ + SC_A2A + tk_ * 256 + sl_ * 16 + hf_ * 8) = (f32x2){(float)h1.x, (float)h1.y}; \
            *(LAS f32x2*)(B_ + SC_A2B + tk_ * 256 + sl_ * 16 + hf_ * 8) = (f32x2){(float)h2.x, (float)h2.y}; } \
        _Pragma("unroll") for (int i = 0; i < 2; ++i) *(LAS u32x4*)(B_ + SC_W + (stid + 256 * i) * 16) = rw[i]; \
        if (stid < 128) { const unsigned y0 = rv[0], y1 = rv[1], y2 = rv[2], y3 = rv[3]; const h2_t g0 = as_h2(y0), g1 = as_h2(y1), g2 = as_h2(y2), g3 = as_h2(y3); \
            *(LAS f32x4*)(B_ + SC_V + stid * 32) = (f32x4){(float)g0.x, (float)g0.y, (float)g1.x, (float)g1.y}; \
            *(LAS f32x4*)(B_ + SC_V + stid * 32 + 16) = (f32x4){(float)g2.x, (float)g2.y, (float)g3.x, (float)g3.y}; } } } while (0)
    f32x2 Sa = {0.f, 0.f}, Sb = {0.f, 0.f};
    SC_GLOAD(0); SC_LSTORE(0);
    __syncthreads();
    const __amdgpu_buffer_rsrc_t orsrc = __builtin_amdgcn_make_buffer_rsrc((void*)(ws + WS_ORAW), 0, 32 * 1024 * 1024, 0x00020000);
    const unsigned obase = (unsigned)((((size_t)(hb >> 2) * SEQ) * 256 + (hb & 3) * 64 + row) * 4);
    for (int c = 0; c < SEQ / SC_TC; ++c) {
        if (c + 1 < SEQ / SC_TC) SC_GLOAD(c + 1);
        if (worker) {
            const LAS unsigned char* B = lds + (c & 1) * SC_BUF + p * 16;
            const LAS unsigned char* pV = lds + (c & 1) * SC_BUF + SC_V + rowl * 8;
            unsigned ooff = (p == 1) ? obase + (unsigned)c * (SC_TC * 1024) : 0x7fffff00u;
            f32x4 n1a = *(const LAS f32x4*)(B + SC_A1A), n1b = *(const LAS f32x4*)(B + SC_A1B), n2a = *(const LAS f32x4*)(B + SC_A2A), n2b = *(const LAS f32x4*)(B + SC_A2B), nw = *(const LAS f32x4*)(B + SC_W);
            f32x2 nv = *(const LAS f32x2*)pV;
#pragma unroll 8
            for (int tt = 0; tt < SC_TC; ++tt) {
                const f32x4 a1a = n1a, a1b = n1b, bb = n2a, kt = n2b, w = nw; const f32x2 v2 = nv;
                { const int o_ = (tt + 1) * 256;
                  n1a = *(const LAS f32x4*)(B + SC_A1A + o_); n1b = *(const LAS f32x4*)(B + SC_A1B + o_); n2a = *(const LAS f32x4*)(B + SC_A2A + o_); n2b = *(const LAS f32x4*)(B + SC_A2B + o_);
                  nw = *(const LAS f32x4*)(B + SC_W + o_); nv = *(const LAS f32x2*)(pV + (tt + 1) * 128); }
                f32x2 pq = (f32x2){a1a[0], a1a[1]} * Sa[0] + (f32x2){a1a[2], a1a[3]} * Sa[1];
                pq = pq + (f32x2){a1b[0], a1b[1]} * Sb[0] + (f32x2){a1b[2], a1b[3]} * Sb[1];
                const float x = odd ? pq[1] : pq[0], y = odd ? pq[0] : pq[1];
                float zr = x + __builtin_bit_cast(float, __builtin_amdgcn_update_dpp(0, __builtin_bit_cast(int, y), 0xB1, 0xf, 0xf, true));
                zr = DPP_ADD(zr, 0x4E);
                zr = DPP_ADD(zr, 0x124);
                zr = DPP_ADD(zr, 0x128);
                const float nsa = -__builtin_bit_cast(float, __builtin_amdgcn_update_dpp(0, __builtin_bit_cast(int, zr), 0xA0, 0xf, 0xf, true));
                Sa = Sa * (f32x2){w[0], w[1]} + ((f32x2){bb[0], bb[1]} * nsa + (f32x2){kt[0], kt[1]} * v2[0]);
                Sb = Sb * (f32x2){w[2], w[3]} + ((f32x2){bb[2], bb[3]} * nsa + (f32x2){kt[2], kt[3]} * v2[0]);
                __builtin_amdgcn_raw_buffer_store_b32(__float_as_uint(zr + v2[1]), orsrc, ooff, 0, 0);
                ooff += 1024u;
            }
        }
        if (c + 1 < SEQ / SC_TC) SC_LSTORE((c + 1) & 1);
        __syncthreads();
    }
    if (worker) *(f32x4*)(P.out + O_WKP + (((size_t)layer * 64 + hb) * 64 + row) * 64 + 4 * p) = (f32x4){Sa[0], Sa[1], Sb[0], Sb[1]};
#undef SC_GLOAD
#undef SC_LSTORE
}

typedef _Float16 half8 __attribute__((ext_vector_type(8)));
typedef _Float16 half4 __attribute__((ext_vector_type(4)));
constexpr int MS_TROW = 144, MS_TILE = 16 * MS_TROW;
constexpr int MS_UK = 0, MS_UW = MS_TILE, MS_A5 = 2 * MS_TILE, MS_OM = MS_A5 + 4096, MS_A3 = MS_OM + 256, MS_A4 = MS_A3 + 1024, MS_VB = MS_A4 + 1024, MS_IMG = MS_VB + 4 * 512;
constexpr int MS_SCR = 2 * MS_TILE, MS_SCR0 = 8 * MS_IMG;
#define MFMA16H(a, b, c) __builtin_amdgcn_mfma_f32_16x16x32_f16((a), (b), (c), 0, 0, 0)
__device__ __forceinline__ half8 pack_h8(f32x4 lo, f32x4 hi) { half8 h; h[0] = (_Float16)lo[0]; h[1] = (_Float16)lo[1]; h[2] = (_Float16)lo[2]; h[3] = (_Float16)lo[3];
    h[4] = (_Float16)hi[0]; h[5] = (_Float16)hi[1]; h[6] = (_Float16)hi[2]; h[7] = (_Float16)hi[3]; return h; }
__device__ __forceinline__ half8 pack_h8v(f32x4 lo, half4 hi) { half8 h; h[0] = (_Float16)lo[0]; h[1] = (_Float16)lo[1]; h[2] = (_Float16)lo[2]; h[3] = (_Float16)lo[3];
    h[4] = hi[0]; h[5] = hi[1]; h[6] = hi[2]; h[7] = hi[3]; return h; }

struct MsRegs { half8 f[4][2]; float om; float krj; unsigned vraw[4][4]; };
__device__ __forceinline__ void mscan_load(const unsigned char* ws, int hb, int c, int lane, MsRegs& R) {
    const int r = lane & 15, q = lane >> 4;
    const size_t t0 = (size_t)c * 16;
    const unsigned char* gB = ws + WS_PB + ((size_t)hb * SEQ + t0 + r) * 512 + (size_t)q * 16;
#pragma unroll
    for (int m = 0; m < 4; ++m)
#pragma unroll
        for (int s2 = 0; s2 < 2; ++s2) R.f[m][s2] = *(const half8*)(gB + m * 128 + s2 * 64);
    R.om = ((const float*)(ws + WS_PO))[((size_t)hb * (SEQ / 16) + c) * 64 + lane];
    R.krj = ((const float*)(ws + WS_KRA))[((size_t)(hb >> 2) * SEQ + t0 + r) * 4 + (hb & 3)];
    const unsigned* gV = (const unsigned*)(ws + WS_PV) + ((size_t)hb * SEQ + t0 + 4 * q) * 64 + r;
#pragma unroll
    for (int rg = 0; rg < 4; ++rg)
#pragma unroll
        for (int e = 0; e < 4; ++e) R.vraw[rg][e] = gV[(size_t)e * 64 + 16 * rg];
}
__device__ __forceinline__ void mscan_build(const MsRegs& R, LAS unsigned char* img, LAS unsigned char* scr, int lane) {
    const int r = lane & 15, q = lane >> 4, k = lane;
    LAS unsigned char* tBH = scr; LAS unsigned char* tKH = scr + MS_TILE;
#pragma unroll
    for (int s2 = 0; s2 < 2; ++s2) { const int co = r * MS_TROW + (8 * q + 32 * s2) * 2;
        *(LAS half8*)(img + MS_UK + co) = R.f[0][s2]; *(LAS half8*)(img + MS_UW + co) = R.f[1][s2];
        *(LAS half8*)(tBH + co) = R.f[2][s2]; *(LAS half8*)(tKH + co) = R.f[3][s2]; }
    f32x4 be = {0.f, 0.f, 0.f, 0.f}, ga = be, bp = be, gp = be, gaT = be, beT = be;
#pragma unroll
    for (int s2 = 0; s2 < 2; ++s2) { const half8 fUK = R.f[0][s2], fUW = R.f[1][s2], fBH = R.f[2][s2], fKH = R.f[3][s2];
        be = MFMA16H(fBH, fUK, be); ga = MFMA16H(fKH, fUK, ga); bp = MFMA16H(fBH, fUW, bp); gp = MFMA16H(fKH, fUW, gp); gaT = MFMA16H(fUK, fKH, gaT); beT = MFMA16H(fUK, fBH, beT); }
#pragma unroll
    for (int reg = 0; reg < 4; ++reg) { const int i = 4 * q + reg; const bool up = i < r, lo = r < i;
        be[reg] = up ? be[reg] : 0.f; ga[reg] = up ? ga[reg] : 0.f; bp[reg] = up ? bp[reg] : 0.f; gp[reg] = up ? gp[reg] : 0.f;
        gaT[reg] = lo ? gaT[reg] : 0.f; beT[reg] = lo ? beT[reg] : 0.f; }
    ga = ga * 16.0f; gp = gp * 16.0f; gaT = gaT * 16.0f;
#define MS_H4(x) ({ half4 h_; h_[0] = (_Float16)(x)[0]; h_[1] = (_Float16)(x)[1]; h_[2] = (_Float16)(x)[2]; h_[3] = (_Float16)(x)[3]; h_; })
#define MS_MM(xt, y) __builtin_amdgcn_mfma_f32_16x16x16f16(MS_H4(xt), MS_H4(y), ((f32x4){0.f, 0.f, 0.f, 0.f}), 0, 0, 0)
    const f32x4 nN = -be, nNT = -beT;
    const f32x4 N2 = MS_MM(nNT, nN), N2T = MS_MM(nN, nNT);
    const f32x4 N4 = MS_MM(N2T, N2), N4T = MS_MM(N2, N2T);
    const f32x4 N8 = MS_MM(N4T, N4);
    const f32x4 N3 = MS_MM(nNT, N2), N3T = MS_MM(N2, nNT);
    f32x4 P1 = nN + N2 + N3, P1T = nNT + N2T + N3T;
#pragma unroll
    for (int reg = 0; reg < 4; ++reg) { const float d = (4 * q + reg == r) ? 1.0f : 0.f; P1[reg] += d; P1T[reg] += d; }
    const f32x4 P2 = P1 + MS_MM(P1T, N4), P2T = P1T + MS_MM(N4, P1T);
    const f32x4 Tm = P2 + MS_MM(P2T, N8);
    const f32x4 g2 = MS_MM(gaT, Tm);
    { half8 h3; h3[0] = (_Float16)Tm[0]; h3[1] = (_Float16)Tm[1]; h3[2] = (_Float16)Tm[2]; h3[3] = (_Float16)Tm[3]; h3[4] = (_Float16)g2[0]; h3[5] = (_Float16)g2[1]; h3[6] = (_Float16)g2[2]; h3[7] = (_Float16)g2[3];
      *(LAS half8*)(img + MS_A3 + lane * 16) = h3; }
    { half8 h4;
#pragma unroll
      for (int e = 0; e < 4; ++e) { h4[e] = (_Float16)(-bp[e]); h4[4 + e] = (_Float16)(gp[e] + ((4 * q + e == r) ? R.krj : 0.f)); }
      *(LAS half8*)(img + MS_A4 + lane * 16) = h4; }
#pragma unroll
    for (int rg = 0; rg < 4; ++rg) { half4 hv;
#pragma unroll
      for (int e = 0; e < 4; ++e) { const unsigned u = R.vraw[rg][e]; hv[e] = as_h2(u).x; }
      *(LAS half4*)(img + MS_VB + rg * 512 + lane * 8) = hv; }
    asm volatile("s_waitcnt lgkmcnt(0)" ::: "memory");
    const float om = R.om;
    {
        const _Float16 omb = (_Float16)(-om), omk = (_Float16)(om * 16.0f);
        _Float16 bvv[16], kvv[16];
#pragma unroll
        for (int i = 0; i < 16; ++i) { bvv[i] = *(const LAS _Float16*)(tBH + i * MS_TROW + k * 2); kvv[i] = *(const LAS _Float16*)(tKH + i * MS_TROW + k * 2); }
        asm volatile("" ::: "memory");
#pragma unroll
        for (int qq = 0; qq < 4; ++qq) { half8 h;
#pragma unroll
            for (int e = 0; e < 4; ++e) { h[e] = bvv[4 * qq + e] * omb; h[4 + e] = kvv[4 * qq + e] * omk; }
            *(LAS half8*)(img + MS_A5 + ((k >> 4) * 64 + qq * 16 + (k & 15)) * 16) = h; }
    }
    *(LAS float*)(img + MS_OM + (((k >> 2) & 3) * 16 + (k >> 4) * 4 + (k & 3)) * 4) = om;
    asm volatile("s_waitcnt lgkmcnt(0)" ::: "memory");
}

struct MsOps { half8 uk0, uk1, uw0, uw1, a3, a4, a5[4]; half4 vb; f32x4 om[4]; };
__device__ __forceinline__ void mscan_ops_load(const LAS unsigned char* I, int rg, int lane, MsOps& o) {
    const int r = lane & 15, q = lane >> 4;
#define MS_UFRAG(T_, s_) ({ const half4 lo_ = *(const LAS half4*)(I + (T_) + r * MS_TROW + (32 * (s_) + 4 * q) * 2), hi_ = *(const LAS half4*)(I + (T_) + r * MS_TROW + (32 * (s_) + 16 + 4 * q) * 2); \
        half8 h_; h_[0] = lo_[0]; h_[1] = lo_[1]; h_[2] = lo_[2]; h_[3] = lo_[3]; h_[4] = hi_[0]; h_[5] = hi_[1]; h_[6] = hi_[2]; h_[7] = hi_[3]; h_; })
    o.uk0 = MS_UFRAG(MS_UK, 0); o.uk1 = MS_UFRAG(MS_UK, 1); o.uw0 = MS_UFRAG(MS_UW, 0); o.uw1 = MS_UFRAG(MS_UW, 1);
    o.vb = *(const LAS half4*)(I + MS_VB + rg * 512 + lane * 8);
    o.a3 = *(const LAS half8*)(I + MS_A3 + lane * 16); o.a4 = *(const LAS half8*)(I + MS_A4 + lane * 16);
#pragma unroll
    for (int kb = 0; kb < 4; ++kb) { o.a5[kb] = *(const LAS half8*)(I + MS_A5 + (kb * 64 + lane) * 16); o.om[kb] = *(const LAS f32x4*)(I + MS_OM + (q * 16 + kb * 4) * 4); }
}
__device__ __forceinline__ void mscan_unit(const Params& P, int layer, int hb, LAS unsigned char* lds, int wid, int lane) {
    unsigned char* ws = P.ws;
    const int r = lane & 15, q = lane >> 4;
    const int rg = wid & 3;
    f32x4 Sacc[4];
#pragma unroll
    for (int kb = 0; kb < 4; ++kb) Sacc[kb] = (f32x4){0.f, 0.f, 0.f, 0.f};
    float* oraw = (float*)(ws + WS_ORAW) + ((size_t)(hb >> 2) * SEQ) * 256 + (hb & 3) * 64 + 16 * rg + r;
    const bool builder = wid >= 4;
    const int bw = wid - 4;
    constexpr int NR = SEQ / 64;
    MsRegs R;
    if (builder) { mscan_load(ws, hb, bw, lane, R); mscan_build(R, lds + bw * MS_IMG, lds + MS_SCR0 + bw * MS_SCR, lane); mscan_load(ws, hb, 4 + bw, lane, R); }
    __syncthreads();
    for (int rd = 0; rd < SEQ / 64; ++rd) {
        if (builder) { if (rd + 1 < NR) { mscan_build(R, lds + (((rd + 1) & 1) * 4 + bw) * MS_IMG, lds + MS_SCR0 + bw * MS_SCR, lane);
                                             if (rd + 2 < NR) mscan_load(ws, hb, 4 * (rd + 2) + bw, lane, R); } }
        else {
            __builtin_amdgcn_s_setprio(2);
            MsOps cur, nxt;
            mscan_ops_load(lds + ((rd & 1) * 4) * MS_IMG, rg, lane, cur);
#pragma unroll
            for (int cc = 0; cc < 4; ++cc) {
                if (cc < 3) mscan_ops_load(lds + ((rd & 1) * 4 + cc + 1) * MS_IMG, rg, lane, nxt);
                asm volatile("" ::: "memory");
                const half8 bS0 = pack_h8(Sacc[0], Sacc[1]), bS1 = pack_h8(Sacc[2], Sacc[3]);
                f32x4 DT = {0.f, 0.f, 0.f, 0.f}, ET = DT;
                DT = MFMA16H(cur.uk0, bS0, DT); DT = MFMA16H(cur.uk1, bS1, DT);
                ET = MFMA16H(cur.uw0, bS0, ET); ET = MFMA16H(cur.uw1, bS1, ET);
                f32x4 SA = {0.f, 0.f, 0.f, 0.f};
                SA = MFMA16H(cur.a3, pack_h8v(DT, cur.vb), SA);
                const half8 b3 = pack_h8v(SA, cur.vb);
                const f32x4 OT = MFMA16H(cur.a4, b3, ET);
                float* op = oraw + ((size_t)(rd * 4 + cc) * 16 + 4 * q) * 256;
#pragma unroll
                for (int reg = 0; reg < 4; ++reg) op[(size_t)reg * 256] = OT[reg];
#pragma unroll
                for (int kb = 0; kb < 4; ++kb) Sacc[kb] = MFMA16H(cur.a5[kb], b3, Sacc[kb] * cur.om[kb]);
                if (cc < 3) cur = nxt;
            }
            __builtin_amdgcn_s_setprio(0);
        }
        __syncthreads();
    }
    if (!builder) {
        float* so = P.out + O_WKP + (((size_t)layer * 64 + hb) * 64 + 16 * rg + r) * 64;
#pragma unroll
        for (int kb = 0; kb < 4; ++kb) *(f32x4*)(so + 16 * kb + 4 * q) = Sacc[kb];
    }
}

__device__ __forceinline__ void post_token4(const Params& P, int layer, int r0, int rstride, int lane, const f32x4 lg, const f32x4 lb, bool dry = false) {
    unsigned char* ws = P.ws;
    const int c0 = 4 * lane, hh = lane >> 4, l16 = lane & 15;
    f32x4 o[4]; float rkr[4]; u32x4 pv[4]; u32x2 gt[4];
#pragma unroll
    for (int j = 0; j < 4; ++j) { const int r = r0 + j * rstride, b = r >> 11, t = r & (SEQ - 1);
        o[j] = *((const f32x4*)(ws + WS_ORAW) + (size_t)r * 64 + lane);
        rkr[j] = ((const float*)(ws + WS_RKR))[(size_t)r * 4 + hh];
        pv[j] = *((const u32x4*)(ws + WS_PV) + ((size_t)(b * 4 + hh) * SEQ + t) * 16 + l16);
        gt[j] = *(const u32x2*)((bf16_t*)(ws + WS_GM) + (size_t)r * 1024 + 768 + c0); }
#pragma unroll
    for (int j = 0; j < 4; ++j) { const int r = r0 + j * rstride;
        const f32x4 oo = o[j];
        const float mean = sum16d((oo[0] + oo[1]) + (oo[2] + oo[3])) * (1.0f / 64.0f);
        const f32x4 d = oo - mean;
        const float var = sum16d((d[0] * d[0] + d[1] * d[1]) + (d[2] * d[2] + d[3] * d[3])) * (1.0f / 64.0f);
        const float rstd = __builtin_amdgcn_rsqf(var + 64e-5f);
        const u32x4 pw = pv[j]; const unsigned pv0 = pw[0], pv1 = pw[1], pv2 = pw[2], pv3 = pw[3];
        const float v[4] = {(float)as_h2(pv0).x, (float)as_h2(pv1).x, (float)as_h2(pv2).x, (float)as_h2(pv3).x};
        const u32x2 gq = gt[j]; const unsigned g0 = gq.x, g1 = gq.y;
        const float g[4] = {bf_lo(g0), bf_hi(g0), bf_lo(g1), bf_hi(g1)};
        float y[4];
#pragma unroll
        for (int i = 0; i < 4; ++i) y[i] = (d[i] * rstd * lg[i] + lb[i] + rkr[j] * v[i]) * g[i];
        *(u32x2*)((bf16_t*)(ws + WS_GM) + (size_t)r * 1024 + 768 + c0) = dry ? gq : (u32x2){pk_bf16(y[0], y[1]), pk_bf16(y[2], y[3])}; }
}

#define XB_TMO      128
#define XB_XCNT(j)  (256  + 64 * (j))
#define XB_XSUB(j)  (1280 + 64 * (j))
#define XB_XGEN(j)  (2304 + 64 * (j))
#define XB_TOP      3328
#define XB_TOPGEN   3392
#define XCD_BAR_WORDS 3456
#define XB_SPIN_CAP (1u << 18)

__device__ __forceinline__ unsigned xb_ld(unsigned* p)              { return __hip_atomic_load(p, __ATOMIC_RELAXED, __HIP_MEMORY_SCOPE_AGENT); }
__device__ __forceinline__ unsigned xb_add(unsigned* p, unsigned v) { return __hip_atomic_fetch_add(p, v, __ATOMIC_RELAXED, __HIP_MEMORY_SCOPE_AGENT); }
__device__ __forceinline__ unsigned xb_xcc_id() { return (unsigned)__builtin_amdgcn_s_getreg((3 << 11) | 20) & 0xFu; }
#define XB_SPIN(cond, bar) do { unsigned _sp = 0; while (cond) { __builtin_amdgcn_s_sleep(1); \
    if ((++_sp & 255u) == 0u) { if (xb_ld(&(bar)[XB_TMO])) break; if (_sp > XB_SPIN_CAP) { atomicAdd(&(bar)[XB_TMO], 1u); break; } } } } while (0)

struct XcdBarrier {
    unsigned* bar; unsigned x;
    volatile LAS unsigned* st;
};

__device__ __forceinline__ XcdBarrier xcd_barrier_post(unsigned* bar, volatile LAS unsigned* st) {
    XcdBarrier b; b.bar = bar; b.x = xb_xcc_id(); b.st = st;
    if (threadIdx.x == 0) (void)xb_add(&bar[XB_XCNT(b.x)], 1u);
    return b;
}
__device__ __forceinline__ void xcd_barrier_complete(unsigned* bar, unsigned x, unsigned& nloc, unsigned& nx) {
    const unsigned G = gridDim.x * gridDim.y * gridDim.z;
    unsigned sum, cnt, mine, sp = 0u;
    for (;;) {
        sum = 0u; cnt = 0u; mine = 0u;
#pragma unroll
        for (unsigned j = 0; j < 16; ++j) { const unsigned c = xb_ld(&bar[XB_XCNT(j)]); sum += c; cnt += (c > 0u) ? 1u : 0u; mine = (j == x) ? c : mine; }
        if (sum == G) break;
        __builtin_amdgcn_s_sleep(1);
        if ((++sp & 255u) == 0u) { if (xb_ld(&bar[XB_TMO])) break; if (sp > XB_SPIN_CAP) { atomicAdd(&bar[XB_TMO], 1u); break; } }
    }
    nloc = mine > 0u ? mine : 1u; nx = cnt > 0u ? cnt : 1u;
}

__device__ __forceinline__ void xcd_barrier(const XcdBarrier& b) {
    asm volatile("s_waitcnt vmcnt(0)" ::: "memory");
    __syncthreads();
    if (threadIdx.x == 0) {
        unsigned* bar = b.bar;
        __builtin_amdgcn_s_waitcnt(0);
        unsigned nloc = b.st[0], nx = b.st[1];
        if (nloc == 0u) { xcd_barrier_complete(bar, b.x, nloc, nx); b.st[0] = nloc; b.st[1] = nx; }
        const unsigned old = xb_add(&bar[XB_XSUB(b.x)], 1u);
        const unsigned gen = old / nloc;
        if (old + 1u == (gen + 1u) * nloc) {
            __builtin_amdgcn_fence(__ATOMIC_RELEASE, "agent");
            asm volatile("s_waitcnt vmcnt(0)" ::: "memory");
            const unsigned og = xb_add(&bar[XB_TOP], 1u);
            const unsigned tg = og / nx;
            if (og + 1u == (tg + 1u) * nx) xb_add(&bar[XB_TOPGEN], 1u);
            else XB_SPIN(xb_ld(&bar[XB_TOPGEN]) == tg, bar);
            __builtin_amdgcn_fence(__ATOMIC_ACQUIRE, "agent");
            xb_add(&bar[XB_XGEN(b.x)], 1u);
            asm volatile("s_waitcnt vmcnt(0)" ::: "memory");
        } else {
            XB_SPIN(xb_ld(&bar[XB_XGEN(b.x)]) == gen, bar);
            __builtin_amdgcn_fence(__ATOMIC_ACQUIRE, "agent");
            asm volatile("s_waitcnt vmcnt(0)" ::: "memory");
        }
    }
    __syncthreads();
}

constexpr int LDS_BYTES = 147456;
constexpr int NPHASE = 11;
template <bool IS_IN>
struct SkinnyPre { const Params& P; int layer, bx, G, wid, lane;
    __device__ __forceinline__ void operator()() const { for (int u = bx; u < (IS_IN ? NPAD / 16 : DM / 16); u += G) skinny_unit<IS_IN>(P, layer, u, wid, lane); } };
#ifndef CODE_PF
#define CODE_PF 0
#endif
__device__ __forceinline__ void code_prefetch(unsigned long long pc0, int tid) {
    const volatile __attribute__((address_space(1))) unsigned* p = (const volatile __attribute__((address_space(1))) unsigned*)(pc0 + (unsigned long long)tid * 64ull);
    unsigned s_ = 0;
#pragma unroll
    for (int k = 0; k < 5; ++k) if (k * 512 + tid < 2240) s_ += p[k * 8192];
    asm volatile("" :: "v"(s_));
}
__global__ void __launch_bounds__(512, 2) hymba_fwd(Params P) {
    extern __shared__ __attribute__((aligned(16))) unsigned char lds_raw[];
    LAS unsigned char* lds = (LAS unsigned char*)lds_raw;
    cg::grid_group grid = cg::this_grid();
    unsigned long long pc0; asm volatile("s_getpc_b64 %0" : "=s"(pc0));
    if (CODE_PF & 1) code_prefetch(pc0, threadIdx.x);
    {
        volatile LAS unsigned* st = (volatile LAS unsigned*)(lds + 147392);
        if (threadIdx.x == 0) { st[0] = 0u; st[1] = 0u; st[2] = 0u; st[3] = 0u; }
        __syncthreads();
    }
#if INKERNEL_BAR_ZERO
    const XcdBarrier xbar = {(unsigned*)(P.ws + WS_CTL) + 4096, xb_xcc_id(), (volatile LAS unsigned*)(lds + 147392)};
    static_assert(XCD_BAR_WORDS <= 3584, "the prologue zeroes 3584 barrier words");
#else
    const XcdBarrier xbar = xcd_barrier_post((unsigned*)(P.ws + WS_CTL) + 4096, (volatile LAS unsigned*)(lds + 147392));
#endif
    const int G = gridDim.x, bx = blockIdx.x;
#define FRESH_IDS int tid = threadIdx.x; asm volatile("" : "+v"(tid)); const int lane = tid & 63; const int wid = __builtin_amdgcn_readfirstlane(tid >> 6); (void)lane; (void)wid; if (CODE_PF & 2) code_prefetch(pc0, tid);
    unsigned char* ws = P.ws;
    const int lo = P.ph_lo, hi = P.ph_hi;
#define IN(k) (lo <= (k) && (k) < hi)
#ifdef DBG_TS
#define TSTAMP(k) do { if (bx == 0 && threadIdx.x == 0) ((unsigned long long*)(ws + WS_CTL + 4096))[(k)] = __builtin_amdgcn_s_memrealtime(); } while (0)
#else
#define TSTAMP(k) do {} while (0)
#endif
#define SYNC_AFTER(k) do { if (IN(k) && IN((k) + 1)) { if ((k) == 0 && USE_CG_SYNC) grid.sync(); else xcd_barrier(xbar); if (DBG_DOUBLE & 8) xcd_barrier(xbar); } TSTAMP((k) + 1); } while (0)
    TSTAMP(0);
#ifndef SKIP_P0
    if (IN(0)) { FRESH_IDS for (int rep = 0; rep < ((DBG_DOUBLE & 32) ? 2 : 1); ++rep) p0_prologue(P, lds, G, tid, wid, lane); }
#endif
    SYNC_AFTER(0);
#if INKERNEL_BAR_ZERO
    if (threadIdx.x == 0) (void)xb_add(&xbar.bar[XB_XCNT(xbar.x)], 1u);
#endif
    for (int layer = 0; layer < NLAYER; ++layer) {
        const int pb = 1 + 5 * layer;
        if (IN(pb)) {
            FRESH_IDS
            pg8::Gemm g{(const pg8::bf16_t*)(ws + WS_XB), (const pg8::bf16_t*)(ws + WS_WIN) + (size_t)layer * NPAD * DM, MP, NPAD, DM};
            pg8::StaticOrder S; S.init(MP, NPAD, G, bx);
            EpiIn E; E.ws = ws; E.out = P.out; E.qg = PRM(PRM_QG) + layer * 64; E.kg = PRM(PRM_KG) + layer * 64; E.layer = layer;
#ifndef SKIP_G1
            for (int rep = 0; rep < ((DBG_DOUBLE & 1) ? 2 : 1); ++rep) pg8::gemm_phase<EpiIn, pg8::StaticOrder, false, SkinnyPre<true>>((PG8_LAS unsigned char*)lds, g, S, E, nullptr, SkinnyPre<true>{P, layer, bx, G, wid, lane});
#endif
        }
        SYNC_AFTER(pb);
        if (IN(pb + 1)) {
            FRESH_IDS
#ifndef SKIP_PL
            for (int rep = ((DBG_DOUBLE & 256) ? 0 : 1); rep < 2; ++rep) for (int u = bx; u < 256; u += G) pool_unit(P, layer, u, lds, wid, lane, rep == 0);
#endif
            __syncthreads();
#ifndef SKIP_PR
            for (int rep = 0; rep < ((DBG_DOUBLE & 16) ? 2 : 1); ++rep) for (int r0 = (bx * 8 + wid) * 16; r0 < MP; r0 += G * 8 * 16) prep_run(P, layer, r0, lane, lds + wid * 16384);
#endif
        }
        SYNC_AFTER(pb + 1);
        if (IN(pb + 2)) {
            FRESH_IDS
            const int NSC = G >= 128 ? 64 : 0;
            if (bx < NSC || NSC == 0) {
#ifndef SKIP_SC
                for (int rep = 0; rep < ((DBG_DOUBLE & 2) ? 2 : 1); ++rep) for (int u = bx; u < 64; u += (NSC ? NSC : G)) { const int hb = ((u & 7) * 8 + (u >> 3)); mscan_unit(P, layer, hb, lds, wid, lane); __syncthreads(); }
#endif
            }
            if (bx >= NSC) {
                const int j = bx - NSC, NW = G - NSC;
#ifndef SKIP_DM
                for (int rep = 0; rep < ((DBG_DOUBLE & 4) ? 2 : 1); ++rep)
                    for (int i = 0; i * NW < 2 * MS; ++i) {
                        const int c = (2 * MS - i * NW) < NW ? (2 * MS - i * NW) : NW, jj = j - (NW - c);
                        if (jj >= 0) { const int u = i * NW + (i == 0 ? jj : (jj ^ 1)); decode_mix(P, layer, u >> 1, u & 1, lds, tid, wid, lane); }
                    }
#endif
                __syncthreads();
#ifndef SKIP_AT
                constexpr int ATT_LDS = 71680;
                for (int rep = ((DBG_DOUBLE & 128) ? 0 : 1); rep < 2; ++rep)
                    for (int u = j; u < 512; u += 2 * NW) {
                        attn_unit<true, false>(P, layer, u, lds, lds + 2 * ATT_LDS, tid, wid, lane);
                        if (u + NW < 512) attn_unit<true, false>(P, layer, u + NW, lds + ATT_LDS, lds + 2 * ATT_LDS, tid, wid, lane);
                        __syncthreads();
                        attn_unit<false, true>(P, layer, u, lds, lds + 2 * ATT_LDS, tid, wid, lane, rep == 0);
                        if (u + NW < 512) attn_unit<false, true>(P, layer, u + NW, lds + ATT_LDS, lds + 2 * ATT_LDS, tid, wid, lane, rep == 0);
                        __syncthreads();
                    }
#endif
            }
        }
        SYNC_AFTER(pb + 2);
        if (IN(pb + 3)) {
            FRESH_IDS
#ifndef SKIP_PO
            { const f32x4 lg = *(const f32x4*)(PRM(PRM_LNG) + layer * 256 + 4 * lane), lb = *(const f32x4*)(PRM(PRM_LNB) + layer * 256 + 4 * lane);
              for (int rep = ((DBG_DOUBLE & 512) ? 0 : 1); rep < 2; ++rep) for (int r = bx * 8 + wid; r < MP; r += 4 * G * 8) post_token4(P, layer, r, G * 8, lane, lg, lb, rep == 0); }
#endif
        }
        SYNC_AFTER(pb + 3);
        if (IN(pb + 4)) {
            FRESH_IDS
            pg8::Gemm g{(const pg8::bf16_t*)(ws + WS_GM), (const pg8::bf16_t*)(ws + WS_WOUT) + (size_t)layer * DM * DM, MP, DM, DM};
            pg8::StaticOrder S; S.init(MP, DM, G, bx);
            EpiOut E; E.resid = INP(0); E.out = P.out + O_YP; E.XB = (bf16_t*)(ws + WS_XB); E.RS = (float*)(ws + WS_RS) + MP; E.layer = layer;
#ifndef SKIP_G2
            for (int rep = 0; rep < (((DBG_DOUBLE & 64) && layer == 0) ? 2 : 1); ++rep) pg8::gemm_phase<EpiOut, pg8::StaticOrder, false, SkinnyPre<false>>((PG8_LAS unsigned char*)lds, g, S, E, nullptr, SkinnyPre<false>{P, layer, bx, G, wid, lane});
#endif
        }
        if (layer + 1 < NLAYER) SYNC_AFTER(pb + 4);
    }
#ifdef DBG_TS
    TSTAMP(NPHASE);
    if (bx == 0 && threadIdx.x == 0) { const unsigned long long* ts = (const unsigned long long*)(ws + WS_CTL + 4096);
        P.out[O_YS] = (float)(ts[DBG_TS + 1] - ts[DBG_TS]) * (DBG_TS_SCALE); }
#endif
#undef IN
#undef SYNC_AFTER
}

#ifdef DBG_MASK
__global__ void dbg_scale(float* out) {
    const size_t G = gridDim.x, bx = blockIdx.x;
#define DBG_SCALE(o, lo_, hi_) if (((DBG_MASK | DBG_MASK2) >> (o)) & 1) { const float f_ = ((DBG_MASK >> (o)) & 1) ? DBG_FACTOR : DBG_FACTOR2; for (size_t i = (lo_) + bx * 256 + threadIdx.x; i < (hi_); i += G * 256) out[i] *= f_; }
    DBG_SCALE(0, O_YP, O_YS) DBG_SCALE(1, O_YS, O_POOLP) DBG_SCALE(2, O_POOLP, O_POOLS) DBG_SCALE(3, O_POOLS, O_KP) DBG_SCALE(4, O_KP, O_KS) DBG_SCALE(5, O_KS, O_VP)
    DBG_SCALE(6, O_VP, O_VS) DBG_SCALE(7, O_VS, O_SHP) DBG_SCALE(8, O_SHP, O_SHS) DBG_SCALE(9, O_SHS, O_WKP) DBG_SCALE(10, O_WKP, O_WKS) DBG_SCALE(11, O_WKS, O_END)
}
#endif
#if SCAN_IMPL == 2
__global__ void dbg_compare(float* out, const unsigned char* ws) {
    __shared__ float red[4][256];
    const int layer = DBG_CMP_SEL >> 1, tid = threadIdx.x;
    float md = 0.f, mr = 0.f;
    if ((DBG_CMP_SEL & 1) == 0) { const float* A_ = (const float*)(ws + WS_ORAW); const float* B_ = (const float*)(ws + WS_ORAW2);
        for (size_t i = tid; i < (size_t)MP * 256; i += 256 * 997) { const float a = A_[i], b = B_[i]; md = fmaxf(md, fabsf(a - b)); mr = fmaxf(mr, fabsf(a)); }
        for (size_t i = (size_t)tid * 4099; i < (size_t)MP * 256; i += (size_t)256 * 4099) { const float a = A_[i], b = B_[i]; md = fmaxf(md, fabsf(a - b)); mr = fmaxf(mr, fabsf(a)); } }
    else { const float* SA_ = out + O_WKP + (size_t)layer * 64 * 4096; const float* SB_ = (const float*)(ws + WS_ORAW2 + 32 * MiB) + (size_t)layer * 64 * 4096;
        for (size_t i = tid; i < (size_t)64 * 4096; i += 256) { const float a = SA_[i], b = SB_[i]; md = fmaxf(md, fabsf(a - b)); mr = fmaxf(mr, fabsf(a)); } }
    red[0][tid] = md; red[1][tid] = mr; __syncthreads();
    if (tid == 0) { for (int i = 1; i < 256; ++i) { md = fmaxf(md, red[0][i]); mr = fmaxf(mr, red[1][i]); }
        out[O_YS] = 1.0e4f * md / fmaxf(mr, 1e-20f); }
}
#endif
#ifndef MK_N_LAUNCHES
#define MK_N_LAUNCHES 1
#endif
extern "C" void kernel_launch(void* const* d_in, const int* in_sizes, int n_in, void* d_out, int out_size, void* d_ws, size_t ws_size, hipStream_t stream) {
    static int grid = 0;
    if (grid == 0) {
        if (n_in != 25 || out_size != (int)O_END || ws_size < WS_END) { fprintf(stderr, "kernel_launch: unexpected shapes: n_in %d out %d ws %zu\n", n_in, out_size, ws_size); grid = -1; return; }
        int dev = 0, cus = 0, per_cu = 0;
        if (hipGetDevice(&dev) != hipSuccess || hipDeviceGetAttribute(&cus, hipDeviceAttributeMultiprocessorCount, dev) != hipSuccess) { grid = -1; return; }
        if (hipFuncSetAttribute((const void*)hymba_fwd, hipFuncAttributeMaxDynamicSharedMemorySize, LDS_BYTES) != hipSuccess) { fprintf(stderr, "kernel_launch: hipFuncSetAttribute failed\n"); grid = -1; return; }
        if (hipOccupancyMaxActiveBlocksPerMultiprocessor(&per_cu, (const void*)hymba_fwd, 512, LDS_BYTES) != hipSuccess || per_cu < 1) { fprintf(stderr, "kernel_launch: occupancy query failed (%d)\n", per_cu); grid = -1; return; }
        grid = cus * 1;
    }
    if (grid < 0) return;
#if !INKERNEL_BAR_ZERO
    if (hipMemsetAsync((char*)d_ws + WS_CTL, 0, 65536, stream) != hipSuccess) { fprintf(stderr, "kernel_launch: memset of control words failed\n"); return; }
#endif
    Params p{};
    for (int i = 0; i < 25; ++i) p.in[i] = (const float*)d_in[i];
    p.out = (float*)d_out; p.ws = (unsigned char*)d_ws;
#if MK_N_LAUNCHES == 1
    p.ph_lo = 0; p.ph_hi = NPHASE;
    void* args[] = {&p};
    hipError_t e = hipLaunchCooperativeKernel((const void*)hymba_fwd, dim3(grid), dim3(512), args, LDS_BYTES, stream);
    if (e != hipSuccess) fprintf(stderr, "kernel_launch: cooperative launch failed: %s (grid %d)\n", hipGetErrorString(e), grid);
#if SCAN_IMPL == 2
    dbg_compare<<<1, 256, 0, stream>>>((float*)d_out, (const unsigned char*)d_ws);
#endif
#ifdef DBG_MASK
    dbg_scale<<<1024, 256, 0, stream>>>((float*)d_out);
#endif
#else
    for (int ph = 0; ph < NPHASE; ++ph) {
        p.ph_lo = ph; p.ph_hi = ph + 1;
        void* args[] = {&p};
        hipError_t e = hipLaunchCooperativeKernel((const void*)hymba_fwd, dim3(grid), dim3(512), args, LDS_BYTES, stream);
        if (e != hipSuccess) { fprintf(stderr, "kernel_launch: launch %d failed: %s\n", ph, hipGetErrorString(e)); break; }
    }
#endif
}
```

```cpp
#include <hip/hip_runtime.h>
#ifndef DBG_DOUBLE
#define DBG_DOUBLE 0
#endif
#ifndef SCAN_IMPL
#define SCAN_IMPL 1
#endif
#ifndef DBG_CMP_SEL
#define DBG_CMP_SEL 0
#endif
#ifndef USE_CG_SYNC
#define INKERNEL_BAR_ZERO 1
#define USE_CG_SYNC 1
#endif
#include <hip/hip_cooperative_groups.h>
#include <cstdio>
#include <cstdint>
namespace cg = cooperative_groups;
namespace pg8 {
#define PG8_LAS __attribute__((address_space(3)))
typedef unsigned short bf16_t;
typedef short bf16x8 __attribute__((ext_vector_type(8)));
typedef float f32x4 __attribute__((ext_vector_type(4)));
typedef unsigned u32x4 __attribute__((ext_vector_type(4)));
constexpr int BM = 256, BK = 64, HALF = 128, HTB = HALF * BK * 2  , STAGE_BYTES = 8 * HTB, NXCD = 8, WGM = 8;

__host__ __device__ __forceinline__ int lds_byte(int r, int c) { const int st = (r >> 4) * 2 + (c >> 5), rr = r & 15, cc = c & 31, ob = rr * 64 + cc * 2; return st * 1024 + (ob ^ (((ob >> 9) & 1) << 5)); }
__host__ __device__ __forceinline__ void stage_rc(int b, int& R, int& C) { const int st = b / 1024, sb = b % 1024, swz = sb ^ (((sb >> 9) & 1) << 5); R = (st >> 1) * 16 + swz / 64; C = (st & 1) * 32 + (swz % 64) / 2; }
__host__ __device__ __forceinline__ int perm32(int rho) { const int n = rho >> 4, i = rho & 15; return 8 * (i >> 2) + 4 * n + (i & 3); }

struct Unit { int pm, pn; };
struct Gemm { const bf16_t* A; const bf16_t* Bt; int M, N, K; };

struct StaticOrder {
    int nM, nN, nwg, G, c;
    __host__ __device__ void init(int M, int N, int G_, int c_) { nM = M / BM; nN = N / BM; nwg = nM * nN; G = G_; c = c_; }
    __host__ __device__ bool next(int i, Unit& u) const {
        const long L = (long)i * G + c; if (L >= nwg) return false;
        int wgid = (int)L; { const int q = nwg / NXCD, r = nwg % NXCD, xcd = wgid % NXCD, off = wgid / NXCD; wgid = (xcd < r ? xcd * (q + 1) : r * (q + 1) + (xcd - r) * q) + off; }
        const int nig = WGM * nN, gid = wgid / nig, fm = gid * WGM, gsz = (nM - fm) < WGM ? (nM - fm) : WGM;
        u.pm = fm + ((wgid % nig) % gsz); u.pn = (wgid % nig) / gsz; return true;
    }
    __device__ __forceinline__ void a_ready(const Unit&) const {}
    __device__ __forceinline__ void done(const Unit&) const {}
};

struct NoPre { __device__ __forceinline__ void operator()() const {} };
template <class Epi, class Sched, bool STAMP = false, class Pre = NoPre>
__device__ __forceinline__ void gemm_phase(PG8_LAS unsigned char* lds, const Gemm g, const Sched& S, const Epi& E, unsigned long long* stamps, const Pre& pre_hook = Pre()) {
    int tid = threadIdx.x; asm volatile("" : "+v"(tid));
    const int wid = __builtin_amdgcn_readfirstlane(tid >> 6), lane = tid & 63, wr = wid >> 2, wc = wid & 3, fr = lane & 15, fq = lane >> 4;
    const int K = g.K, nt = K / BK;
    int ts_lo = 0, ts_hi = 0, nts = 0; const unsigned long long rt_entry = STAMP ? (unsigned long long)wall_clock64() : 0ull;
#define PG8_STAMP() do { if (STAMP && wid == 0 && nts < 64) { const unsigned long long _c = (unsigned long long)clock64(); \
        ts_lo = (lane == nts) ? (int)(unsigned)_c : ts_lo; ts_hi = (lane == nts) ? (int)(unsigned)(_c >> 32) : ts_hi; ++nts; } } while (0)
    PG8_STAMP();
    unsigned voffA[2], voffB[2];
#pragma unroll
    for (int i = 0; i < 2; ++i) { int R, C; stage_rc(tid * 16 + i * 8192, R, C); const int Rb = Epi::PERM ? ((R & ~31) + perm32(R & 31)) : R;
        voffA[i] = (unsigned)(R * K + C) * 2u; voffB[i] = (unsigned)(Rb * K + C) * 2u; }
    const size_t kstep = (size_t)(BK * 2);
    const size_t hstep = (size_t)HALF * K * 2;
    const size_t tstep = 2 * hstep;
    const unsigned ldsw = (unsigned)wid * 1024u;
    const int aoff = lds_byte(wr * 64 + fr, fq * 8), boff = lds_byte(wc * 32 + fr, fq * 8);
#define PG8_SA(b, h) (((b) * 2 + (h)) * HTB)
#define PG8_SB(b, h) ((4 + (b) * 2 + (h)) * HTB)
#define PG8_STAGE(bufoff, gbase, voff) do { _Pragma("unroll") for (int _i = 0; _i < 2; ++_i) \
        __builtin_amdgcn_global_load_lds((const unsigned*)((const char*)(gbase) + (voff)[_i]), (PG8_LAS unsigned*)(lds + (bufoff) + ldsw + _i * 8192), 16, 0, 0); } while (0)
#define PG8_LDA(dst, b, h) do { _Pragma("unroll") for (int m = 0; m < 4; ++m) _Pragma("unroll") for (int k = 0; k < 2; ++k) dst[m][k] = *(const PG8_LAS bf16x8*)(lds + PG8_SA(b, h) + aoff + m * 2048 + k * 1024); } while (0)
#define PG8_LDB(dst, b, h) do { _Pragma("unroll") for (int n = 0; n < 2; ++n) _Pragma("unroll") for (int k = 0; k < 2; ++k) dst[n][k] = *(const PG8_LAS bf16x8*)(lds + PG8_SB(b, h) + boff + n * 2048 + k * 1024); } while (0)
#define PG8_MMA(ai, bj, At, Bt) do { __builtin_amdgcn_s_setprio(1); _Pragma("unroll") for (int m = 0; m < 4; ++m) _Pragma("unroll") for (int n = 0; n < 2; ++n) _Pragma("unroll") for (int k = 0; k < 2; ++k) \
        acc[ai][bj][m][n] = __builtin_amdgcn_mfma_f32_16x16x32_bf16(Bt[n][k], At[m][k], acc[ai][bj][m][n], 0, 0, 0); __builtin_amdgcn_s_setprio(0); } while (0)
#define PG8_WAIT_V(n) asm volatile("s_waitcnt vmcnt(" #n ")" ::: "memory")
#define PG8_WAIT_L(n) asm volatile("s_waitcnt lgkmcnt(" #n ")" ::: "memory")
#define PG8_BAR __builtin_amdgcn_s_barrier()
#define PG8_SCHED __builtin_amdgcn_sched_barrier(0)
    Unit cur, nxt; int ui = 0;
    if (!S.next(0, cur)) return;
    float pre[8] = {0.f, 0.f, 0.f, 0.f, 0.f, 0.f, 0.f, 0.f};
    f32x4 acc[2][2][4][2];
#pragma unroll
    for (int a = 0; a < 2; ++a)
#pragma unroll
        for (int b = 0; b < 2; ++b)
#pragma unroll
            for (int m = 0; m < 4; ++m)
#pragma unroll
                for (int n = 0; n < 2; ++n) acc[a][b][m][n] = (f32x4){0.f, 0.f, 0.f, 0.f};
    bf16x8 At[4][2], B0[2][2], B1[2][2];
    const char* cA = (const char*)g.A + (size_t)cur.pm * tstep; const char* cB = (const char*)g.Bt + (size_t)cur.pn * tstep;
    S.a_ready(cur);
    PG8_STAGE(PG8_SB(0, 0), cB, voffB); PG8_STAGE(PG8_SA(0, 0), cA, voffA); PG8_STAGE(PG8_SB(0, 1), cB + hstep, voffB); PG8_STAGE(PG8_SA(0, 1), cA + hstep, voffA);
    pre_hook();
    if (wr == 1) PG8_BAR;
    PG8_WAIT_V(4); PG8_BAR;
    PG8_STAGE(PG8_SB(1, 0), cB + kstep, voffB); PG8_STAGE(PG8_SA(1, 0), cA + kstep, voffA); PG8_STAGE(PG8_SB(1, 1), cB + hstep + kstep, voffB);
    PG8_WAIT_V(6); PG8_BAR;
    PG8_STAMP();
    for (;;) {
        const bool has_next = S.next(ui + 1, nxt);
        const char* nA = has_next ? (const char*)g.A + (size_t)nxt.pm * tstep : cA; const char* nB = has_next ? (const char*)g.Bt + (size_t)nxt.pn * tstep : cB;
        for (int t = 0; t < nt; t += 2) {
            const bool last = (t == nt - 2);
            const char* a1 = cA + (size_t)(t + 1) * kstep;
            const char* a2 = last ? nA : cA + (size_t)(t + 2) * kstep; const char* b2 = last ? nB : cB + (size_t)(t + 2) * kstep;
            const char* a3 = a2 + kstep; const char* b3 = b2 + kstep;
            if (last && has_next) S.a_ready(nxt);
            if (t == nt - 4) E.preload(cur, wr, fr, pre);
            PG8_LDB(B0, 0, 0); PG8_SCHED; PG8_LDA(At, 0, 0); PG8_STAGE(PG8_SA(1, 1), a1 + hstep, voffA);
            PG8_WAIT_L(8); PG8_BAR; PG8_WAIT_L(0); PG8_MMA(0, 0, At, B0); PG8_BAR; PG8_SCHED;
            PG8_LDB(B1, 0, 1); PG8_STAGE(PG8_SB(0, 0), b2, voffB);
            PG8_BAR; PG8_WAIT_L(0); PG8_MMA(0, 1, At, B1); PG8_BAR;
            PG8_LDA(At, 0, 1); PG8_STAGE(PG8_SA(0, 0), a2, voffA);
            PG8_BAR; PG8_WAIT_L(0); PG8_MMA(1, 0, At, B0); PG8_BAR; PG8_SCHED;
            PG8_STAGE(PG8_SB(0, 1), b2 + hstep, voffB);
            PG8_WAIT_V(6); PG8_BAR; PG8_MMA(1, 1, At, B1); PG8_BAR;
            PG8_LDB(B0, 1, 0); PG8_SCHED; PG8_LDA(At, 1, 0); PG8_STAGE(PG8_SA(0, 1), a2 + hstep, voffA);
            PG8_WAIT_L(8); PG8_BAR; PG8_WAIT_L(0); PG8_MMA(0, 0, At, B0); PG8_BAR; PG8_SCHED;
            PG8_LDB(B1, 1, 1); PG8_STAGE(PG8_SB(1, 0), b3, voffB);
            PG8_BAR; PG8_WAIT_L(0); PG8_MMA(0, 1, At, B1); PG8_BAR;
            PG8_LDA(At, 1, 1); PG8_STAGE(PG8_SA(1, 0), a3, voffA);
            PG8_BAR; PG8_WAIT_L(0); PG8_MMA(1, 0, At, B0); PG8_BAR; PG8_SCHED;
            PG8_STAGE(PG8_SB(1, 1), b3 + hstep, voffB);
            PG8_WAIT_V(6); PG8_BAR; PG8_MMA(1, 1, At, B1); PG8_BAR;
        }
        PG8_STAMP();
        if constexpr (!Epi::AFTER_DRAIN) { if ((DBG_DOUBLE & 2048) && Epi::IDEMPOTENT) E(acc, cur, wr, wc, fr, fq, pre); E(acc, cur, wr, wc, fr, fq, pre); S.done(cur); }
        PG8_STAMP();
        if (!has_next) break;
#pragma unroll
        for (int a = 0; a < 2; ++a)
#pragma unroll
            for (int b = 0; b < 2; ++b)
#pragma unroll
                for (int m = 0; m < 4; ++m)
#pragma unroll
                    for (int n = 0; n < 2; ++n) acc[a][b][m][n] = (f32x4){0.f, 0.f, 0.f, 0.f};
        cur = nxt; cA = nA; cB = nB; ++ui;
    }
    PG8_WAIT_V(0);
    if (wr == 0) PG8_BAR;
    PG8_BAR;
    if constexpr (Epi::AFTER_DRAIN) { E.fused(acc, cur, wr, wc, fr, fq, lds, wid, lane); S.done(cur); }
    PG8_STAMP();
    if (STAMP && wid == 0) { stamps[lane] = lane < nts ? (((unsigned long long)(unsigned)ts_hi << 32) | (unsigned)ts_lo) : 0ull;
        if (lane == 62) stamps[62] = rt_entry; if (lane == 63) stamps[63] = (unsigned long long)wall_clock64(); }
#undef PG8_STAMP
#undef PG8_SA
#undef PG8_SB
#undef PG8_STAGE
#undef PG8_LDA
#undef PG8_LDB
#undef PG8_MMA
#undef PG8_WAIT_V
#undef PG8_WAIT_L
#undef PG8_BAR
#undef PG8_SCHED
}
}

#define LAS __attribute__((address_space(3)))
typedef unsigned short bf16_t;
typedef short bf16x8 __attribute__((ext_vector_type(8)));
typedef float f32x2 __attribute__((ext_vector_type(2)));
typedef float f32x4 __attribute__((ext_vector_type(4)));
typedef float f32x16 __attribute__((ext_vector_type(16)));
typedef unsigned u32x2 __attribute__((ext_vector_type(2)));
typedef unsigned u32x4 __attribute__((ext_vector_type(4)));
typedef __bf16 bf2_t __attribute__((ext_vector_type(2)));
typedef _Float16 h2_t __attribute__((ext_vector_type(2)));

constexpr int DM = 1024, NB = 16, SEQ = 2048, MP = NB * SEQ, MS = 128, DIN = 2880, NPAD = 3072;
constexpr int DSH = 832, NLAYER = 2;
constexpr float LOG2E = 1.4426950408889634f;
constexpr float QSCALE = 0.125f * LOG2E;
constexpr size_t O_YP = 0, O_YS = 33554432, O_POOLP = 33685504, O_POOLS = 33808384, O_KP = 34791424, O_KS = 35315712,
                 O_VP = 39510016, O_VS = 40034304, O_SHP = 44228608, O_SHS = 44255232, O_WKP = 44468224, O_WKS = 44992512, O_END = 49186816;
constexpr size_t MiB = 1u << 20;
constexpr size_t WS_CTL = 0;
constexpr size_t WS_WIN = 1 * MiB;
constexpr size_t WS_WOUT = 13 * MiB;
constexpr size_t WS_ROPE = 17 * MiB;
constexpr size_t WS_XBS = 18 * MiB;
constexpr size_t WS_RSS = 18 * MiB + 512 * 1024;
constexpr size_t WS_MIXS = 19 * MiB;
constexpr size_t WS_ZS = 20 * MiB;
constexpr size_t WS_RS = 22 * MiB;
constexpr size_t WS_RKR = 24 * MiB;
constexpr size_t WS_KRA = 24 * MiB + 512 * 1024;
constexpr size_t WS_PRM = 25 * MiB;
constexpr int PRM_POOLW = 0, PRM_POOLSC = 32768, PRM_QG = 33280, PRM_KG = 33408, PRM_SINK = 33536, PRM_MU = 33552, PRM_W0 = 35216, PRM_WUP = 35728,
              PRM_A0 = 52112, PRM_AUP = 52624, PRM_KK = 69008, PRM_KA = 69520, PRM_RK = 70032, PRM_LNG = 70544, PRM_LNB = 71056, PRM_END = 71568;
constexpr size_t WS_POOLF = WS_PRM + 640 * 1024;
constexpr size_t WS_WUPF = WS_PRM + 512 * 1024;
#define PRM(off) ((const float*)(ws + WS_PRM) + (off))
__device__ __forceinline__ const float* inp_ptr(const unsigned char* ws, int k) {
    const unsigned long long v = ((const unsigned long long*)(ws + (size_t)32768))[k];
    const unsigned lo = __builtin_amdgcn_readfirstlane((unsigned)v), hi = __builtin_amdgcn_readfirstlane((unsigned)(v >> 32));
    return (const float*)(((unsigned long long)hi << 32) | lo);
}
#define INP(k) inp_ptr(ws, (k))
constexpr size_t WS_XB = 32 * MiB;
constexpr size_t WS_U = 96 * MiB;
constexpr size_t WS_Q = 112 * MiB;
constexpr size_t WS_K = 144 * MiB;
constexpr size_t WS_VT = 152 * MiB;
constexpr size_t WS_RIN = 160 * MiB;
constexpr size_t WS_GM = 216 * MiB;
constexpr size_t WS_PA = 280 * MiB;
constexpr size_t WS_PW = 344 * MiB;
constexpr size_t WS_PV = 376 * MiB;
constexpr size_t WS_ORAW = 408 * MiB;
constexpr size_t WS_PO = 28 * MiB;
#if SCAN_IMPL == 2
constexpr size_t WS_PB = 32 * MiB;
#else
constexpr size_t WS_PB = 280 * MiB;
#endif
constexpr size_t WS_ORAW2 = 440 * MiB;
constexpr size_t WS_END = 476 * MiB;

struct Params {
    const float* in[25];
    float* out;
    unsigned char* ws;
    int ph_lo, ph_hi;
};

__device__ __forceinline__ unsigned pk_bf16(float lo, float hi) { f32x2 v = {lo, hi}; bf2_t b = __builtin_convertvector(v, bf2_t); return __builtin_bit_cast(unsigned, b); }
__device__ __forceinline__ h2_t as_h2(unsigned u) { return __builtin_bit_cast(h2_t, u); }
__device__ __forceinline__ unsigned pk_f16(float lo, float hi) { h2_t h = {(_Float16)lo, (_Float16)hi}; return __builtin_bit_cast(unsigned, h); }
__device__ __forceinline__ float bf_lo(unsigned u) { return __uint_as_float(u << 16); }
__device__ __forceinline__ float bf_hi(unsigned u) { return __uint_as_float(u & 0xffff0000u); }
__device__ __forceinline__ float bf1(bf16_t b) { return __uint_as_float(((unsigned)b) << 16); }
__device__ __forceinline__ bf16_t f2bf(float f) { return (bf16_t)(pk_bf16(f, 0.f) & 0xffffu); }
__device__ __forceinline__ float fast_exp(float x) { return __builtin_amdgcn_exp2f(x * LOG2E); }
__device__ __forceinline__ float sigmoidf_(float x) { return __builtin_amdgcn_rcpf(1.0f + fast_exp(-x)); }
__device__ __forceinline__ float siluf_(float x) { return x * sigmoidf_(x); }
#define DPPF(z, CTRL) __builtin_bit_cast(float, __builtin_amdgcn_update_dpp(0, __builtin_bit_cast(int, (z)), (CTRL), 0xf, 0xf, true))
__device__ __forceinline__ float wave_sum(float v) {
    v += DPPF(v, 0xB1); v += DPPF(v, 0x4E); v += DPPF(v, 0x124); v += DPPF(v, 0x128);
    { const auto sw = __builtin_amdgcn_permlane16_swap(__float_as_uint(v), __float_as_uint(v), false, false); v = __uint_as_float(sw[0]) + __uint_as_float(sw[1]); }
    { const auto sw = __builtin_amdgcn_permlane32_swap(__float_as_uint(v), __float_as_uint(v), false, false); v = __uint_as_float(sw[0]) + __uint_as_float(sw[1]); }
    return v;
}
__device__ __forceinline__ float wave_max(float v) {
    v = fmaxf(v, DPPF(v, 0xB1)); v = fmaxf(v, DPPF(v, 0x4E)); v = fmaxf(v, DPPF(v, 0x124)); v = fmaxf(v, DPPF(v, 0x128));
    { const auto sw = __builtin_amdgcn_permlane16_swap(__float_as_uint(v), __float_as_uint(v), false, false); v = fmaxf(__uint_as_float(sw[0]), __uint_as_float(sw[1])); }
    { const auto sw = __builtin_amdgcn_permlane32_swap(__float_as_uint(v), __float_as_uint(v), false, false); v = fmaxf(__uint_as_float(sw[0]), __uint_as_float(sw[1])); }
    return v;
}
__device__ __forceinline__ float sum_x16_x32(float v) {
    { const auto sw = __builtin_amdgcn_permlane16_swap(__float_as_uint(v), __float_as_uint(v), false, false); v = __uint_as_float(sw[0]) + __uint_as_float(sw[1]); }
    { const auto sw = __builtin_amdgcn_permlane32_swap(__float_as_uint(v), __float_as_uint(v), false, false); v = __uint_as_float(sw[0]) + __uint_as_float(sw[1]); }
    return v;
}
__device__ __forceinline__ float sum16(float v) {
    v += __shfl_xor(v, 1); v += __shfl_xor(v, 2); v += __shfl_xor(v, 4); v += __shfl_xor(v, 8); return v;
}
#define DPPX(z, CTRL) __builtin_bit_cast(float, __builtin_amdgcn_update_dpp(0, __builtin_bit_cast(int, (z)), (CTRL), 0xf, 0xf, true))
__device__ __forceinline__ float sum16d(float v) {
    v += DPPX(v, 0xB1); v += DPPX(v, 0x4E); v += DPPX(v, 0x124); v += DPPX(v, 0x128); return v;
}
__device__ __forceinline__ void store8_bf16(bf16_t* p, f32x4 a, f32x4 b) {
    u32x4 w; w.x = pk_bf16(a[0], a[1]); w.y = pk_bf16(a[2], a[3]); w.z = pk_bf16(b[0], b[1]); w.w = pk_bf16(b[2], b[3]);
    *(u32x4*)p = w;
}

__host__ __device__ __forceinline__ int src_col_in(int n) {
    const int pn = n >> 8, p = n & 255, bj = p >> 7, wc = (p >> 5) & 3, j = p & 31, nn = j >> 4, fq = (j >> 2) & 3, e = j & 3;
    const int i8 = 8 * fq + 4 * nn + e;
    const int gen = 128 * bj + 32 * wc + i8;
    const int hd = 64 * wc + 32 * bj + i8;
    switch (pn) {
        case 0: return gen;
        case 1: return 256 + gen;
        case 2: return 512 + hd;
        case 3: return 768 + hd;
        case 4: return 1024 + hd;
        case 5: return 1280 + gen;
        case 6: return 1536 + gen;
        case 7: return 1792 + gen;
        case 8: return 2048 + gen;
        case 9: return 2304 + gen;
        case 10: return 2624 + gen;
        default: return gen < 64 ? 2560 + gen : -1;
    }
}
__host__ __device__ __forceinline__ int src_col_out(int n) {
    const int pn = n >> 8, p = n & 255, bj = p >> 7, wc = (p >> 5) & 3, j = p & 31, nn = j >> 4, fq = (j >> 2) & 3, e = j & 3;
    return pn * 256 + 128 * bj + 32 * wc + 8 * fq + 4 * nn + e;
}

struct EpiIn {
    static constexpr bool PERM = false, AFTER_DRAIN = false, IDEMPOTENT = true;
    unsigned char* ws; float* out; const float* qg; const float* kg; int layer;
    __device__ __forceinline__ void preload(const pg8::Unit& u, int wr, int fr, float (&pre)[8]) const {
        const float* RS = (const float*)(ws + WS_RS) + (size_t)layer * MP + u.pm * 256 + wr * 64 + fr;
#pragma unroll
        for (int g = 0; g < 8; ++g) pre[g] = RS[(g >> 2) * 128 + (g & 3) * 16];
    }
    template <int KIND>
    __device__ __forceinline__ void body(const f32x4 (&acc)[2][2][4][2], const pg8::Unit& u, int wr, int wc, int fr, int fq, const float (&pre)[8]) const {
        const int pn = u.pn;
        const int row0 = u.pm * 256 + wr * 64 + fr;
        const int i8 = 8 * fq;
        float rsv[2][4];
#pragma unroll
        for (int ai = 0; ai < 2; ++ai)
#pragma unroll
            for (int m = 0; m < 4; ++m) rsv[ai][m] = pre[ai * 4 + m];
        if constexpr (KIND == 5) {
            const float* g = (pn == 4) ? kg : qg;
            const f32x4 gl0 = *(const f32x4*)(g + i8), gl1 = *(const f32x4*)(g + i8 + 4), gh0 = *(const f32x4*)(g + 32 + i8), gh1 = *(const f32x4*)(g + 36 + i8);
            const float osc = (pn == 4) ? 1.0f : QSCALE;
            const int t0 = row0 & (SEQ - 1), b = row0 >> 11;
            const f32x4* cs0 = (const f32x4*)((const f32x2*)(ws + WS_ROPE) + (size_t)t0 * 32 + i8);
            f32x4 nc[4];
#pragma unroll
            for (int i = 0; i < 4; ++i) nc[i] = cs0[i];
#pragma unroll
            for (int gi = 0; gi < 8; ++gi) {
                const int ai = gi >> 2, m = gi & 3;
                const int r = row0 + ai * 128 + m * 16, t = t0 + ai * 128 + m * 16;
                const float ri = __builtin_amdgcn_rsqf(rsv[ai][m] * (1.0f / 1024.0f) + 1e-6f);
                f32x4 cc[4];
#pragma unroll
                for (int i = 0; i < 4; ++i) cc[i] = nc[i];
                if (gi < 7) { const f32x4* cn = cs0 + (size_t)((((gi + 1) >> 2) * 128 + ((gi + 1) & 3) * 16) * 16);
#pragma unroll
                    for (int i = 0; i < 4; ++i) nc[i] = cn[i]; }
                float ss = 0.f;
#pragma unroll
                for (int bj = 0; bj < 2; ++bj)
#pragma unroll
                    for (int nn = 0; nn < 2; ++nn) { const f32x4 v = acc[ai][bj][m][nn]; ss += (v[0] * v[0] + v[1] * v[1]) + (v[2] * v[2] + v[3] * v[3]); }
                ss = sum_x16_x32(ss);
                ss *= ri * ri;
                const float sc = ri * __builtin_amdgcn_rsqf(ss * (1.0f / 64.0f) + 1e-6f);
                bf16_t* pq = (pn == 4) ? (bf16_t*)(ws + WS_K) + (size_t)r * 128 + wc * 64 + i8 : (bf16_t*)(ws + WS_Q) + (size_t)r * 512 + ((pn - 2) * 4 + wc) * 64 + i8;
                float* o = out + (long)O_KP + ((((long)layer * NB + b) * 128 + (t - (SEQ - 128))) * 2 + wc) * 64 + i8;
                f32x4 lo[2], hi[2];
#pragma unroll
                for (int nn = 0; nn < 2; ++nn) {
                    const f32x4 a = acc[ai][0][m][nn] * sc * (nn ? gl1 : gl0), bq = acc[ai][1][m][nn] * sc * (nn ? gh1 : gh0); const f32x4 c0 = cc[2 * nn], c1 = cc[2 * nn + 1];
                    lo[nn][0] = a[0] * c0[0] - bq[0] * c0[1]; hi[nn][0] = a[0] * c0[1] + bq[0] * c0[0];
                    lo[nn][1] = a[1] * c0[2] - bq[1] * c0[3]; hi[nn][1] = a[1] * c0[3] + bq[1] * c0[2];
                    lo[nn][2] = a[2] * c1[0] - bq[2] * c1[1]; hi[nn][2] = a[2] * c1[1] + bq[2] * c1[0];
                    lo[nn][3] = a[3] * c1[2] - bq[3] * c1[3]; hi[nn][3] = a[3] * c1[3] + bq[3] * c1[2];
                }
                if (pn == 4 && t >= SEQ - 128) { *(f32x4*)o = lo[0]; *(f32x4*)(o + 4) = lo[1]; *(f32x4*)(o + 32) = hi[0]; *(f32x4*)(o + 36) = hi[1]; }
                store8_bf16(pq, lo[0] * osc, lo[1] * osc); store8_bf16(pq + 32, hi[0] * osc, hi[1] * osc);
                asm volatile("" ::: "memory");
            }
            return;
        }
#pragma unroll
        for (int ai = 0; ai < 2; ++ai)
#pragma unroll
            for (int m = 0; m < 4; ++m) {
                const int r = row0 + ai * 128 + m * 16;
                const int t = r & (SEQ - 1), b = r >> 11;
                const float ri = __builtin_amdgcn_rsqf(rsv[ai][m] * (1.0f / 1024.0f) + 1e-6f);
                if (KIND == 0) {
                    bf16_t* p = (bf16_t*)(ws + WS_U) + (size_t)r * 256 + 32 * wc + i8;
                    float* o = out + (long)O_POOLP + (((long)layer * NB + b) * 15 + (t - (SEQ - 15))) * 256 + 32 * wc + i8;
#pragma unroll
                    for (int bj = 0; bj < 2; ++bj) { const f32x4 v0 = acc[ai][bj][m][0] * ri, v1 = acc[ai][bj][m][1] * ri;
                        store8_bf16(p + 128 * bj, v0, v1);
                        if (t >= SEQ - 15) { *(f32x4*)(o + 128 * bj) = v0; *(f32x4*)(o + 128 * bj + 4) = v1; } }
                } else if (KIND == 1) {
                    const int cbase = (pn == 1) ? 0 : (pn == 5) ? 256 : (pn == 6) ? 512 : 768;
                    bf16_t* p = (bf16_t*)(ws + WS_GM) + (size_t)r * 1024 + cbase + 32 * wc + i8;
#pragma unroll
                    for (int bj = 0; bj < 2; ++bj) { f32x4 v0 = acc[ai][bj][m][0] * ri, v1 = acc[ai][bj][m][1] * ri;
#pragma unroll
                        for (int e = 0; e < 4; ++e) { v0[e] = siluf_(v0[e]); v1[e] = siluf_(v1[e]); }
                        store8_bf16(p + 128 * bj, v0, v1); }
                } else if (KIND == 2) {
                    const int cbase = (pn - 7) * 256 + 32 * wc + i8;
                    bf16_t* p = (bf16_t*)(ws + WS_RIN) + (size_t)r * DSH + cbase;
                    float* o = out + O_SHP + ((size_t)layer * NB + b) * DSH + cbase;
#pragma unroll
                    for (int bj = 0; bj < 2; ++bj) { const f32x4 v0 = acc[ai][bj][m][0] * ri, v1 = acc[ai][bj][m][1] * ri;
                        store8_bf16(p + 128 * bj, v0, v1);
                        if (t == SEQ - 1) { *(f32x4*)(o + 128 * bj) = v0; *(f32x4*)(o + 128 * bj + 4) = v1; } }
                } else if (KIND == 3) {
                    const int cbase = 768 + 32 * wc + i8;
                    const f32x4 v0 = acc[ai][0][m][0] * ri, v1 = acc[ai][0][m][1] * ri;
                    store8_bf16((bf16_t*)(ws + WS_RIN) + (size_t)r * DSH + cbase, v0, v1);
                    if (t == SEQ - 1) { float* o = out + O_SHP + ((size_t)layer * NB + b) * DSH + cbase; *(f32x4*)o = v0; *(f32x4*)(o + 4) = v1; }
                } else if (KIND == 4) {
                    const int h = wc - 2;
                    bf16_t* vt = (bf16_t*)(ws + WS_VT) + ((size_t)(b * 2 + h) * 64) * SEQ + t;
                    float* o = out + (long)O_VP + ((((long)layer * NB + b) * 128 + (t - (SEQ - 128))) * 2 + h) * 64 + i8;
#pragma unroll
                    for (int bj = 0; bj < 2; ++bj) { const f32x4 v0 = acc[ai][bj][m][0] * ri, v1 = acc[ai][bj][m][1] * ri;
#pragma unroll
                        for (int e = 0; e < 4; ++e) { vt[(size_t)(32 * bj + i8 + e) * SEQ] = f2bf(v0[e]); vt[(size_t)(32 * bj + i8 + 4 + e) * SEQ] = f2bf(v1[e]); }
                        if (t >= SEQ - 128) { *(f32x4*)(o + 32 * bj) = v0; *(f32x4*)(o + 32 * bj + 4) = v1; } }
                }
                asm volatile("" ::: "memory");
            }
    }
    __device__ __forceinline__ void operator()(const f32x4 (&acc)[2][2][4][2], const pg8::Unit& u, int wr, int wc, int fr, int fq, const float (&pre)[8]) const {
        asm volatile("" : "+v"(fr), "+v"(fq));
        const int pn = u.pn;
        if (pn == 0) body<0>(acc, u, wr, wc, fr, fq, pre);
        else if (pn == 1 || pn == 5 || pn == 6 || pn == 10) body<1>(acc, u, wr, wc, fr, fq, pre);
        else if (pn >= 7 && pn <= 9) body<2>(acc, u, wr, wc, fr, fq, pre);
        else if (pn == 11) { if (wc < 2) body<3>(acc, u, wr, wc, fr, fq, pre); }
        else if (pn == 4 && wc >= 2) body<4>(acc, u, wr, wc, fr, fq, pre);
        else body<5>(acc, u, wr, wc, fr, fq, pre);
    }
};

struct EpiOut {
    static constexpr bool PERM = false, AFTER_DRAIN = false, IDEMPOTENT = false;
    const float* resid; float* out; bf16_t* XB; float* RS; int layer;
    __device__ __forceinline__ void preload(const pg8::Unit&, int, int, float (&)[8]) const {}
    __device__ __forceinline__ void operator()(const f32x4 (&acc)[2][2][4][2], const pg8::Unit& u, int wr, int wc, int fr, int fq, const float (&)[8]) const {
        asm volatile("" : "+v"(fr), "+v"(fq));
        const int row0 = u.pm * 256 + wr * 64 + fr;
        const int cb = u.pn * 256 + 32 * wc + 8 * fq;
        const size_t off0 = (size_t)row0 * DM + cb;
#define EPO_OFF(g) ((size_t)(row0 + ((g) >> 2) * 128 + ((g) & 3) * 16) * DM + cb)
        u32x4 nb[8][2];
#pragma unroll
        for (int g = 0; g < 8; ++g)
#pragma unroll
            for (int bj = 0; bj < 2; ++bj) nb[g][bj] = *(const u32x4*)(XB + EPO_OFF(g) + bj * 128);
#pragma unroll
        for (int g = 0; g < 8; ++g) {
            const int ai = g >> 2, m = g & 3;
            const int r = row0 + ai * 128 + m * 16;
            const size_t off = EPO_OFF(g);
            float ss = 0.f;
#pragma unroll
            for (int bj = 0; bj < 2; ++bj) {
                const unsigned b0 = nb[g][bj][0], b1 = nb[g][bj][1], b2 = nb[g][bj][2], b3 = nb[g][bj][3];
                const f32x4 r0 = {bf_lo(b0), bf_hi(b0), bf_lo(b1), bf_hi(b1)}, r1 = {bf_lo(b2), bf_hi(b2), bf_lo(b3), bf_hi(b3)};
                const f32x4 y0 = acc[ai][bj][m][0] + r0, y1 = acc[ai][bj][m][1] + r1;
                if (layer == 0) { store8_bf16(XB + off + bj * 128, y0, y1);
#pragma unroll
                    for (int e = 0; e < 4; ++e) ss += y0[e] * y0[e] + y1[e] * y1[e]; }
                else { *(f32x4*)(out + off + bj * 128) = y0; *(f32x4*)(out + off + bj * 128 + 4) = y1; } }
            if (layer == 0) { ss = sum_x16_x32(ss);
                if (fq == 0) __hip_atomic_fetch_add(RS + r, ss, __ATOMIC_RELAXED, __HIP_MEMORY_SCOPE_AGENT); }
            asm volatile("" ::: "memory");
        }
#undef EPO_OFF
    }
};

__device__ __forceinline__ void p0_transpose_item(const float* W, int ldw, const float* g, bf16_t* WT, LAS float* scr, int item, int nblk, bool is_in, int lane) {
    const int kb = item / nblk, nb = item % nblk, k0 = 64 * kb, n0 = 32 * nb;
    const int sc = is_in ? src_col_in(n0 + (lane & 31)) : src_col_out(n0 + (lane & 31));
    float wv_[32], gv_[32];
#pragma unroll
    for (int i = 0; i < 32; ++i) { const int kk = 2 * i + (lane >> 5); wv_[i] = 0.f; gv_[i] = 1.f;
        if (sc >= 0) { wv_[i] = W[(size_t)(k0 + kk) * ldw + sc]; if (g) gv_[i] = g[k0 + kk]; } }
#pragma unroll
    for (int i = 0; i < 32; ++i) { const int kk = 2 * i + (lane >> 5); scr[kk * 33 + (lane & 31)] = wv_[i] * gv_[i]; }
    asm volatile("s_waitcnt lgkmcnt(0)" ::: "memory");
    const int c = lane & 7;
#pragma unroll
    for (int j = 0; j < 4; ++j) { const int n = (lane >> 3) + 8 * j; const LAS float* s = scr + (8 * c) * 33 + n;
        u32x4 o; o.x = pk_bf16(s[0 * 33], s[1 * 33]); o.y = pk_bf16(s[2 * 33], s[3 * 33]); o.z = pk_bf16(s[4 * 33], s[5 * 33]); o.w = pk_bf16(s[6 * 33], s[7 * 33]);
        *(u32x4*)(WT + (size_t)(n0 + n) * DM + k0 + 8 * c) = o; }
    asm volatile("s_waitcnt lgkmcnt(0)" ::: "memory");
}
__device__ __forceinline__ float row_to_bf16(const float* xrow, bf16_t* orow, int lane) {
    const f32x4* xr = (const f32x4*)xrow + lane;
    f32x4 v[4]; float s = 0.f;
#pragma unroll
    for (int j = 0; j < 4; ++j) { v[j] = xr[64 * j]; s += (v[j][0] * v[j][0] + v[j][1] * v[j][1]) + (v[j][2] * v[j][2] + v[j][3] * v[j][3]); }
    u32x2* o8 = (u32x2*)orow + lane;
#pragma unroll
    for (int j = 0; j < 4; ++j) { u32x2 w; w.x = pk_bf16(v[j][0], v[j][1]); w.y = pk_bf16(v[j][2], v[j][3]); o8[64 * j] = w; }
    return wave_sum(s);
}
__device__ __forceinline__ void p0_prologue(const Params& P, LAS unsigned char* lds, int G, int tid, int wid, int lane) {
    unsigned char* ws = P.ws;
    LAS float* scr = (LAS float*)(lds + wid * 16384);
    const int gw = blockIdx.x * 8 + wid, NGW = G * 8;
    constexpr int I_IN = 16 * 96, I_OUT = 16 * 32, NITEMS = 2 * I_IN + 2 * I_OUT;
    for (int it = gw; it < NITEMS; it += NGW) {
        int r = it;
        if (r < 2 * I_IN) { const int l = r / I_IN; r -= l * I_IN;
            p0_transpose_item(P.in[8] + (size_t)l * DM * DIN, DIN, P.in[7] + l * DM, (bf16_t*)(ws + WS_WIN) + (size_t)l * NPAD * DM, scr, r, 96, true, lane); continue; }
        r -= 2 * I_IN; { const int l = r / I_OUT; r -= l * I_OUT;
            p0_transpose_item(P.in[9] + (size_t)l * DM * DM, DM, nullptr, (bf16_t*)(ws + WS_WOUT) + (size_t)l * DM * DM, scr, r, 32, false, lane); }
    }
    if (blockIdx.x == 0 && tid < 7) ((unsigned long long*)(ws + WS_CTL + 32768))[tid] = (unsigned long long)P.in[tid];
#if INKERNEL_BAR_ZERO
    if (blockIdx.x == 0) for (int i = tid; i < 3584; i += 512) ((unsigned*)(ws + WS_CTL) + 4096)[i] = 0u;
#endif
    for (int e = blockIdx.x * 512 + tid; e < 32768; e += G * 512) {
        float v[15];
#define P0_LD(k, idx, n) v[k] = e < (n) ? P.in[idx][e] : 0.f;
        P0_LD(0, 10, 32768) P0_LD(1, 11, 512) P0_LD(2, 12, 128) P0_LD(3, 13, 128) P0_LD(4, 14, 16) P0_LD(5, 15, 1664) P0_LD(6, 16, 512) P0_LD(7, 17, 16384)
        P0_LD(8, 18, 512) P0_LD(9, 19, 16384) P0_LD(10, 20, 512) P0_LD(11, 21, 512) P0_LD(12, 22, 512) P0_LD(13, 23, 512) P0_LD(14, 24, 512)
#define P0_ST(k, off, n) if (e < (n)) ((float*)(ws + WS_PRM))[(off) + e] = v[k];
        P0_ST(0, PRM_POOLW, 32768) P0_ST(1, PRM_POOLSC, 512) P0_ST(2, PRM_QG, 128) P0_ST(3, PRM_KG, 128) P0_ST(4, PRM_SINK, 16) P0_ST(5, PRM_MU, 1664) P0_ST(6, PRM_W0, 512) P0_ST(7, PRM_WUP, 16384)
        P0_ST(8, PRM_A0, 512) P0_ST(9, PRM_AUP, 16384) P0_ST(10, PRM_KK, 512) P0_ST(11, PRM_KA, 512) P0_ST(12, PRM_RK, 512) P0_ST(13, PRM_LNG, 512) P0_ST(14, PRM_LNB, 512)
    }
    for (int e = blockIdx.x * 512 + tid; e < 2 * 2 * 16 * 64 * 8; e += G * 512) {
        const int j = e & 7, ln = (e >> 3) & 63, nb = (e >> 9) & 15, mat = (e >> 13) & 1, l = e >> 14;
        const float* up = P.in[mat ? 19 : 17] + (size_t)l * 32 * 256;
        ((bf16_t*)(ws + WS_WUPF))[e] = f2bf(up[(8 * (ln >> 4) + j) * 256 + 16 * nb + (ln & 15)]);
    }
    for (int e = blockIdx.x * 512 + tid; e < 2 * 4 * 4 * 2 * 64 * 8; e += G * 512) {
        const int j = e & 7, ln = (e >> 3) & 63, kk = (e >> 9) & 1, nb = (e >> 10) & 3, lg = e >> 12;
        ((bf16_t*)(ws + WS_POOLF))[e] = f2bf(P.in[10][((size_t)lg * 64 + 8 * (ln >> 4) + 32 * kk + j) * 64 + 16 * nb + (ln & 15)]);
    }
    for (int e = blockIdx.x * 512 + tid; e < 2049 * 32; e += G * 512) {
        const int pi = e >> 5, i = e & 31; const int pos = pi < 2048 ? pi : 16384;
        const float fr = (float)pow(10000.0, -(double)i / 32.0);
        const float ang = (float)pos * fr;
        f32x2 cs; cs.x = cosf(ang); cs.y = sinf(ang);
        ((f32x2*)(ws + WS_ROPE))[e] = cs;
    }
    for (int m0 = gw; m0 < MP; m0 += 4 * NGW) {
        f32x4 v[4][4];
#pragma unroll
        for (int j = 0; j < 4; ++j) { const int m = m0 + j * NGW; if (m < MP) { const f32x4* xr = (const f32x4*)(P.in[0] + (size_t)m * DM) + lane;
#pragma unroll
            for (int c = 0; c < 4; ++c) v[j][c] = xr[64 * c]; } }
#pragma unroll
        for (int j = 0; j < 4; ++j) { const int m = m0 + j * NGW; if (m < MP) { float s_ = 0.f;
#pragma unroll
            for (int c = 0; c < 4; ++c) s_ += (v[j][c][0] * v[j][c][0] + v[j][c][1] * v[j][c][1]) + (v[j][c][2] * v[j][c][2] + v[j][c][3] * v[j][c][3]);
            u32x2* o8 = (u32x2*)((bf16_t*)(ws + WS_XB) + (size_t)m * DM) + lane;
#pragma unroll
            for (int c = 0; c < 4; ++c) { u32x2 w; w.x = pk_bf16(v[j][c][0], v[j][c][1]); w.y = pk_bf16(v[j][c][2], v[j][c][3]); o8[64 * c] = w; }
            s_ = wave_sum(s_);
            if (lane < 2) ((float*)(ws + WS_RS))[(size_t)lane * MP + m] = lane == 0 ? s_ : 0.f; } }
    }
    for (int ms = gw; ms < MS; ms += NGW) { const float s_ = row_to_bf16(P.in[1] + (size_t)ms * DM, (bf16_t*)(ws + WS_XBS) + (size_t)ms * DM, lane);
        ((float*)(ws + WS_RSS))[ms * 64 + lane] = lane == 0 ? s_ : 0.f; }
}

constexpr int SK_BROW = 2048 + 16;
template <bool IS_IN>
__device__ __forceinline__ void skinny_unit(const Params& P, int layer, int unit, int wid, int lane, LAS unsigned char* lb) {
    unsigned char* ws = P.ws;
    const bf16_t* A = IS_IN ? (const bf16_t*)(ws + WS_XBS) : (const bf16_t*)(ws + WS_MIXS);
    const bf16_t* Bt = IS_IN ? (const bf16_t*)(ws + WS_WIN) + (size_t)layer * NPAD * DM : (const bf16_t*)(ws + WS_WOUT) + (size_t)layer * DM * DM;
    const int n0 = unit * 16, r16 = lane & 15, kq = lane >> 4;
    const bf16x8* ap = (const bf16x8*)(A + (size_t)(16 * wid + r16) * DM + 8 * kq);
    { const int tid = wid * 64 + lane; u32x4 bt[4];
#pragma unroll
      for (int i = 0; i < 4; ++i) bt[i] = *(const u32x4*)(Bt + (size_t)(n0 + (tid >> 5)) * DM + ((tid & 31) + 32 * i) * 8);
#pragma unroll
      for (int i = 0; i < 4; ++i) *(LAS u32x4*)(lb + (tid >> 5) * SK_BROW + ((tid & 31) + 32 * i) * 16) = bt[i]; }
    const LAS unsigned char* bl = lb + r16 * SK_BROW + kq * 16;
    f32x4 acc = {0.f, 0.f, 0.f, 0.f};
    float rsv[16];
    if (IS_IN) { const float* RSS = (const float*)(ws + WS_RSS);
#pragma unroll
        for (int rr = 0; rr < 16; ++rr) rsv[rr] = RSS[(16 * wid + rr) * 64 + lane]; }
    const int kst = (unit * 5 + wid * 3) & 31;
    bf16x8 av[32];
#pragma unroll
    for (int i = 0; i < 32; ++i) av[i] = ap[((kst + i) & 31) * 4];
    __syncthreads();
#pragma unroll
    for (int i = 0; i < 32; ++i) acc = __builtin_amdgcn_mfma_f32_16x16x32_bf16(av[i], *(const LAS bf16x8*)(bl + ((kst + i) & 31) * 64), acc, 0, 0, 0);
    __syncthreads();
    const int n = n0 + r16;
    if (IS_IN) {
        float rv = 0.f;
#pragma unroll
        for (int rr = 0; rr < 16; ++rr) { const float s = wave_sum(rsv[rr]); rv = (lane == rr) ? s : rv; }
        rv = __builtin_amdgcn_rsqf(rv * (1.0f / 1024.0f) + 1e-6f);
        const int lc = src_col_in(n);
        float* ZS = (float*)(ws + WS_ZS);
#pragma unroll
        for (int reg = 0; reg < 4; ++reg) { const float ri = __shfl(rv, 4 * kq + reg); if (lc >= 0) ZS[(size_t)(16 * wid + 4 * kq + reg) * DIN + lc] = acc[reg] * ri; }
    } else {
        const int lc = src_col_out(n);
        const float* resid = layer == 0 ? INP(1) : P.out + O_YS;
        float* out = P.out + O_YS;
        bf16_t* XBS = (bf16_t*)(ws + WS_XBS); float* RSS = (float*)(ws + WS_RSS);
#pragma unroll
        for (int reg = 0; reg < 4; ++reg) { const int row = 16 * wid + 4 * kq + reg;
            const float y = resid[(size_t)row * DM + lc] + acc[reg];
            out[(size_t)row * DM + lc] = y;
            if (layer == 0) { XBS[(size_t)row * DM + lc] = f2bf(y); const float s = sum16d(y * y); if (r16 == 0) RSS[row * 64 + unit] = s; } }
    }
}

constexpr int PL_ROW = 144, PL_WAVE = 16 * PL_ROW;
template <int W_>
__device__ __forceinline__ void pool_wave(const Params& P, int layer, int b, int t0, int g, LAS unsigned char* lw, int lane, bool dry) {
    unsigned char* ws = P.ws;
    const int r16 = lane & 15, kq = lane >> 4;
    bf16x8 bfr[4][2];
#pragma unroll
    for (int nb = 0; nb < 4; ++nb)
#pragma unroll
        for (int kk = 0; kk < 2; ++kk) bfr[nb][kk] = *((const bf16x8*)(ws + WS_POOLF) + ((((size_t)(layer * 4 + g) * 4 + nb) * 2 + kk) * 64 + lane));
    LAS unsigned char* us = lw + PL_WAVE;
    { const bf16_t* ug = (const bf16_t*)(ws + WS_U) + ((size_t)b * SEQ) * 256 + 64 * g + 8 * (lane & 7);
      u32x4 uv[10];
#pragma unroll
      for (int i = 0; i < 10; ++i) { const int tt = t0 - 16 + 8 * i + (lane >> 3); uv[i] = (u32x4){0u, 0u, 0u, 0u}; if (tt >= 0) uv[i] = *(const u32x4*)(ug + (long)tt * 256); }
#pragma unroll
      for (int i = 0; i < 10; ++i) *(LAS u32x4*)(us + (8 * i + (lane >> 3)) * PL_ROW + (lane & 7) * 16) = uv[i]; }
    f32x4 scl[4];
#pragma unroll
    for (int nb = 0; nb < 4; ++nb) scl[nb] = *(const f32x4*)(PRM(PRM_POOLSC) + layer * 256 + 64 * g + 16 * nb + 4 * kq);
    float up[16], un[16];
#pragma unroll
    for (int j = 0; j < 16; ++j) up[j] = bf1(*(const LAS bf16_t*)(us + j * PL_ROW + lane * 2));
    float win = 0.f;
#pragma unroll
    for (int j = 1; j < W_; ++j) win += up[16 - j];
    bf16_t* gmb = (bf16_t*)(ws + WS_GM) + ((size_t)b * SEQ + t0 + r16) * 1024 + 64 * g + 4 * kq;
    u32x2 ngt[4];
#pragma unroll
    for (int nb = 0; nb < 4; ++nb) ngt[nb] = *(const u32x2*)(gmb + 16 * nb);
    for (int tq = 0; tq < 64; tq += 16) {
#pragma unroll
        for (int j = 0; j < 16; ++j) un[j] = bf1(*(const LAS bf16_t*)(us + (16 + tq + j) * PL_ROW + lane * 2));
        u32x2 gt[4];
#pragma unroll
        for (int nb = 0; nb < 4; ++nb) gt[nb] = ngt[nb];
        if (tq + 16 < 64) {
#pragma unroll
            for (int nb = 0; nb < 4; ++nb) ngt[nb] = *(const u32x2*)(gmb + (size_t)(tq + 16) * 1024 + 16 * nb); }
#pragma unroll
        for (int j = 0; j < 16; ++j) { const int t = t0 + tq + j;
            win += un[j];
            const float pooled = (t + 1 >= W_) ? win * (1.0f / (float)W_) - un[j] : win / (float)(t + 1) - un[j];
            win -= (j - W_ + 1 >= 0) ? un[(j - W_ + 1) & 15] : up[(16 + j - W_ + 1) & 15];
            *(LAS bf16_t*)(lw + j * PL_ROW + lane * 2) = f2bf(pooled); }
        const bf16x8 a0 = *(const LAS bf16x8*)(lw + r16 * PL_ROW + (8 * kq) * 2), a1 = *(const LAS bf16x8*)(lw + r16 * PL_ROW + (8 * kq + 32) * 2);
#pragma unroll
        for (int nb = 0; nb < 4; ++nb) { f32x4 acc = {0.f, 0.f, 0.f, 0.f};
            acc = __builtin_amdgcn_mfma_f32_16x16x32_bf16(bfr[nb][0], a0, acc, 0, 0, 0);
            acc = __builtin_amdgcn_mfma_f32_16x16x32_bf16(bfr[nb][1], a1, acc, 0, 0, 0);
            const unsigned g0 = gt[nb].x, g1 = gt[nb].y;
            u32x2 w; w.x = pk_bf16(acc[0] * scl[nb][0] * bf_lo(g0), acc[1] * scl[nb][1] * bf_hi(g0)); w.y = pk_bf16(acc[2] * scl[nb][2] * bf_lo(g1), acc[3] * scl[nb][3] * bf_hi(g1));
            *(u32x2*)(gmb + (size_t)tq * 1024 + 16 * nb) = dry ? gt[nb] : w; }
#pragma unroll
        for (int j = 0; j < 16; ++j) up[j] = un[j];
    }
}
__device__ __forceinline__ void pool_unit(const Params& P, int layer, int unit, LAS unsigned char* lds, int wid, int lane, bool dry = false) {
    const int b = unit >> 4, chunk = unit & 15, g = wid & 3, half = wid >> 2;
    const int t0 = chunk * 128 + half * 64;
    LAS unsigned char* lw = lds + wid * (PL_WAVE + 80 * PL_ROW);
    if (g == 0) pool_wave<2>(P, layer, b, t0, g, lw, lane, dry);
    else if (g == 1) pool_wave<4>(P, layer, b, t0, g, lw, lane, dry);
    else if (g == 2) pool_wave<8>(P, layer, b, t0, g, lw, lane, dry);
    else pool_wave<16>(P, layer, b, t0, g, lw, lane, dry);
}

constexpr int KS_STRIDE = 144, VS_STRIDE = 520, ATT_VOFF = 256 * KS_STRIDE;
template <bool STAGE, bool COMPUTE>
__device__ __forceinline__ void attn_unit(const Params& P, int layer, int unit, LAS unsigned char* lds, LAS unsigned char* inv_strip, int tid, int wid, int lane, bool dry = false) {
    unsigned char* ws = P.ws;
    const bf16_t* Q = (const bf16_t*)(ws + WS_Q); const bf16_t* K = (const bf16_t*)(ws + WS_K); const bf16_t* VT = (const bf16_t*)(ws + WS_VT);
    bf16_t* GM = (bf16_t*)(ws + WS_GM);
    const int kvh = unit & 1, n = (unit >> 1) & 15, b = unit >> 5;
    const int tk0 = n * 128 - 128;
    if (STAGE) {
#pragma unroll
    for (int i = 0; i < 4; ++i) { const int idx = tid + 512 * i; const int row = idx >> 3, c = idx & 7; const int t = tk0 + row;
        u32x4 v = {0u, 0u, 0u, 0u}; if (t >= 0) v = *(const u32x4*)(K + ((size_t)b * SEQ + t) * 128 + kvh * 64 + c * 8);
        *(LAS u32x4*)(lds + row * KS_STRIDE + c * 16) = v; }
#pragma unroll
    for (int i = 0; i < 4; ++i) { const int idx = tid + 512 * i; const int d = idx >> 5, c = idx & 31; const int t = tk0 + 8 * c;
        u32x4 v = {0u, 0u, 0u, 0u}; if (t >= 0) v = *(const u32x4*)(VT + ((size_t)(b * 2 + kvh) * 64 + d) * SEQ + t);
        LAS u32x2* dst = (LAS u32x2*)(lds + ATT_VOFF + d * VS_STRIDE + c * 16); dst[0] = (u32x2){v.x, v.y}; dst[1] = (u32x2){v.z, v.w}; }
    }
    if (!COMPUTE) return;
    const int hq = wid >> 1, qh = wid & 1, head = kvh * 4 + hq;
    const int r31 = lane & 31, h = lane >> 5;
    const float sink2 = PRM(PRM_SINK)[layer * 8 + head] * LOG2E;
    const bf16_t* qp0 = Q + ((size_t)b * SEQ + n * 128 + 64 * qh + r31) * 512 + head * 64 + 8 * h;
    bf16x8 nq[4];
#pragma unroll
    for (int ks = 0; ks < 4; ++ks) nq[ks] = *(const bf16x8*)(qp0 + 16 * ks);
#pragma unroll 1
    for (int qb2 = 0; qb2 < 2; ++qb2) {
        const int qb = 2 * qh + qb2, i0 = 32 * qb;
        bf16x8 qf[4];
#pragma unroll
        for (int ks = 0; ks < 4; ++ks) qf[ks] = nq[ks];
        if (qb2 == 0) {
#pragma unroll
            for (int ks = 0; ks < 4; ++ks) nq[ks] = *(const bf16x8*)(qp0 + (size_t)32 * 512 + 16 * ks); }
        f32x16 s[5];
#pragma unroll
        for (int kt = 0; kt < 5; ++kt) {
#pragma unroll
            for (int e = 0; e < 16; ++e) s[kt][e] = 0.f;
            const LAS unsigned char* kb = lds + (32 * (qb + kt) + r31) * KS_STRIDE + 16 * h;
#pragma unroll
            for (int ks = 0; ks < 4; ++ks) { const bf16x8 a = *(const LAS bf16x8*)(kb + 32 * ks); s[kt] = __builtin_amdgcn_mfma_f32_32x32x16_bf16(a, qf[ks], s[kt], 0, 0, 0); }
        }
        const float dqf = (float)(r31 - 4 * h);
        float mx = sink2;
#pragma unroll
        for (int kt = 0; kt < 5; ++kt) { if ((n > 0) || (qb + kt >= 4)) {
#pragma unroll
            for (int e = 0; e < 16; ++e) mx = fmaxf(mx, s[kt][e]); } }
        mx = fmaxf(mx, __shfl_xor(mx, 32));
        float sum = 0.f;
#pragma unroll
        for (int kt = 0; kt < 5; ++kt) { if ((n > 0) || (qb + kt >= 4)) {
#pragma unroll
            for (int e = 0; e < 16; ++e) { const float ko = (float)((e & 3) + 8 * (e >> 2));
                float p = __builtin_amdgcn_exp2f(s[kt][e] - mx);
                if (kt == 0) p *= __builtin_amdgcn_fmed3f(ko - dqf, 0.f, 1.f);
                if (kt == 4) p *= __builtin_amdgcn_fmed3f(dqf - ko + 1.0f, 0.f, 1.f);
                s[kt][e] = p; sum += p; } }
          else {
#pragma unroll
            for (int e = 0; e < 16; ++e) s[kt][e] = 0.f; } }
        sum += __shfl_xor(sum, 32);
        const float inv = 1.0f / (sum + __builtin_amdgcn_exp2f(sink2 - mx));
        bf16_t* gbase = GM + ((size_t)b * SEQ + n * 128 + i0 + r31) * 1024 + 256 + head * 64 + 8 * h;
        u32x4 gts[2][2];
#pragma unroll
        for (int db = 0; db < 2; ++db)
#pragma unroll
            for (int k = 0; k < 2; ++k) gts[db][k] = *(const u32x4*)(gbase + 32 * db + 16 * k);
        f32x16 o[2];
#pragma unroll
        for (int e = 0; e < 16; ++e) { o[0][e] = 0.f; o[1][e] = 0.f; }
#pragma unroll
        for (int kt = 0; kt < 5; ++kt)
#pragma unroll
            for (int s2 = 0; s2 < 2; ++s2) {
                u32x4 pw; pw.x = pk_bf16(s[kt][8 * s2 + 0], s[kt][8 * s2 + 1]); pw.y = pk_bf16(s[kt][8 * s2 + 2], s[kt][8 * s2 + 3]);
                pw.z = pk_bf16(s[kt][8 * s2 + 4], s[kt][8 * s2 + 5]); pw.w = pk_bf16(s[kt][8 * s2 + 6], s[kt][8 * s2 + 7]);
                const bf16x8 pf = __builtin_bit_cast(bf16x8, pw);
#pragma unroll
                for (int db = 0; db < 2; ++db) {
                    const LAS unsigned char* vb = lds + ATT_VOFF + (32 * db + r31) * VS_STRIDE + (32 * (qb + kt) + 16 * s2 + 4 * h) * 2;
                    const u32x2 v0 = *(const LAS u32x2*)vb, v1 = *(const LAS u32x2*)(vb + 16);
                    const u32x4 vw = {v0.x, v0.y, v1.x, v1.y};
                    o[db] = __builtin_amdgcn_mfma_f32_32x32x16_bf16(__builtin_bit_cast(bf16x8, vw), pf, o[db], 0, 0, 0);
                }
            }
#pragma unroll
        for (int db = 0; db < 2; ++db)
#pragma unroll
            for (int k = 0; k < 2; ++k) {
                float v[8];
#pragma unroll
                for (int i = 0; i < 4; ++i) { const auto sw = __builtin_amdgcn_permlane32_swap(__float_as_uint(o[db][8 * k + i]), __float_as_uint(o[db][8 * k + 4 + i]), false, false);
                    v[i] = __uint_as_float(sw[0]) * inv; v[4 + i] = __uint_as_float(sw[1]) * inv; }
                const u32x4 gg = gts[db][k]; const unsigned g0 = gg[0], g1 = gg[1], g2 = gg[2], g3 = gg[3];
                u32x4 w; w.x = pk_bf16(v[0] * bf_lo(g0), v[1] * bf_hi(g0)); w.y = pk_bf16(v[2] * bf_lo(g1), v[3] * bf_hi(g1));
                w.z = pk_bf16(v[4] * bf_lo(g2), v[5] * bf_hi(g2)); w.w = pk_bf16(v[6] * bf_lo(g3), v[7] * bf_hi(g3));
                *(u32x4*)(gbase + 32 * db + 16 * k) = dry ? gg : w;
            }
    }
}

__device__ __forceinline__ float tanhf_(float x) { const float e = fast_exp(2.0f * x); return 1.0f - 2.0f * __builtin_amdgcn_rcpf(e + 1.0f); }
struct PrepRaw { u32x2 r, k, v; };
__device__ __forceinline__ PrepRaw prep_load(const bf16_t* row, int c0, int lane) {
    PrepRaw x; x.r = *(const u32x2*)(row + c0); x.k = *(const u32x2*)(row + 256 + c0); x.v = *(const u32x2*)(row + 512 + c0); return x;
}
struct PrepConst { f32x4 mr, mk, mv, w0, a0, kkp, kap, rkp; };
__device__ __forceinline__ void prep_token(const Params& P, int layer, int r, int lane, const LAS unsigned char* lup, int ti, const PrepRaw& cu, const PrepRaw& pv_, float (&om)[4], const PrepConst& C, float& keep_rkr, float& keep_kr) {
    unsigned char* ws = P.ws;
    const int b = r >> 11, t = r & (SEQ - 1), c0 = 4 * lane, hh = lane >> 4;
    float rs[4], ks[4], vs[4];
    { const u32x2 cr = cu.r, ck = cu.k, cv = cu.v, pr = pv_.r, pk = pv_.k, pv = pv_.v;
      const f32x4 mr = C.mr, mk = C.mk, mv = C.mv;
      const float xr[4] = {bf_lo(cr.x), bf_hi(cr.x), bf_lo(cr.y), bf_hi(cr.y)}, yr[4] = {bf_lo(pr.x), bf_hi(pr.x), bf_lo(pr.y), bf_hi(pr.y)};
      const float xk[4] = {bf_lo(ck.x), bf_hi(ck.x), bf_lo(ck.y), bf_hi(ck.y)}, yk[4] = {bf_lo(pk.x), bf_hi(pk.x), bf_lo(pk.y), bf_hi(pk.y)};
      const float xv[4] = {bf_lo(cv.x), bf_hi(cv.x), bf_lo(cv.y), bf_hi(cv.y)}, yv[4] = {bf_lo(pv.x), bf_hi(pv.x), bf_lo(pv.y), bf_hi(pv.y)};
#pragma unroll
      for (int i = 0; i < 4; ++i) { rs[i] = xr[i] + (yr[i] - xr[i]) * mr[i]; ks[i] = xk[i] + (yk[i] - xk[i]) * mk[i]; vs[i] = xv[i] + (yv[i] - xv[i]) * mv[i]; } }
    float lw[4], la[4];
    { const u32x2 hw = *(const LAS u32x2*)(lup + (size_t)ti * 512 + c0 * 2), ha = *(const LAS u32x2*)(lup + 8192 + (size_t)ti * 512 + c0 * 2);
      const unsigned w0_ = hw[0], w1_ = hw[1], a0_ = ha[0], a1_ = ha[1];
      lw[0] = (float)as_h2(w0_).x; lw[1] = (float)as_h2(w0_).y; lw[2] = (float)as_h2(w1_).x; lw[3] = (float)as_h2(w1_).y;
      la[0] = (float)as_h2(a0_).x; la[1] = (float)as_h2(a0_).y; la[2] = (float)as_h2(a1_).x; la[3] = (float)as_h2(a1_).y; }
    const f32x4 w0 = C.w0, a0 = C.a0, kkp = C.kkp, kap = C.kap, rkp = C.rkp;
    float wv[4], av[4], kk[4], kt[4], bb[4];
    float ssq = 0.f, br = 0.f, kr = 0.f, rkr = 0.f;
#pragma unroll
    for (int i = 0; i < 4; ++i) {
        wv[i] = fast_exp(-0.6065306597126334f * sigmoidf_(w0[i] + lw[i]));
        av[i] = sigmoidf_(a0[i] + la[i]);
        kk[i] = ks[i] * kkp[i]; ssq += kk[i] * kk[i];
        kt[i] = ks[i] * (1.0f + (av[i] - 1.0f) * kap[i]);
        kr += kt[i] * rs[i]; rkr += rs[i] * kt[i] * rkp[i];
    }
    ssq = sum16d(ssq);
    const float kn = fminf(__builtin_amdgcn_rsqf(ssq), 1e12f);
#pragma unroll
    for (int i = 0; i < 4; ++i) { kk[i] *= kn; bb[i] = kk[i] * av[i]; br += bb[i] * rs[i]; }
    br = sum16d(br); kr = sum16d(kr); rkr = sum16d(rkr);
    float wr[4];
#pragma unroll
    for (int i = 0; i < 4; ++i) wr[i] = wv[i] * rs[i] - br * kk[i];
    const size_t rec = ((size_t)(b * 4 + hh) * SEQ + t);
    const int l16 = lane & 15;
#if SCAN_IMPL != 1
    u32x4* pa = (u32x4*)(ws + WS_PA) + rec * 32 + 2 * l16;
    pa[0] = (u32x4){pk_f16(kk[0], kk[1]), pk_f16(bb[0], bb[1]), pk_f16(kt[0], kt[1]), pk_f16(wr[0], wr[1])};
    pa[1] = (u32x4){pk_f16(kk[2], kk[3]), pk_f16(bb[2], bb[3]), pk_f16(kt[2], kt[3]), pk_f16(wr[2], wr[3])};
    *((f32x4*)(ws + WS_PW) + rec * 16 + l16) = (f32x4){wv[0], wv[1], wv[2], wv[3]};
#endif
#if SCAN_IMPL != 0
    if (SCAN_IMPL == 1 || layer == 0) {
        float uk[4], uw[4], bh[4], kh[4];
#pragma unroll
        for (int i = 0; i < 4; ++i) { uk[i] = om[i] * kk[i]; uw[i] = om[i] * wr[i]; om[i] *= wv[i]; const float inv = __builtin_amdgcn_rcpf(om[i]); bh[i] = bb[i] * inv; kh[i] = kt[i] * (inv * 0.0625f); }
        { const bool odd = lane & 1;
          u32x2* pb = (u32x2*)(ws + WS_PB) + rec * 64 + (odd ? 16 + l16 - 1 : l16);
          const unsigned uk0 = pk_f16(uk[0], uk[1]), uk1 = pk_f16(uk[2], uk[3]), uw0 = pk_f16(uw[0], uw[1]), uw1 = pk_f16(uw[2], uw[3]);
          const unsigned bh0 = pk_f16(bh[0], bh[1]), bh1 = pk_f16(bh[2], bh[3]), kh0 = pk_f16(kh[0], kh[1]), kh1 = pk_f16(kh[2], kh[3]);
          const unsigned s0 = odd ? uk0 : uw0, s1 = odd ? uk1 : uw1, s2 = odd ? bh0 : kh0, s3 = odd ? bh1 : kh1;
          const unsigned q0 = (unsigned)__builtin_amdgcn_update_dpp(0, (int)s0, 0xB1, 0xf, 0xf, true), q1 = (unsigned)__builtin_amdgcn_update_dpp(0, (int)s1, 0xB1, 0xf, 0xf, true);
          const unsigned q2 = (unsigned)__builtin_amdgcn_update_dpp(0, (int)s2, 0xB1, 0xf, 0xf, true), q3 = (unsigned)__builtin_amdgcn_update_dpp(0, (int)s3, 0xB1, 0xf, 0xf, true);
          *(u32x4*)pb = odd ? (u32x4){q0, q1, uw0, uw1} : (u32x4){uk0, uk1, q0, q1};
          *(u32x4*)(pb + 32) = odd ? (u32x4){q2, q3, kh0, kh1} : (u32x4){bh0, bh1, q2, q3}; }
#if DBG_DOUBLE & 4096
        { u32x2* pd = (u32x2*)(ws + WS_PW) + (rec & 65535) * 64 + l16;
          pd[0] = (u32x2){pk_f16(uk[0], uk[1]), pk_f16(uk[2], uk[3])}; pd[16] = (u32x2){pk_f16(uw[0], uw[1]), pk_f16(uw[2], uw[3])};
          pd[32] = (u32x2){pk_f16(bh[0], bh[1]), pk_f16(bh[2], bh[3])}; pd[48] = (u32x2){pk_f16(kh[0], kh[1]), pk_f16(kh[2], kh[3])}; }
#endif
        if ((t & 15) == 15) *((f32x4*)(ws + WS_PO) + ((size_t)(b * 4 + hh) * (SEQ / 16) + (t >> 4)) * 16 + l16) = (f32x4){om[0], om[1], om[2], om[3]};
    }
#endif
    *((u32x4*)(ws + WS_PV) + rec * 16 + l16) = (u32x4){pk_f16(vs[0], vs[0] * kr), pk_f16(vs[1], vs[1] * kr), pk_f16(vs[2], vs[2] * kr), pk_f16(vs[3], vs[3] * kr)};
    if (l16 == ti) { keep_rkr = rkr; keep_kr = kr; }
}
__device__ __forceinline__ void prep_run(const Params& P, int layer, int r0, int lane, LAS unsigned char* lup) {
    unsigned char* ws = P.ws;
    const bf16_t* RIN = (const bf16_t*)(ws + WS_RIN);
    const int c0 = 4 * lane;
    {
        const int tok = lane & 15, kq = lane >> 4, r = r0 + tok; const bool hp = (r & (SEQ - 1)) != 0;
        const float* mu = PRM(PRM_MU) + layer * DSH + 768 + 8 * kq;
        const bf16_t* cw = RIN + (size_t)r * DSH + 768 + 8 * kq;
        const u32x4 cww = *(const u32x4*)cw, caw = *(const u32x4*)(cw + 32);
        u32x4 pww = {0u, 0u, 0u, 0u}, paw = {0u, 0u, 0u, 0u};
        if (hp) { pww = *(const u32x4*)(cw - DSH); paw = *(const u32x4*)(cw - DSH + 32); }
        const f32x4 mw0 = *(const f32x4*)mu, mw1 = *(const f32x4*)(mu + 4), ma0 = *(const f32x4*)(mu + 32), ma1 = *(const f32x4*)(mu + 36);
        u32x4 fw, fa;
#pragma unroll
        for (int q = 0; q < 4; ++q) { const unsigned cwq = cww[q], pwq = pww[q], caq = caw[q], paq = paw[q];
            const float mlo = q < 2 ? mw0[2 * q] : mw1[2 * q - 4], mhi = q < 2 ? mw0[2 * q + 1] : mw1[2 * q - 3];
            const float nlo = q < 2 ? ma0[2 * q] : ma1[2 * q - 4], nhi = q < 2 ? ma0[2 * q + 1] : ma1[2 * q - 3];
            const float xl = bf_lo(cwq), xh = bf_hi(cwq), yl = bf_lo(caq), yh = bf_hi(caq);
            fw[q] = pk_bf16(tanhf_(xl + (bf_lo(pwq) - xl) * mlo), tanhf_(xh + (bf_hi(pwq) - xh) * mhi));
            fa[q] = pk_bf16(yl + (bf_lo(paq) - yl) * nlo, yh + (bf_hi(paq) - yh) * nhi); }
        const bf16x8 Aw = __builtin_bit_cast(bf16x8, fw), Aa = __builtin_bit_cast(bf16x8, fa);
        const u32x4* bfw = (const u32x4*)(ws + WS_WUPF) + (size_t)layer * 2 * 16 * 64 + lane;
#pragma unroll 4
        for (int nb = 0; nb < 16; ++nb) {
            const u32x4 bw = bfw[nb * 64], ba = bfw[(16 + nb) * 64];
            f32x4 z = {0.f, 0.f, 0.f, 0.f};
            const f32x4 dw = __builtin_amdgcn_mfma_f32_16x16x32_bf16(Aw, __builtin_bit_cast(bf16x8, bw), z, 0, 0, 0);
            const f32x4 da = __builtin_amdgcn_mfma_f32_16x16x32_bf16(Aa, __builtin_bit_cast(bf16x8, ba), z, 0, 0, 0);
            LAS _Float16* dst = (LAS _Float16*)lup + (size_t)(4 * kq) * 256 + 16 * nb + tok;
#pragma unroll
            for (int reg = 0; reg < 4; ++reg) { dst[reg * 256] = (_Float16)dw[reg]; dst[4096 + reg * 256] = (_Float16)da[reg]; }
        }
        asm volatile("s_waitcnt lgkmcnt(0)" ::: "memory");
    }
    PrepRaw pv_; pv_.r = (u32x2){0u, 0u}; pv_.k = (u32x2){0u, 0u}; pv_.v = (u32x2){0u, 0u};
    if ((r0 & (SEQ - 1)) != 0) pv_ = prep_load(RIN + (size_t)(r0 - 1) * DSH, c0, lane);
    PrepRaw cu = prep_load(RIN + (size_t)r0 * DSH, c0, lane);
    float om[4] = {1.f, 1.f, 1.f, 1.f};
    PrepConst C;
    { const float* mu = PRM(PRM_MU) + layer * DSH;
      C.mr = *(const f32x4*)(mu + c0); C.mk = *(const f32x4*)(mu + 256 + c0); C.mv = *(const f32x4*)(mu + 512 + c0);
      C.w0 = *(const f32x4*)(PRM(PRM_W0) + layer * 256 + c0); C.a0 = *(const f32x4*)(PRM(PRM_A0) + layer * 256 + c0);
      C.kkp = *(const f32x4*)(PRM(PRM_KK) + layer * 256 + c0); C.kap = *(const f32x4*)(PRM(PRM_KA) + layer * 256 + c0); C.rkp = *(const f32x4*)(PRM(PRM_RK) + layer * 256 + c0); }
    float keep_rkr = 0.f, keep_kr = 0.f;
#pragma unroll 2
    for (int i = 0; i < 16; ++i) {
        PrepRaw nx = cu;
        if (i < 15) nx = prep_load(RIN + (size_t)(r0 + i + 1) * DSH, c0, lane);
        prep_token(P, layer, r0 + i, lane, lup, i, cu, pv_, om, C, keep_rkr, keep_kr);
        pv_ = cu; cu = nx;
    }
    { const size_t o = (size_t)(r0 + (lane & 15)) * 4 + (lane >> 4); ((float*)(ws + WS_RKR))[o] = keep_rkr; ((float*)(ws + WS_KRA))[o] = keep_kr; }
    asm volatile("s_waitcnt lgkmcnt(0)" ::: "memory");
}

__device__ __forceinline__ void decode_mix(const Params& P, int layer, int tok, int part, LAS unsigned char* lds, int tid, int wid, int lane) {
    unsigned char* ws = P.ws;
    const float* z = (const float*)(ws + WS_ZS) + (size_t)tok * DIN;
    bf16_t* MIXS = (bf16_t*)(ws + WS_MIXS) + (size_t)tok * DM;
    constexpr int DK_ROW = 528, DK_V = 67072, DK_SCR = 134144;
    LAS float* L = (LAS float*)(lds + DK_SCR);
    LAS float* pooled = L;
    LAS float* qs = L + 256;
    LAS float* knew = L + 768;
    LAS float* vnew = L + 896;
    LAS float* scs = L + 1024;
    LAS float* xs = (LAS float*)lds;
    LAS float* kkn = xs + 832;
    LAS float* bvec = kkn + 256;
    LAS float* wvv = bvec + 256;
    LAS float* ktv = wvv + 256;
    LAS float* rrv = ktv + 256;
    LAS float* vvv = rrv + 256;
    LAS float* ov = vvv + 256;
    LAS float* rkrs = ov + 256;
    const size_t lt = (size_t)layer * MS + tok;
    if (part == 0) {
    const float* kc = INP(3) + lt * 128 * 128; const float* vc = INP(4) + lt * 128 * 128;
    {
        const f32x4* ks_ = (const f32x4*)(kc + 128); const f32x4* vs_ = (const f32x4*)(vc + 128);
        f32x4* kd = (f32x4*)(P.out + O_KS + lt * 128 * 128); f32x4* vd = (f32x4*)(P.out + O_VS + lt * 128 * 128);
        f32x4 kt_[8], vt_[8];
#pragma unroll
        for (int q = 0; q < 8; ++q) { const int i = tid + 512 * q; if (i < 127 * 32) { kt_[q] = ks_[i]; vt_[q] = vs_[i]; } }
#pragma unroll
        for (int q = 0; q < 8; ++q) { const int i = tid + 512 * q; if (i < 127 * 32) { kd[i] = kt_[q]; vd[i] = vt_[q];
            *(LAS f32x4*)(lds + (i >> 5) * DK_ROW + (i & 31) * 16) = kt_[q]; *(LAS f32x4*)(lds + DK_V + (i >> 5) * DK_ROW + (i & 31) * 16) = vt_[q]; } }
    }
    const f32x2 cs = ((const f32x2*)(ws + WS_ROPE))[2048 * 32 + (lane & 31)];
    {
        const float x = z[512 + wid * 64 + lane];
        const float ss = wave_sum(x * x);
        const float xn = x * (1.0f / sqrtf(ss * (1.0f / 64.0f) + 1e-6f)) * PRM(PRM_QG)[layer * 64 + lane];
        const float pr = __shfl_xor(xn, 32);
        qs[wid * 64 + lane] = (lane < 32 ? xn * cs.x - pr * cs.y : pr * cs.y + xn * cs.x) * 0.125f;
    }
    if (wid < 2) {
        const float x = z[1024 + wid * 64 + lane];
        const float ss = wave_sum(x * x);
        const float xn = x * (1.0f / sqrtf(ss * (1.0f / 64.0f) + 1e-6f)) * PRM(PRM_KG)[layer * 64 + lane];
        const float pr = __shfl_xor(xn, 32);
        const float kv = lane < 32 ? xn * cs.x - pr * cs.y : pr * cs.y + xn * cs.x;
        knew[wid * 64 + lane] = kv;
        P.out[O_KS + (lt * 128 + 127) * 128 + wid * 64 + lane] = kv;
    } else if (wid < 4) {
        const float x = z[1152 + (wid - 2) * 64 + lane];
        vnew[(wid - 2) * 64 + lane] = x;
        P.out[O_VS + (lt * 128 + 127) * 128 + (wid - 2) * 64 + lane] = x;
    }
    __syncthreads();
    {
        const int kvh = wid >> 2;
#pragma unroll
        for (int jj = 0; jj < 2; ++jj) { const int j = lane + 64 * jj; float a = 0.f;
            if (j < 127) { const LAS f32x4* kr_ = (const LAS f32x4*)(lds + j * DK_ROW + kvh * 256);
#pragma unroll
                for (int d4 = 0; d4 < 16; ++d4) { const f32x4 kq = kr_[d4]; const LAS float* qq = qs + wid * 64 + 4 * d4; a += kq[0] * qq[0] + kq[1] * qq[1] + kq[2] * qq[2] + kq[3] * qq[3]; } }
            else {
#pragma unroll 8
                for (int d = 0; d < 64; ++d) a += knew[kvh * 64 + d] * qs[wid * 64 + d]; }
            scs[wid * 128 + j] = a; }
    }
    __syncthreads();
    {
        const float sk = PRM(PRM_SINK)[layer * 8 + wid];
        const float s0 = scs[wid * 128 + lane], s1 = scs[wid * 128 + 64 + lane];
        const float m = fmaxf(wave_max(fmaxf(s0, s1)), sk);
        const float p0 = fast_exp(s0 - m), p1 = fast_exp(s1 - m);
        const float den = wave_sum(p0 + p1) + fast_exp(sk - m);
        scs[wid * 128 + lane] = p0 / den; scs[wid * 128 + 64 + lane] = p1 / den;
    }
    __syncthreads();
    {
        const int kvh = wid >> 2; float o = 0.f;
        const LAS float* vb = (const LAS float*)(lds + DK_V) + kvh * 64 + lane;
#pragma unroll 16
        for (int j = 0; j < 127; ++j) o += scs[wid * 128 + j] * vb[j * (DK_ROW / 4)];
        o += scs[wid * 128 + 127] * vnew[kvh * 64 + lane];
        MIXS[256 + wid * 64 + lane] = f2bf(o * siluf_(z[1280 + wid * 64 + lane]));
    }
    } else {
    const int row = tid >> 1, half = tid & 1, hd = row >> 6;
    const f32x4* sp = (const f32x4*)(INP(6) + (lt * 256 + row) * 64 + 32 * half);
    f32x4 S[8];
#pragma unroll
    for (int i = 0; i < 8; ++i) S[i] = sp[i];
    const float* mu = PRM(PRM_MU) + layer * DSH;
    const float* shp = INP(5) + lt * DSH;
    { const int i0 = tid, i1 = tid + 512;
      float x0 = 0.f, x1 = 0.f, s0 = 0.f, s1 = 0.f, m0 = 0.f, m1 = 0.f;
      if (i0 < DSH) { x0 = z[1792 + i0]; s0 = shp[i0]; m0 = mu[i0]; }
      if (i1 < DSH) { x1 = z[1792 + i1]; s1 = shp[i1]; m1 = mu[i1]; }
      if (i0 < DSH) { P.out[O_SHS + lt * DSH + i0] = x0; xs[i0] = x0 + (s0 - x0) * m0; }
      if (i1 < DSH) { P.out[O_SHS + lt * DSH + i1] = x1; xs[i1] = x1 + (s1 - x1) * m1; } }
    if (tid >= 256) {
        const int c = tid - 256, g = c >> 6, W_ = 2 << g;
        const float* buf = INP(2) + lt * 15 * 256 + c;
        float* po = P.out + O_POOLS + lt * 15 * 256 + c;
        const float u = z[c];
        float eb[15];
#pragma unroll
        for (int j = 0; j < 15; ++j) eb[j] = buf[j * 256];
        float win = u;
#pragma unroll
        for (int j = 0; j < 15; ++j) { if (j >= 16 - W_) win += eb[j]; if (j >= 1) po[(j - 1) * 256] = eb[j]; }
        po[14 * 256] = u;
        pooled[c] = win / (float)W_ - u;
    }
    __syncthreads();
    if (tid >= 256) {
        const int c = tid - 256, g = c >> 6, d = c & 63;
        const float* pw = PRM(PRM_POOLW) + ((size_t)(layer * 4 + g) * 64) * 64 + d;
        float a = 0.f;
#pragma unroll 32
        for (int cc = 0; cc < 64; ++cc) a += pooled[64 * g + cc] * pw[cc * 64];
        MIXS[c] = f2bf(a * PRM(PRM_POOLSC)[layer * 256 + c] * siluf_(z[256 + c]));
    }
    if (tid < 256) {
        const int c = tid;
        float lw = 0.f, la = 0.f;
#pragma unroll 16
        for (int j = 0; j < 32; ++j) { lw += tanhf_(xs[768 + j]) * PRM(PRM_WUP)[((size_t)layer * 32 + j) * 256 + c]; la += xs[800 + j] * PRM(PRM_AUP)[((size_t)layer * 32 + j) * 256 + c]; }
        const float wv = fast_exp(-0.6065306597126334f * sigmoidf_(PRM(PRM_W0)[layer * 256 + c] + lw));
        const float av = sigmoidf_(PRM(PRM_A0)[layer * 256 + c] + la);
        const float rr = xs[c], kx = xs[256 + c], vx = xs[512 + c];
        float kk = kx * PRM(PRM_KK)[layer * 256 + c];
        const float ssq = wave_sum(kk * kk);
        kk = kk / fmaxf(sqrtf(ssq), 1e-12f);
        const float kt = kx * (1.0f + (av - 1.0f) * PRM(PRM_KA)[layer * 256 + c]);
        const float rkr = wave_sum(rr * kt * PRM(PRM_RK)[layer * 256 + c]);
        kkn[c] = kk; bvec[c] = kk * av; wvv[c] = wv; ktv[c] = kt; rrv[c] = rr; vvv[c] = vx;
        if (lane == 0) rkrs[wid] = rkr;
    }
    __syncthreads();
    {
        f32x4* so = (f32x4*)(P.out + O_WKS + (lt * 256 + row) * 64 + 32 * half);
        float sa = 0.f;
#pragma unroll
        for (int i = 0; i < 8; ++i) {
#pragma unroll
            for (int e = 0; e < 4; ++e) sa += S[i][e] * kkn[hd * 64 + 32 * half + 4 * i + e]; }
        sa += __shfl_xor(sa, 1);
        const float vr = vvv[row]; float o = 0.f;
#pragma unroll
        for (int i = 0; i < 8; ++i) {
#pragma unroll
            for (int e = 0; e < 4; ++e) { const int k = hd * 64 + 32 * half + 4 * i + e;
                const float sn = S[i][e] * wvv[k] - sa * bvec[k] + vr * ktv[k]; S[i][e] = sn; o += sn * rrv[k]; }
            so[i] = S[i]; }
        o += __shfl_xor(o, 1);
        if (half == 0) ov[row] = o;
    }
    __syncthreads();
    if (tid < 256) {
        const int c = tid;
        const float o = ov[c];
        const float mean = wave_sum(o) * (1.0f / 64.0f);
        const float dlt = o - mean;
        const float var = wave_sum(dlt * dlt) * (1.0f / 64.0f);
        const float on = dlt * (1.0f / sqrtf(var + 64e-5f)) * PRM(PRM_LNG)[layer * 256 + c] + PRM(PRM_LNB)[layer * 256 + c];
        MIXS[768 + c] = f2bf((on + rkrs[wid] * vvv[c]) * siluf_(z[2624 + c]));
    }
    }
    __syncthreads();
}

constexpr int SC_TC = 32, SC_A1A = 0, SC_A1B = SC_TC * 256, SC_A2A = 2 * SC_TC * 256, SC_A2B = 3 * SC_TC * 256, SC_W = 4 * SC_TC * 256, SC_V = 5 * SC_TC * 256, SC_BUF = SC_V + SC_TC * 128;
#define DPP_ADD(z, CTRL) ((z) + __builtin_bit_cast(float, __builtin_amdgcn_update_dpp(0, __builtin_bit_cast(int, (z)), (CTRL), 0xf, 0xf, true)))
__device__ __forceinline__ void scan_unit(const Params& P, int layer, int unit, LAS unsigned char* lds, int tid, int wid, int lane) {
    unsigned char* ws = P.ws;
    const int hb = unit >> 2, rg = unit & 3;
    const int p = lane & 15, rowl = (wid & 3) * 4 + (lane >> 4), row = 16 * rg + rowl;
    const bool odd = (lane & 1) != 0, worker = wid < 4;
    const unsigned char* gA = ws + WS_PA + (size_t)hb * SEQ * 512;
    const unsigned char* gW = ws + WS_PW + (size_t)hb * SEQ * 256;
    const unsigned char* gV = ws + WS_PV + ((size_t)hb * SEQ * 64 + 16 * rg) * 4;
    const int stid = tid - 256;
    u32x4 ra[4], rw[2], rv = {0u, 0u, 0u, 0u};
#define SC_GLOAD(c) do { if (!worker) { const size_t t0_ = (size_t)(c) * SC_TC; \
        _Pragma("unroll") for (int i = 0; i < 4; ++i) ra[i] = *(const u32x4*)(gA + t0_ * 512 + (size_t)(stid + 256 * i) * 16); \
        _Pragma("unroll") for (int i = 0; i < 2; ++i) rw[i] = *(const u32x4*)(gW + t0_ * 256 + (size_t)(stid + 256 * i) * 16); \
        if (stid < 128) rv = *(const u32x4*)(gV + (t0_ + (stid >> 2)) * 256 + (stid & 3) * 16); } } while (0)
#define SC_LSTORE(buf) do { if (!worker) { LAS unsigned char* B_ = lds + (buf) * SC_BUF; \
        _Pragma("unroll") for (int i = 0; i < 4; ++i) { const int idx = stid + 256 * i; const int tk_ = idx >> 5, pr_ = idx & 31, sl_ = pr_ >> 1, hf_ = pr_ & 1; \
            const unsigned x0 = ra[i][0], x1 = ra[i][1], x2 = ra[i][2], x3 = ra[i][3]; const h2_t h0 = as_h2(x0), h1 = as_h2(x1), h2 = as_h2(x2), h3 = as_h2(x3); \
            *(LAS f32x4*)(B_ + (hf_ ? SC_A1B : SC_A1A) + tk_ * 256 + sl_ * 16) = (f32x4){(float)h0.x, (float)h3.x, (float)h0.y, (float)h3.y}; \
            *(LAS f32x2*)(B_ + SC_A2A + tk_ * 256 + sl_ * 16 + hf_ * 8) = (f32x2){(float)h1.x, (float)h1.y}; \
            *(LAS f32x2*)(B_ + SC_A2B + tk_ * 256 + sl_ * 16 + hf_ * 8) = (f32x2){(float)h2.x, (float)h2.y}; } \
        _Pragma("unroll") for (int i = 0; i < 2; ++i) *(LAS u32x4*)(B_ + SC_W + (stid + 256 * i) * 16) = rw[i]; \
        if (stid < 128) { const unsigned y0 = rv[0], y1 = rv[1], y2 = rv[2], y3 = rv[3]; const h2_t g0 = as_h2(y0), g1 = as_h2(y1), g2 = as_h2(y2), g3 = as_h2(y3); \
            *(LAS f32x4*)(B_ + SC_V + stid * 32) = (f32x4){(float)g0.x, (float)g0.y, (float)g1.x, (float)g1.y}; \
            *(LAS f32x4*)(B_ + SC_V + stid * 32 + 16) = (f32x4){(float)g2.x, (float)g2.y, (float)g3.x, (float)g3.y}; } } } while (0)
    f32x2 Sa = {0.f, 0.f}, Sb = {0.f, 0.f};
    SC_GLOAD(0); SC_LSTORE(0);
    __syncthreads();
    const __amdgpu_buffer_rsrc_t orsrc = __builtin_amdgcn_make_buffer_rsrc((void*)(ws + WS_ORAW), 0, 32 * 1024 * 1024, 0x00020000);
    const unsigned obase = (unsigned)((((size_t)(hb >> 2) * SEQ) * 256 + (hb & 3) * 64 + row) * 4);
    for (int c = 0; c < SEQ / SC_TC; ++c) {
        if (c + 1 < SEQ / SC_TC) SC_GLOAD(c + 1);
        if (worker) {
            const LAS unsigned char* B = lds + (c & 1) * SC_BUF + p * 16;
            const LAS unsigned char* pV = lds + (c & 1) * SC_BUF + SC_V + rowl * 8;
            unsigned ooff = (p == 1) ? obase + (unsigned)c * (SC_TC * 1024) : 0x7fffff00u;
            f32x4 n1a = *(const LAS f32x4*)(B + SC_A1A), n1b = *(const LAS f32x4*)(B + SC_A1B), n2a = *(const LAS f32x4*)(B + SC_A2A), n2b = *(const LAS f32x4*)(B + SC_A2B), nw = *(const LAS f32x4*)(B + SC_W);
            f32x2 nv = *(const LAS f32x2*)pV;
#pragma unroll 8
            for (int tt = 0; tt < SC_TC; ++tt) {
                const f32x4 a1a = n1a, a1b = n1b, bb = n2a, kt = n2b, w = nw; const f32x2 v2 = nv;
                { const int o_ = (tt + 1) * 256;
                  n1a = *(const LAS f32x4*)(B + SC_A1A + o_); n1b = *(const LAS f32x4*)(B + SC_A1B + o_); n2a = *(const LAS f32x4*)(B + SC_A2A + o_); n2b = *(const LAS f32x4*)(B + SC_A2B + o_);
                  nw = *(const LAS f32x4*)(B + SC_W + o_); nv = *(const LAS f32x2*)(pV + (tt + 1) * 128); }
                f32x2 pq = (f32x2){a1a[0], a1a[1]} * Sa[0] + (f32x2){a1a[2], a1a[3]} * Sa[1];
                pq = pq + (f32x2){a1b[0], a1b[1]} * Sb[0] + (f32x2){a1b[2], a1b[3]} * Sb[1];
                const float x = odd ? pq[1] : pq[0], y = odd ? pq[0] : pq[1];
                float zr = x + __builtin_bit_cast(float, __builtin_amdgcn_update_dpp(0, __builtin_bit_cast(int, y), 0xB1, 0xf, 0xf, true));
                zr = DPP_ADD(zr, 0x4E);
                zr = DPP_ADD(zr, 0x124);
                zr = DPP_ADD(zr, 0x128);
                const float nsa = -__builtin_bit_cast(float, __builtin_amdgcn_update_dpp(0, __builtin_bit_cast(int, zr), 0xA0, 0xf, 0xf, true));
                Sa = Sa * (f32x2){w[0], w[1]} + ((f32x2){bb[0], bb[1]} * nsa + (f32x2){kt[0], kt[1]} * v2[0]);
                Sb = Sb * (f32x2){w[2], w[3]} + ((f32x2){bb[2], bb[3]} * nsa + (f32x2){kt[2], kt[3]} * v2[0]);
                __builtin_amdgcn_raw_buffer_store_b32(__float_as_uint(zr + v2[1]), orsrc, ooff, 0, 0);
                ooff += 1024u;
            }
        }
        if (c + 1 < SEQ / SC_TC) SC_LSTORE((c + 1) & 1);
        __syncthreads();
    }
    if (worker) *(f32x4*)(P.out + O_WKP + (((size_t)layer * 64 + hb) * 64 + row) * 64 + 4 * p) = (f32x4){Sa[0], Sa[1], Sb[0], Sb[1]};
#undef SC_GLOAD
#undef SC_LSTORE
}

typedef _Float16 half8 __attribute__((ext_vector_type(8)));
typedef _Float16 half4 __attribute__((ext_vector_type(4)));
constexpr int MS_TROW = 144, MS_TILE = 16 * MS_TROW;
constexpr int MS_UK = 0, MS_UW = MS_TILE, MS_A5 = 2 * MS_TILE, MS_OM = MS_A5 + 4096, MS_A3 = MS_OM + 256, MS_A4 = MS_A3 + 1024, MS_VB = MS_A4 + 1024, MS_IMG = MS_VB + 4 * 512;
constexpr int MS_SCR = 2 * MS_TILE, MS_SCR0 = 8 * MS_IMG;
#define MFMA16H(a, b, c) __builtin_amdgcn_mfma_f32_16x16x32_f16((a), (b), (c), 0, 0, 0)
__device__ __forceinline__ half8 pack_h8(f32x4 lo, f32x4 hi) { half8 h; h[0] = (_Float16)lo[0]; h[1] = (_Float16)lo[1]; h[2] = (_Float16)lo[2]; h[3] = (_Float16)lo[3];
    h[4] = (_Float16)hi[0]; h[5] = (_Float16)hi[1]; h[6] = (_Float16)hi[2]; h[7] = (_Float16)hi[3]; return h; }
__device__ __forceinline__ half8 pack_h8v(f32x4 lo, half4 hi) { half8 h; h[0] = (_Float16)lo[0]; h[1] = (_Float16)lo[1]; h[2] = (_Float16)lo[2]; h[3] = (_Float16)lo[3];
    h[4] = hi[0]; h[5] = hi[1]; h[6] = hi[2]; h[7] = hi[3]; return h; }

struct MsRegs { half8 f[4][2]; float om; float krj; unsigned vraw[4][4]; };
__device__ __forceinline__ void mscan_load(const unsigned char* ws, int hb, int c, int lane, MsRegs& R) {
    const int r = lane & 15, q = lane >> 4;
    const size_t t0 = (size_t)c * 16;
    const unsigned char* gB = ws + WS_PB + ((size_t)hb * SEQ + t0 + r) * 512 + (size_t)q * 16;
#pragma unroll
    for (int m = 0; m < 4; ++m)
#pragma unroll
        for (int s2 = 0; s2 < 2; ++s2) R.f[m][s2] = *(const half8*)(gB + m * 128 + s2 * 64);
    R.om = ((const float*)(ws + WS_PO))[((size_t)hb * (SEQ / 16) + c) * 64 + lane];
    R.krj = ((const float*)(ws + WS_KRA))[((size_t)(hb >> 2) * SEQ + t0 + r) * 4 + (hb & 3)];
    const unsigned* gV = (const unsigned*)(ws + WS_PV) + ((size_t)hb * SEQ + t0 + 4 * q) * 64 + r;
#pragma unroll
    for (int rg = 0; rg < 4; ++rg)
#pragma unroll
        for (int e = 0; e < 4; ++e) R.vraw[rg][e] = gV[(size_t)e * 64 + 16 * rg];
}
__device__ __forceinline__ void mscan_build(const MsRegs& R, LAS unsigned char* img, LAS unsigned char* scr, int lane) {
    const int r = lane & 15, q = lane >> 4, k = lane;
    LAS unsigned char* tBH = scr; LAS unsigned char* tKH = scr + MS_TILE;
#pragma unroll
    for (int s2 = 0; s2 < 2; ++s2) { const int co = r * MS_TROW + (8 * q + 32 * s2) * 2;
        *(LAS half8*)(img + MS_UK + co) = R.f[0][s2]; *(LAS half8*)(img + MS_UW + co) = R.f[1][s2];
        *(LAS half8*)(tBH + co) = R.f[2][s2]; *(LAS half8*)(tKH + co) = R.f[3][s2]; }
    f32x4 be = {0.f, 0.f, 0.f, 0.f}, ga = be, bp = be, gp = be, gaT = be, beT = be;
#pragma unroll
    for (int s2 = 0; s2 < 2; ++s2) { const half8 fUK = R.f[0][s2], fUW = R.f[1][s2], fBH = R.f[2][s2], fKH = R.f[3][s2];
        be = MFMA16H(fBH, fUK, be); ga = MFMA16H(fKH, fUK, ga); bp = MFMA16H(fBH, fUW, bp); gp = MFMA16H(fKH, fUW, gp); gaT = MFMA16H(fUK, fKH, gaT); beT = MFMA16H(fUK, fBH, beT); }
#pragma unroll
    for (int reg = 0; reg < 4; ++reg) { const int i = 4 * q + reg; const bool up = i < r, lo = r < i;
        be[reg] = up ? be[reg] : 0.f; ga[reg] = up ? ga[reg] : 0.f; bp[reg] = up ? bp[reg] : 0.f; gp[reg] = up ? gp[reg] : 0.f;
        gaT[reg] = lo ? gaT[reg] : 0.f; beT[reg] = lo ? beT[reg] : 0.f; }
    ga = ga * 16.0f; gp = gp * 16.0f; gaT = gaT * 16.0f;
#define MS_H4(x) ({ half4 h_; h_[0] = (_Float16)(x)[0]; h_[1] = (_Float16)(x)[1]; h_[2] = (_Float16)(x)[2]; h_[3] = (_Float16)(x)[3]; h_; })
#define MS_MM(xt, y) __builtin_amdgcn_mfma_f32_16x16x16f16(MS_H4(xt), MS_H4(y), ((f32x4){0.f, 0.f, 0.f, 0.f}), 0, 0, 0)
    const f32x4 nN = -be, nNT = -beT;
    const f32x4 N2 = MS_MM(nNT, nN), N2T = MS_MM(nN, nNT);
    const f32x4 N4 = MS_MM(N2T, N2), N4T = MS_MM(N2, N2T);
    const f32x4 N8 = MS_MM(N4T, N4);
    const f32x4 N3 = MS_MM(nNT, N2), N3T = MS_MM(N2, nNT);
    f32x4 P1 = nN + N2 + N3, P1T = nNT + N2T + N3T;
#pragma unroll
    for (int reg = 0; reg < 4; ++reg) { const float d = (4 * q + reg == r) ? 1.0f : 0.f; P1[reg] += d; P1T[reg] += d; }
    const f32x4 P2 = P1 + MS_MM(P1T, N4), P2T = P1T + MS_MM(N4, P1T);
    const f32x4 Tm = P2 + MS_MM(P2T, N8);
    const f32x4 g2 = MS_MM(gaT, Tm);
    { half8 h3; h3[0] = (_Float16)Tm[0]; h3[1] = (_Float16)Tm[1]; h3[2] = (_Float16)Tm[2]; h3[3] = (_Float16)Tm[3]; h3[4] = (_Float16)g2[0]; h3[5] = (_Float16)g2[1]; h3[6] = (_Float16)g2[2]; h3[7] = (_Float16)g2[3];
      *(LAS half8*)(img + MS_A3 + lane * 16) = h3; }
    { half8 h4;
#pragma unroll
      for (int e = 0; e < 4; ++e) { h4[e] = (_Float16)(-bp[e]); h4[4 + e] = (_Float16)(gp[e] + ((4 * q + e == r) ? R.krj : 0.f)); }
      *(LAS half8*)(img + MS_A4 + lane * 16) = h4; }
#pragma unroll
    for (int rg = 0; rg < 4; ++rg) { half4 hv;
#pragma unroll
      for (int e = 0; e < 4; ++e) { const unsigned u = R.vraw[rg][e]; hv[e] = as_h2(u).x; }
      *(LAS half4*)(img + MS_VB + rg * 512 + lane * 8) = hv; }
    asm volatile("s_waitcnt lgkmcnt(0)" ::: "memory");
    const float om = R.om;
    {
        const _Float16 omb = (_Float16)(-om), omk = (_Float16)(om * 16.0f);
        _Float16 bvv[16], kvv[16];
#pragma unroll
        for (int i = 0; i < 16; ++i) { bvv[i] = *(const LAS _Float16*)(tBH + i * MS_TROW + k * 2); kvv[i] = *(const LAS _Float16*)(tKH + i * MS_TROW + k * 2); }
        asm volatile("" ::: "memory");
#pragma unroll
        for (int qq = 0; qq < 4; ++qq) { half8 h;
#pragma unroll
            for (int e = 0; e < 4; ++e) { h[e] = bvv[4 * qq + e] * omb; h[4 + e] = kvv[4 * qq + e] * omk; }
            *(LAS half8*)(img + MS_A5 + ((k >> 4) * 64 + qq * 16 + (k & 15)) * 16) = h; }
    }
    *(LAS float*)(img + MS_OM + (((k >> 2) & 3) * 16 + (k >> 4) * 4 + (k & 3)) * 4) = om;
    asm volatile("s_waitcnt lgkmcnt(0)" ::: "memory");
}

struct MsOps { half8 uk0, uk1, uw0, uw1, a3, a4, a5[4]; half4 vb; f32x4 om[4]; };
__device__ __forceinline__ void mscan_ops_load(const LAS unsigned char* I, int rg, int lane, MsOps& o) {
    const int r = lane & 15, q = lane >> 4;
#define MS_UFRAG(T_, s_) ({ const half4 lo_ = *(const LAS half4*)(I + (T_) + r * MS_TROW + (32 * (s_) + 4 * q) * 2), hi_ = *(const LAS half4*)(I + (T_) + r * MS_TROW + (32 * (s_) + 16 + 4 * q) * 2); \
        half8 h_; h_[0] = lo_[0]; h_[1] = lo_[1]; h_[2] = lo_[2]; h_[3] = lo_[3]; h_[4] = hi_[0]; h_[5] = hi_[1]; h_[6] = hi_[2]; h_[7] = hi_[3]; h_; })
    o.uk0 = MS_UFRAG(MS_UK, 0); o.uk1 = MS_UFRAG(MS_UK, 1); o.uw0 = MS_UFRAG(MS_UW, 0); o.uw1 = MS_UFRAG(MS_UW, 1);
    o.vb = *(const LAS half4*)(I + MS_VB + rg * 512 + lane * 8);
    o.a3 = *(const LAS half8*)(I + MS_A3 + lane * 16); o.a4 = *(const LAS half8*)(I + MS_A4 + lane * 16);
#pragma unroll
    for (int kb = 0; kb < 4; ++kb) { o.a5[kb] = *(const LAS half8*)(I + MS_A5 + (kb * 64 + lane) * 16); o.om[kb] = *(const LAS f32x4*)(I + MS_OM + (q * 16 + kb * 4) * 4); }
}
__device__ __forceinline__ void mscan_unit(const Params& P, int layer, int hb, LAS unsigned char* lds, int wid, int lane) {
    unsigned char* ws = P.ws;
    const int r = lane & 15, q = lane >> 4;
    const int rg = wid & 3;
    f32x4 Sacc[4];
#pragma unroll
    for (int kb = 0; kb < 4; ++kb) Sacc[kb] = (f32x4){0.f, 0.f, 0.f, 0.f};
    float* oraw = (float*)(ws + WS_ORAW) + ((size_t)(hb >> 2) * SEQ) * 256 + (hb & 3) * 64 + 16 * rg + r;
    const bool builder = wid >= 4;
    const int bw = wid - 4;
    constexpr int NR = SEQ / 64;
    MsRegs R;
    if (builder) { mscan_load(ws, hb, bw, lane, R); mscan_build(R, lds + bw * MS_IMG, lds + MS_SCR0 + bw * MS_SCR, lane); mscan_load(ws, hb, 4 + bw, lane, R); }
    __syncthreads();
    for (int rd = 0; rd < SEQ / 64; ++rd) {
        if (builder) { if (rd + 1 < NR) { mscan_build(R, lds + (((rd + 1) & 1) * 4 + bw) * MS_IMG, lds + MS_SCR0 + bw * MS_SCR, lane);
                                             if (rd + 2 < NR) mscan_load(ws, hb, 4 * (rd + 2) + bw, lane, R); } }
        else {
            __builtin_amdgcn_s_setprio(2);
            MsOps cur, nxt;
            mscan_ops_load(lds + ((rd & 1) * 4) * MS_IMG, rg, lane, cur);
#pragma unroll
            for (int cc = 0; cc < 4; ++cc) {
                if (cc < 3) mscan_ops_load(lds + ((rd & 1) * 4 + cc + 1) * MS_IMG, rg, lane, nxt);
                asm volatile("" ::: "memory");
                const half8 bS0 = pack_h8(Sacc[0], Sacc[1]), bS1 = pack_h8(Sacc[2], Sacc[3]);
                f32x4 DT = {0.f, 0.f, 0.f, 0.f}, ET = DT;
                DT = MFMA16H(cur.uk0, bS0, DT); DT = MFMA16H(cur.uk1, bS1, DT);
                ET = MFMA16H(cur.uw0, bS0, ET); ET = MFMA16H(cur.uw1, bS1, ET);
                f32x4 SA = {0.f, 0.f, 0.f, 0.f};
                SA = MFMA16H(cur.a3, pack_h8v(DT, cur.vb), SA);
                const half8 b3 = pack_h8v(SA, cur.vb);
                const f32x4 OT = MFMA16H(cur.a4, b3, ET);
                float* op = oraw + ((size_t)(rd * 4 + cc) * 16 + 4 * q) * 256;
#pragma unroll
                for (int reg = 0; reg < 4; ++reg) op[(size_t)reg * 256] = OT[reg];
#pragma unroll
                for (int kb = 0; kb < 4; ++kb) Sacc[kb] = MFMA16H(cur.a5[kb], b3, Sacc[kb] * cur.om[kb]);
                if (cc < 3) cur = nxt;
            }
            __builtin_amdgcn_s_setprio(0);
        }
        __syncthreads();
    }
    if (!builder) {
        float* so = P.out + O_WKP + (((size_t)layer * 64 + hb) * 64 + 16 * rg + r) * 64;
#pragma unroll
        for (int kb = 0; kb < 4; ++kb) *(f32x4*)(so + 16 * kb + 4 * q) = Sacc[kb];
    }
}

__device__ __forceinline__ void post_token4(const Params& P, int layer, int r0, int rstride, int lane, const f32x4 lg, const f32x4 lb, bool dry = false) {
    unsigned char* ws = P.ws;
    const int c0 = 4 * lane, hh = lane >> 4, l16 = lane & 15;
    f32x4 o[4]; float rkr[4]; u32x4 pv[4]; u32x2 gt[4];
#pragma unroll
    for (int j = 0; j < 4; ++j) { const int r = r0 + j * rstride, b = r >> 11, t = r & (SEQ - 1);
        o[j] = *((const f32x4*)(ws + WS_ORAW) + (size_t)r * 64 + lane);
        rkr[j] = ((const float*)(ws + WS_RKR))[(size_t)r * 4 + hh];
        pv[j] = *((const u32x4*)(ws + WS_PV) + ((size_t)(b * 4 + hh) * SEQ + t) * 16 + l16);
        gt[j] = *(const u32x2*)((bf16_t*)(ws + WS_GM) + (size_t)r * 1024 + 768 + c0); }
#pragma unroll
    for (int j = 0; j < 4; ++j) { const int r = r0 + j * rstride;
        const f32x4 oo = o[j];
        const float mean = sum16d((oo[0] + oo[1]) + (oo[2] + oo[3])) * (1.0f / 64.0f);
        const f32x4 d = oo - mean;
        const float var = sum16d((d[0] * d[0] + d[1] * d[1]) + (d[2] * d[2] + d[3] * d[3])) * (1.0f / 64.0f);
        const float rstd = __builtin_amdgcn_rsqf(var + 64e-5f);
        const u32x4 pw = pv[j]; const unsigned pv0 = pw[0], pv1 = pw[1], pv2 = pw[2], pv3 = pw[3];
        const float v[4] = {(float)as_h2(pv0).x, (float)as_h2(pv1).x, (float)as_h2(pv2).x, (float)as_h2(pv3).x};
        const u32x2 gq = gt[j]; const unsigned g0 = gq.x, g1 = gq.y;
        const float g[4] = {bf_lo(g0), bf_hi(g0), bf_lo(g1), bf_hi(g1)};
        float y[4];
#pragma unroll
        for (int i = 0; i < 4; ++i) y[i] = (d[i] * rstd * lg[i] + lb[i] + rkr[j] * v[i]) * g[i];
        *(u32x2*)((bf16_t*)(ws + WS_GM) + (size_t)r * 1024 + 768 + c0) = dry ? gq : (u32x2){pk_bf16(y[0], y[1]), pk_bf16(y[2], y[3])}; }
}

#define XB_TMO      128
#define XB_XCNT(j)  (256  + 64 * (j))
#define XB_XSUB(j)  (1280 + 64 * (j))
#define XB_XGEN(j)  (2304 + 64 * (j))
#define XB_TOP      3328
#define XB_TOPGEN   3392
#define XCD_BAR_WORDS 3456
#define XB_SPIN_CAP (1u << 18)

__device__ __forceinline__ unsigned xb_ld(unsigned* p)              { return __hip_atomic_load(p, __ATOMIC_RELAXED, __HIP_MEMORY_SCOPE_AGENT); }
__device__ __forceinline__ unsigned xb_add(unsigned* p, unsigned v) { return __hip_atomic_fetch_add(p, v, __ATOMIC_RELAXED, __HIP_MEMORY_SCOPE_AGENT); }
__device__ __forceinline__ unsigned xb_xcc_id() { return (unsigned)__builtin_amdgcn_s_getreg((3 << 11) | 20) & 0xFu; }
#define XB_SPIN(cond, bar) do { unsigned _sp = 0; while (cond) { __builtin_amdgcn_s_sleep(1); \
    if ((++_sp & 255u) == 0u) { if (xb_ld(&(bar)[XB_TMO])) break; if (_sp > XB_SPIN_CAP) { atomicAdd(&(bar)[XB_TMO], 1u); break; } } } } while (0)

struct XcdBarrier {
    unsigned* bar; unsigned x;
    volatile LAS unsigned* st;
};

__device__ __forceinline__ XcdBarrier xcd_barrier_post(unsigned* bar, volatile LAS unsigned* st) {
    XcdBarrier b; b.bar = bar; b.x = xb_xcc_id(); b.st = st;
    if (threadIdx.x == 0) (void)xb_add(&bar[XB_XCNT(b.x)], 1u);
    return b;
}
__device__ __forceinline__ void xcd_barrier_complete(unsigned* bar, unsigned x, unsigned& nloc, unsigned& nx) {
    const unsigned G = gridDim.x * gridDim.y * gridDim.z;
    unsigned sum, cnt, mine, sp = 0u;
    for (;;) {
        sum = 0u; cnt = 0u; mine = 0u;
#pragma unroll
        for (unsigned j = 0; j < 16; ++j) { const unsigned c = xb_ld(&bar[XB_XCNT(j)]); sum += c; cnt += (c > 0u) ? 1u : 0u; mine = (j == x) ? c : mine; }
        if (sum == G) break;
        __builtin_amdgcn_s_sleep(1);
        if ((++sp & 255u) == 0u) { if (xb_ld(&bar[XB_TMO])) break; if (sp > XB_SPIN_CAP) { atomicAdd(&bar[XB_TMO], 1u); break; } }
    }
    nloc = mine > 0u ? mine : 1u; nx = cnt > 0u ? cnt : 1u;
}

__device__ __forceinline__ void xcd_barrier(const XcdBarrier& b) {
    asm volatile("s_waitcnt vmcnt(0)" ::: "memory");
    __syncthreads();
    if (threadIdx.x == 0) {
        unsigned* bar = b.bar;
        __builtin_amdgcn_s_waitcnt(0);
        unsigned nloc = b.st[0], nx = b.st[1];
        if (nloc == 0u) { xcd_barrier_complete(bar, b.x, nloc, nx); b.st[0] = nloc; b.st[1] = nx; }
        const unsigned old = xb_add(&bar[XB_XSUB(b.x)], 1u);
        const unsigned gen = old / nloc;
        if (old + 1u == (gen + 1u) * nloc) {
            __builtin_amdgcn_fence(__ATOMIC_RELEASE, "agent");
            asm volatile("s_waitcnt vmcnt(0)" ::: "memory");
            const unsigned og = xb_add(&bar[XB_TOP], 1u);
            const unsigned tg = og / nx;
            if (og + 1u == (tg + 1u) * nx) xb_add(&bar[XB_TOPGEN], 1u);
            else XB_SPIN(xb_ld(&bar[XB_TOPGEN]) == tg, bar);
            __builtin_amdgcn_fence(__ATOMIC_ACQUIRE, "agent");
            xb_add(&bar[XB_XGEN(b.x)], 1u);
            asm volatile("s_waitcnt vmcnt(0)" ::: "memory");
        } else {
            XB_SPIN(xb_ld(&bar[XB_XGEN(b.x)]) == gen, bar);
            __builtin_amdgcn_fence(__ATOMIC_ACQUIRE, "agent");
            asm volatile("s_waitcnt vmcnt(0)" ::: "memory");
        }
    }
    __syncthreads();
}

constexpr int LDS_BYTES = 147456;
constexpr int NPHASE = 11;
template <bool IS_IN>
struct SkinnyPre { const Params& P; int layer, bx, G, wid, lane; LAS unsigned char* lb;
    __device__ __forceinline__ void operator()() const { for (int u = bx; u < (IS_IN ? NPAD / 16 : DM / 16); u += G) skinny_unit<IS_IN>(P, layer, u, wid, lane, lb); } };
#ifndef CODE_PF
#define CODE_PF 0
#endif
__device__ __forceinline__ void code_prefetch(unsigned long long pc0, int tid) {
    const volatile __attribute__((address_space(1))) unsigned* p = (const volatile __attribute__((address_space(1))) unsigned*)(pc0 + (unsigned long long)tid * 64ull);
    unsigned s_ = 0;
#pragma unroll
    for (int k = 0; k < 5; ++k) if (k * 512 + tid < 2240) s_ += p[k * 8192];
    asm volatile("" :: "v"(s_));
}
__global__ void __launch_bounds__(512, 2) hymba_fwd(Params P) {
    extern __shared__ __attribute__((aligned(16))) unsigned char lds_raw[];
    LAS unsigned char* lds = (LAS unsigned char*)lds_raw;
    cg::grid_group grid = cg::this_grid();
    unsigned long long pc0; asm volatile("s_getpc_b64 %0" : "=s"(pc0));
    if (CODE_PF & 1) code_prefetch(pc0, threadIdx.x);
    {
        volatile LAS unsigned* st = (volatile LAS unsigned*)(lds + 147392);
        if (threadIdx.x == 0) { st[0] = 0u; st[1] = 0u; st[2] = 0u; st[3] = 0u; }
        __syncthreads();
    }
#if INKERNEL_BAR_ZERO
    const XcdBarrier xbar = {(unsigned*)(P.ws + WS_CTL) + 4096, xb_xcc_id(), (volatile LAS unsigned*)(lds + 147392)};
    static_assert(XCD_BAR_WORDS <= 3584, "the prologue zeroes 3584 barrier words");
#else
    const XcdBarrier xbar = xcd_barrier_post((unsigned*)(P.ws + WS_CTL) + 4096, (volatile LAS unsigned*)(lds + 147392));
#endif
    const int G = gridDim.x, bx = blockIdx.x;
#define FRESH_IDS int tid = threadIdx.x; asm volatile("" : "+v"(tid)); const int lane = tid & 63; const int wid = __builtin_amdgcn_readfirstlane(tid >> 6); (void)lane; (void)wid; if (CODE_PF & 2) code_prefetch(pc0, tid);
    unsigned char* ws = P.ws;
    const int lo = P.ph_lo, hi = P.ph_hi;
#define IN(k) (lo <= (k) && (k) < hi)
#ifdef DBG_TS
#define TSTAMP(k) do { if (bx == 0 && threadIdx.x == 0) ((unsigned long long*)(ws + WS_CTL + 4096))[(k)] = __builtin_amdgcn_s_memrealtime(); } while (0)
#else
#define TSTAMP(k) do {} while (0)
#endif
#define SYNC_AFTER(k) do { if (IN(k) && IN((k) + 1)) { if ((k) == 0 && USE_CG_SYNC) grid.sync(); else xcd_barrier(xbar); if (DBG_DOUBLE & 8) xcd_barrier(xbar); } TSTAMP((k) + 1); } while (0)
    TSTAMP(0);
#ifndef SKIP_P0
    if (IN(0)) { FRESH_IDS for (int rep = 0; rep < ((DBG_DOUBLE & 32) ? 2 : 1); ++rep) p0_prologue(P, lds, G, tid, wid, lane); }
#endif
    SYNC_AFTER(0);
#if INKERNEL_BAR_ZERO
    if (threadIdx.x == 0) (void)xb_add(&xbar.bar[XB_XCNT(xbar.x)], 1u);
#endif
    for (int layer = 0; layer < NLAYER; ++layer) {
        const int pb = 1 + 5 * layer;
        if (IN(pb)) {
            FRESH_IDS
            pg8::Gemm g{(const pg8::bf16_t*)(ws + WS_XB), (const pg8::bf16_t*)(ws + WS_WIN) + (size_t)layer * NPAD * DM, MP, NPAD, DM};
            pg8::StaticOrder S; S.init(MP, NPAD, G, bx);
            EpiIn E; E.ws = ws; E.out = P.out; E.qg = PRM(PRM_QG) + layer * 64; E.kg = PRM(PRM_KG) + layer * 64; E.layer = layer;
#ifndef SKIP_G1
            for (int rep = 0; rep < ((DBG_DOUBLE & 1) ? 2 : 1); ++rep) pg8::gemm_phase<EpiIn, pg8::StaticOrder, false, SkinnyPre<true>>((PG8_LAS unsigned char*)lds, g, S, E, nullptr, SkinnyPre<true>{P, layer, bx, G, wid, lane, lds + 98304});
#endif
        }
        SYNC_AFTER(pb);
        if (IN(pb + 1)) {
            FRESH_IDS
#ifndef SKIP_PL
            for (int rep = ((DBG_DOUBLE & 256) ? 0 : 1); rep < 2; ++rep) for (int u = bx; u < 256; u += G) pool_unit(P, layer, u, lds, wid, lane, rep == 0);
#endif
            __syncthreads();
#ifndef SKIP_PR
            for (int rep = 0; rep < ((DBG_DOUBLE & 16) ? 2 : 1); ++rep) for (int r0 = (bx * 8 + wid) * 16; r0 < MP; r0 += G * 8 * 16) prep_run(P, layer, r0, lane, lds + wid * 16384);
#endif
        }
        SYNC_AFTER(pb + 1);
        if (IN(pb + 2)) {
            FRESH_IDS
            const int NSC = G >= 128 ? 64 : 0;
            if (bx < NSC || NSC == 0) {
#ifndef SKIP_SC
                for (int rep = 0; rep < ((DBG_DOUBLE & 2) ? 2 : 1); ++rep) for (int u = bx; u < 64; u += (NSC ? NSC : G)) { const int hb = ((u & 7) * 8 + (u >> 3)); mscan_unit(P, layer, hb, lds, wid, lane); __syncthreads(); }
#endif
            }
            if (bx >= NSC) {
                const int j = bx - NSC, NW = G - NSC;
#ifndef SKIP_DM
                for (int rep = 0; rep < ((DBG_DOUBLE & 4) ? 2 : 1); ++rep)
                    for (int i = 0; i * NW < 2 * MS; ++i) {
                        const int c = (2 * MS - i * NW) < NW ? (2 * MS - i * NW) : NW, jj = j - (NW - c);
                        if (jj >= 0) { const int u = i * NW + (i == 0 ? jj : (jj ^ 1)); decode_mix(P, layer, u >> 1, u & 1, lds, tid, wid, lane); }
                    }
#endif
                __syncthreads();
#ifndef SKIP_AT
                constexpr int ATT_LDS = 71680;
                for (int rep = ((DBG_DOUBLE & 128) ? 0 : 1); rep < 2; ++rep)
                    for (int u = j; u < 512; u += 2 * NW) {
                        attn_unit<true, false>(P, layer, u, lds, lds + 2 * ATT_LDS, tid, wid, lane);
                        if (u + NW < 512) attn_unit<true, false>(P, layer, u + NW, lds + ATT_LDS, lds + 2 * ATT_LDS, tid, wid, lane);
                        __syncthreads();
                        attn_unit<false, true>(P, layer, u, lds, lds + 2 * ATT_LDS, tid, wid, lane, rep == 0);
                        if (u + NW < 512) attn_unit<false, true>(P, layer, u + NW, lds + ATT_LDS, lds + 2 * ATT_LDS, tid, wid, lane, rep == 0);
                        __syncthreads();
                    }
#endif
            }
        }
        SYNC_AFTER(pb + 2);
        if (IN(pb + 3)) {
            FRESH_IDS
#ifndef SKIP_PO
            { const f32x4 lg = *(const f32x4*)(PRM(PRM_LNG) + layer * 256 + 4 * lane), lb = *(const f32x4*)(PRM(PRM_LNB) + layer * 256 + 4 * lane);
              for (int rep = ((DBG_DOUBLE & 512) ? 0 : 1); rep < 2; ++rep) for (int r = bx * 8 + wid; r < MP; r += 4 * G * 8) post_token4(P, layer, r, G * 8, lane, lg, lb, rep == 0); }
#endif
        }
        SYNC_AFTER(pb + 3);
        if (IN(pb + 4)) {
            FRESH_IDS
            pg8::Gemm g{(const pg8::bf16_t*)(ws + WS_GM), (const pg8::bf16_t*)(ws + WS_WOUT) + (size_t)layer * DM * DM, MP, DM, DM};
            pg8::StaticOrder S; S.init(MP, DM, G, bx);
            EpiOut E; E.resid = INP(0); E.out = P.out + O_YP; E.XB = (bf16_t*)(ws + WS_XB); E.RS = (float*)(ws + WS_RS) + MP; E.layer = layer;
#ifndef SKIP_G2
            for (int rep = 0; rep < (((DBG_DOUBLE & 64) && layer == 0) ? 2 : 1); ++rep) pg8::gemm_phase<EpiOut, pg8::StaticOrder, false, SkinnyPre<false>>((PG8_LAS unsigned char*)lds, g, S, E, nullptr, SkinnyPre<false>{P, layer, bx, G, wid, lane, lds + 98304});
#endif
        }
        if (layer + 1 < NLAYER) SYNC_AFTER(pb + 4);
    }
#ifdef DBG_TS
    TSTAMP(NPHASE);
    if (bx == 0 && threadIdx.x == 0) { const unsigned long long* ts = (const unsigned long long*)(ws + WS_CTL + 4096);
        P.out[O_YS] = (float)(ts[DBG_TS + 1] - ts[DBG_TS]) * (DBG_TS_SCALE); }
#endif
#undef IN
#undef SYNC_AFTER
}

#ifdef DBG_MASK
__global__ void dbg_scale(float* out) {
    const size_t G = gridDim.x, bx = blockIdx.x;
#define DBG_SCALE(o, lo_, hi_) if (((DBG_MASK | DBG_MASK2) >> (o)) & 1) { const float f_ = ((DBG_MASK >> (o)) & 1) ? DBG_FACTOR : DBG_FACTOR2; for (size_t i = (lo_) + bx * 256 + threadIdx.x; i < (hi_); i += G * 256) out[i] *= f_; }
    DBG_SCALE(0, O_YP, O_YS) DBG_SCALE(1, O_YS, O_POOLP) DBG_SCALE(2, O_POOLP, O_POOLS) DBG_SCALE(3, O_POOLS, O_KP) DBG_SCALE(4, O_KP, O_KS) DBG_SCALE(5, O_KS, O_VP)
    DBG_SCALE(6, O_VP, O_VS) DBG_SCALE(7, O_VS, O_SHP) DBG_SCALE(8, O_SHP, O_SHS) DBG_SCALE(9, O_SHS, O_WKP) DBG_SCALE(10, O_WKP, O_WKS) DBG_SCALE(11, O_WKS, O_END)
}
#endif
#if SCAN_IMPL == 2
__global__ void dbg_compare(float* out, const unsigned char* ws) {
    __shared__ float red[4][256];
    const int layer = DBG_CMP_SEL >> 1, tid = threadIdx.x;
    float md = 0.f, mr = 0.f;
    if ((DBG_CMP_SEL & 1) == 0) { const float* A_ = (const float*)(ws + WS_ORAW); const float* B_ = (const float*)(ws + WS_ORAW2);
        for (size_t i = tid; i < (size_t)MP * 256; i += 256 * 997) { const float a = A_[i], b = B_[i]; md = fmaxf(md, fabsf(a - b)); mr = fmaxf(mr, fabsf(a)); }
        for (size_t i = (size_t)tid * 4099; i < (size_t)MP * 256; i += (size_t)256 * 4099) { const float a = A_[i], b = B_[i]; md = fmaxf(md, fabsf(a - b)); mr = fmaxf(mr, fabsf(a)); } }
    else { const float* SA_ = out + O_WKP + (size_t)layer * 64 * 4096; const float* SB_ = (const float*)(ws + WS_ORAW2 + 32 * MiB) + (size_t)layer * 64 * 4096;
        for (size_t i = tid; i < (size_t)64 * 4096; i += 256) { const float a = SA_[i], b = SB_[i]; md = fmaxf(md, fabsf(a - b)); mr = fmaxf(mr, fabsf(a)); } }
    red[0][tid] = md; red[1][tid] = mr; __syncthreads();
    if (tid == 0) { for (int i = 1; i < 256; ++i) { md = fmaxf(md, red[0][i]); mr = fmaxf(mr, red[1][i]); }
        out[O_YS] = 1.0e4f * md / fmaxf(mr, 1e-20f); }
}
#endif
#ifndef MK_N_LAUNCHES
#define MK_N_LAUNCHES 1
#endif
extern "C" void kernel_launch(void* const* d_in, const int* in_sizes, int n_in, void* d_out, int out_size, void* d_ws, size_t ws_size, hipStream_t stream) {
    static int grid = 0;
    if (grid == 0) {
        if (n_in != 25 || out_size != (int)O_END || ws_size < WS_END) { fprintf(stderr, "kernel_launch: unexpected shapes: n_in %d out %d ws %zu\n", n_in, out_size, ws_size); grid = -1; return; }
        int dev = 0, cus = 0, per_cu = 0;
        if (hipGetDevice(&dev) != hipSuccess || hipDeviceGetAttribute(&cus, hipDeviceAttributeMultiprocessorCount, dev) != hipSuccess) { grid = -1; return; }
        if (hipFuncSetAttribute((const void*)hymba_fwd, hipFuncAttributeMaxDynamicSharedMemorySize, LDS_BYTES) != hipSuccess) { fprintf(stderr, "kernel_launch: hipFuncSetAttribute failed\n"); grid = -1; return; }
        if (hipOccupancyMaxActiveBlocksPerMultiprocessor(&per_cu, (const void*)hymba_fwd, 512, LDS_BYTES) != hipSuccess || per_cu < 1) { fprintf(stderr, "kernel_launch: occupancy query failed (%d)\n", per_cu); grid = -1; return; }
        grid = cus * 1;
    }
    if (grid < 0) return;
#if !INKERNEL_BAR_ZERO
    if (hipMemsetAsync((char*)d_ws + WS_CTL, 0, 65536, stream) != hipSuccess) { fprintf(stderr, "kernel_launch: memset of control words failed\n"); return; }
#endif
    Params p{};
    for (int i = 0; i < 25; ++i) p.in[i] = (const float*)d_in[i];
    p.out = (float*)d_out; p.ws = (unsigned char*)d_ws;
#if MK_N_LAUNCHES == 1
    p.ph_lo = 0; p.ph_hi = NPHASE;
    void* args[] = {&p};
    hipError_t e = hipLaunchCooperativeKernel((const void*)hymba_fwd, dim3(grid), dim3(512), args, LDS_BYTES, stream);
    if (e != hipSuccess) fprintf(stderr, "kernel_launch: cooperative launch failed: %s (grid %d)\n", hipGetErrorString(e), grid);
#if SCAN_IMPL == 2
    dbg_compare<<<1, 256, 0, stream>>>((float*)d_out, (const unsigned char*)d_ws);
#endif
#ifdef DBG_MASK
    dbg_scale<<<1024, 256, 0, stream>>>((float*)d_out);
#endif
#else
    for (int ph = 0; ph < NPHASE; ++ph) {
        p.ph_lo = ph; p.ph_hi = ph + 1;
        void* args[] = {&p};
        hipError_t e = hipLaunchCooperativeKernel((const void*)hymba_fwd, dim3(grid), dim3(512), args, LDS_BYTES, stream);
        if (e != hipSuccess) { fprintf(stderr, "kernel_launch: launch %d failed: %s\n", ph, hipGetErrorString(e)); break; }
    }
#endif
}
```
